# Optimizing an MI355X kernel written in HIP

```python
import jax, jax.numpy as jnp
from jax import lax
import numpy as np

D_MODEL = 2048
BATCH = 4
SEQ = 2048
DEPTH = 2
DEC_BATCH = 128
DEC_SEQ = 8
PAST_LEN = 16384
PAGE_SIZE = 128

N_META = 16
N_AB = (DEPTH + 1) // 2
N_C = DEPTH // 2
MIX_A = D_MODEL // 2
NH_A = 4
HD_A = MIX_A // NH_A
CHUNK_A = 128
RG_W = D_MODEL // 2
RG_BLOCKS = 8
RG_BW = RG_W // RG_BLOCKS
CONV_W = 4
RG_C = 8.0
PROJ_AB = 4 * MIX_A + 2 * NH_A + 2 * RG_W
HD_C = 64
NH_C = D_MODEL // HD_C
DECAY_LORA = 96
AAA_LORA = 96
GATE_LORA = 256
D_FF = 4 * D_MODEL
LN_EPS = 1e-5
GN_EPS = 64e-5
ALPHA = (2.0 * DEPTH) ** 0.25
BETA = (8.0 * DEPTH) ** -0.25

kernel_name = 'hybrid_mlstm_rglru_rwkv7_step'


def layer_norm(x, g, b, eps=LN_EPS):
    xf = x.astype(jnp.float32)
    mu = jnp.mean(xf, axis=-1, keepdims=True)
    var = jnp.mean(jnp.square(xf - mu), axis=-1, keepdims=True)
    return ((xf - mu) * lax.rsqrt(var + eps) * g + b).astype(x.dtype)


def sq_relu_mlp(x, w_up, w_down):
    return jnp.square(jax.nn.relu(x @ w_up)) @ w_down


def mlstm_chunk(carry, inp):
    C, n, m = carry
    q, k, v, ig, lf = inp
    L = q.shape[1]
    Fh = jnp.swapaxes(jnp.cumsum(lf, axis=1), 1, 2)
    igh = jnp.swapaxes(ig, 1, 2)
    logD = Fh[..., :, None] - Fh[..., None, :] + igh[..., None, :]
    logD = jnp.where(jnp.tril(jnp.ones((L, L), bool)), logD, -jnp.inf)
    b = Fh + m[..., None]
    m_row = jnp.maximum(b, jnp.max(logD, axis=-1))
    inter = jnp.exp(b - m_row)
    s = jnp.einsum('blhd,bmhd->bhlm', q, k) * jnp.exp(logD - m_row[..., None])
    num = jnp.einsum('bhlm,bmhd->bhld', s, v) + inter[..., None] * jnp.einsum('blhk,bhkv->bhlv', q, C)
    den = jnp.sum(s, axis=-1) + inter * jnp.einsum('blhk,bhk->bhl', q, n)
    h = num / jnp.maximum(jnp.abs(den), jnp.exp(-m_row))[..., None]
    FL = Fh[..., -1]
    wj = FL[..., None] - Fh + igh
    m_new = jnp.maximum(FL + m, jnp.max(wj, axis=-1))
    wexp = jnp.exp(wj - m_new[..., None])
    dec = jnp.exp(FL + m - m_new)
    C_new = dec[..., None, None] * C + jnp.einsum('bhl,blhk,blhv->bhkv', wexp, k, v)
    n_new = dec[..., None] * n + jnp.einsum('bhl,blhk->bhk', wexp, k)
    return (C_new, n_new, m_new), jnp.swapaxes(h, 1, 2)


def mlstm_seq(state, q, k, v, ig, lf, lead):
    B, T = q.shape[:2]
    ins = (q, k, v, ig, lf)
    if lead > 0:
        state, h_lead = mlstm_chunk(state, tuple(a[:, :lead] for a in ins))
        ins = tuple(a[:, lead:] for a in ins)
    rest = T - lead
    if rest % CHUNK_A == 0 and rest >= CHUNK_A:
        nc = rest // CHUNK_A
        split = lambda a: jnp.swapaxes(a.reshape((B, nc, CHUNK_A) + a.shape[2:]), 0, 1)
        state, h = lax.scan(mlstm_chunk, state, tuple(split(a) for a in ins))
        h = jnp.swapaxes(h, 0, 1)
        h = h.reshape((B, rest) + h.shape[3:])
    else:
        state, h = mlstm_chunk(state, ins)
    if lead > 0:
        h = jnp.concatenate([h_lead, h], axis=1)
    return state, h


def causal_conv(xb, buf, w, b):
    T = xb.shape[1]
    xp = jnp.concatenate([buf.astype(xb.dtype), xb], axis=1)
    out = b + sum(xp[:, j:j + T] * w[j] for j in range(CONV_W))
    return out, xp[:, T:]


def block_diag(x, w, b):
    xb = x.reshape(x.shape[:-1] + (RG_BLOCKS, RG_BW))
    return jnp.einsum('btni,nij->btnj', xb, w).reshape(x.shape) + b


def _lin_combine(e1, e2):
    return (e1[0] * e2[0], e2[0] * e1[1] + e2[1])


def rglru(x, h0, wa, ba, wx, bx, lam):
    r = jax.nn.sigmoid(block_diag(x, wa, ba))
    gi = jax.nn.sigmoid(block_diag(x, wx, bx))
    log_a = -RG_C * r * jax.nn.softplus(-lam.astype(jnp.float32))
    a = jnp.exp(log_a)
    u = jnp.sqrt(-jnp.expm1(2.0 * log_a)) * (gi * x)
    u = u.at[:, 0].add(a[:, 0] * h0)
    _, h = lax.associative_scan(_lin_combine, (a, u), axis=1)
    return h, h[:, -1]


def ab_mixer(x, C0, n0, m0, h0, conv0, p, i, lead):
    B, T, _ = x.shape
    z = x @ p['w_in_ab'][i]
    cuts = [MIX_A, 2 * MIX_A, 3 * MIX_A, 4 * MIX_A, 4 * MIX_A + 2 * NH_A, 4 * MIX_A + 2 * NH_A + RG_W]
    q, k, v, o, gates, xr, gr = jnp.split(z, cuts, axis=-1)
    heads = lambda t: t.astype(jnp.float32).reshape(B, T, NH_A, HD_A)
    gates = gates.astype(jnp.float32) + p['b_if_ab'][i].astype(jnp.float32)
    ig, lf = gates[..., :NH_A], jax.nn.log_sigmoid(gates[..., NH_A:])
    st0 = (C0.astype(jnp.float32), n0.astype(jnp.float32), m0.astype(jnp.float32))
    (C, n, m), hm = mlstm_seq(st0, heads(q), heads(k) * HD_A ** -0.5, heads(v), ig, lf, lead)
    mu = jnp.mean(hm, axis=-1, keepdims=True)
    var = jnp.mean(jnp.square(hm - mu), axis=-1, keepdims=True)
    hm = (hm - mu) * lax.rsqrt(var + LN_EPS) * p['mlstm_norm_g'][i].reshape(NH_A, HD_A)
    hm = hm.reshape(B, T, MIX_A) * jax.nn.sigmoid(o.astype(jnp.float32))
    xc, conv_new = causal_conv(xr, conv0, p['rg_conv_w'][i], p['rg_conv_b'][i])
    hr, h_last = rglru(xc.astype(jnp.float32), h0.astype(jnp.float32), p['rg_wa'][i], p['rg_ba'][i],
                       p['rg_wx'][i], p['rg_bx'][i], p['rg_lambda'][i])
    yr = hr * jax.nn.gelu(gr.astype(jnp.float32))
    y = jnp.concatenate([hm, yr], axis=-1).astype(x.dtype) @ p['w_out_ab'][i]
    return y.astype(x.dtype), C, n, m, h_last, conv_new


def rwkv_step(S, inp):
    r, w, k, v, a, b = inp
    sa = jnp.einsum('bhvk,bhk->bhv', S, a)
    S = S * w[:, :, None, :] + sa[..., None] * b[:, :, None, :] + v[..., None] * k[:, :, None, :]
    return S, jnp.einsum('bhvk,bhk->bhv', S, r)


def rwkv_mixer(x, S0, x_last, p, i):
    B, T, D = x.shape
    xf = x.astype(jnp.float32)
    x_prev = jnp.concatenate([x_last.astype(jnp.float32)[:, None], xf[:, :-1]], axis=1)
    xs = xf[:, :, None] + (x_prev - xf)[:, :, None] * p['rw_mu'][i]
    xr, xw, xk, xv, xa, xg = (xs[:, :, j] for j in range(6))
    r = xr @ p['rw_wr'][i]
    k = xk @ p['rw_wk'][i]
    v = xv @ p['rw_wv'][i]
    w = -jax.nn.softplus(-(p['rw_w0'][i] + jnp.tanh(xw @ p['rw_w1'][i]) @ p['rw_w2'][i])) - 0.5
    a = jax.nn.sigmoid(p['rw_a0'][i] + (xa @ p['rw_a1'][i]) @ p['rw_a2'][i])
    g = jax.nn.sigmoid(xg @ p['rw_g1'][i]) @ p['rw_g2'][i]
    heads = lambda t: t.astype(jnp.float32).reshape(B, T, NH_C, HD_C)
    kk = heads(k * p['rw_kk'][i])
    kk = kk / jnp.maximum(jnp.sqrt(jnp.sum(jnp.square(kk), axis=-1, keepdims=True)), 1e-12)
    k = k * (1.0 + (a - 1.0) * p['rw_ka'][i])
    rh, kh, vh = heads(r), heads(k), heads(v)
    seq = (rh, heads(jnp.exp(-jnp.exp(w))), kh, vh, -kk, kk * heads(a))
    S, y = lax.scan(rwkv_step, S0.astype(jnp.float32), tuple(jnp.moveaxis(t, 1, 0) for t in seq))
    y = jnp.moveaxis(y, 0, 1)
    mu = jnp.mean(y, axis=-1, keepdims=True)
    var = jnp.mean(jnp.square(y - mu), axis=-1, keepdims=True)
    yn = ((y - mu) * lax.rsqrt(var + GN_EPS)).reshape(B, T, D) * p['rw_lnx_g'][i] + p['rw_lnx_b'][i]
    bonus = jnp.sum(rh * kh * p['rw_rk'][i], axis=-1, keepdims=True) * vh
    out = ((yn + bonus.reshape(B, T, D)) * g).astype(x.dtype) @ p['rw_wo'][i]
    return out.astype(x.dtype), S, x[:, -1]


def trunk(h, states, p, lead):
    mC, mn, mm, rgh, rgc, rwS, rwx = states
    out = [[] for _ in range(7)]
    for layer in range(DEPTH):
        i = layer // 2
        if layer % 2 == 0:
            y, *new = ab_mixer(h, mC[i], mn[i], mm[i], rgh[i], rgc[i], p, i, lead)
            for lst, s in zip(out[:5], new):
                lst.append(s)
        else:
            y, *new = rwkv_mixer(h, rwS[i], rwx[i], p, i)
            for lst, s in zip(out[5:], new):
                lst.append(s)
        h = layer_norm(ALPHA * h + y, p['ln1_g'][layer], p['ln1_b'][layer])
        h = layer_norm(ALPHA * h + sq_relu_mlp(h, p['w_up'][layer], p['w_down'][layer]),
                       p['ln2_g'][layer], p['ln2_b'][layer])
    return h, [jnp.stack(lst) for lst in out]


def setup_inputs(seed: int = 0) -> dict:
    key = jax.random.key(seed)
    keys = list(jax.random.split(key, 64))
    nrm = lambda shape, scale: scale * jax.random.normal(keys.pop(), shape, jnp.float32)
    unif = lambda shape, lo, hi: jax.random.uniform(keys.pop(), shape, jnp.float32, lo, hi)
    D = D_MODEL
    s = unif((N_AB, RG_W), 0.9, 0.999) ** (1.0 / RG_C)
    return {
        'x_prompt': nrm((BATCH, SEQ, D), 1.0),
        'x_sample': nrm((DEC_BATCH, DEC_SEQ, D), 1.0),
        'state_mlstm_C': nrm((N_AB, DEC_BATCH, NH_A, HD_A, HD_A), 0.05),
        'state_mlstm_n': nrm((N_AB, DEC_BATCH, NH_A, HD_A), 0.05),
        'state_mlstm_m': nrm((N_AB, DEC_BATCH, NH_A), 1.0),
        'state_rglru_h': nrm((N_AB, DEC_BATCH, RG_W), 0.5),
        'state_rglru_conv': nrm((N_AB, DEC_BATCH, CONV_W - 1, RG_W), 1.0),
        'state_rwkv_S': nrm((N_C, DEC_BATCH, NH_C, HD_C, HD_C), 0.1),
        'state_rwkv_shift': nrm((N_C, DEC_BATCH, D), 1.0),
        'meta_tokens': nrm((N_META, D), 1.0),
        'w_in_ab': nrm((N_AB, D, PROJ_AB), D ** -0.5),
        'b_if_ab': jnp.concatenate([nrm((N_AB, NH_A), 0.1), 3.0 + unif((N_AB, NH_A), 0.0, 3.0)], axis=-1),
        'mlstm_norm_g': 1.0 + nrm((N_AB, MIX_A), 0.02),
        'rg_conv_w': nrm((N_AB, CONV_W, RG_W), CONV_W ** -0.5),
        'rg_conv_b': nrm((N_AB, RG_W), 0.02),
        'rg_wa': nrm((N_AB, RG_BLOCKS, RG_BW, RG_BW), RG_BW ** -0.5),
        'rg_ba': nrm((N_AB, RG_W), 0.02),
        'rg_wx': nrm((N_AB, RG_BLOCKS, RG_BW, RG_BW), RG_BW ** -0.5),
        'rg_bx': nrm((N_AB, RG_W), 0.02),
        'rg_lambda': jnp.log(s) - jnp.log1p(-s),
        'w_out_ab': nrm((N_AB, MIX_A + RG_W, D), (MIX_A + RG_W) ** -0.5 * BETA),
        'rw_mu': unif((N_C, 6, D), 0.0, 1.0),
        'rw_wr': nrm((N_C, D, D), D ** -0.5),
        'rw_wk': nrm((N_C, D, D), D ** -0.5),
        'rw_wv': nrm((N_C, D, D), D ** -0.5),
        'rw_wo': nrm((N_C, D, D), D ** -0.5 * BETA),
        'rw_w0': unif((N_C, D), -6.0, 0.5),
        'rw_w1': nrm((N_C, D, DECAY_LORA), D ** -0.5),
        'rw_w2': nrm((N_C, DECAY_LORA, D), 0.1 * DECAY_LORA ** -0.5),
        'rw_a0': nrm((N_C, D), 0.1),
        'rw_a1': nrm((N_C, D, AAA_LORA), D ** -0.5),
        'rw_a2': nrm((N_C, AAA_LORA, D), 0.1 * AAA_LORA ** -0.5),
        'rw_g1': nrm((N_C, D, GATE_LORA), D ** -0.5),
        'rw_g2': nrm((N_C, GATE_LORA, D), GATE_LORA ** -0.5),
        'rw_kk': 0.85 + nrm((N_C, D), 0.02),
        'rw_ka': 1.0 + nrm((N_C, D), 0.02),
        'rw_rk': nrm((N_C, NH_C, HD_C), 0.1),
        'rw_lnx_g': 1.0 + nrm((N_C, D), 0.02),
        'rw_lnx_b': nrm((N_C, D), 0.02),
        'ln1_g': 1.0 + nrm((DEPTH, D), 0.02),
        'ln1_b': nrm((DEPTH, D), 0.02),
        'ln2_g': 1.0 + nrm((DEPTH, D), 0.02),
        'ln2_b': nrm((DEPTH, D), 0.02),
        'w_up': nrm((DEPTH, D, D_FF), D ** -0.5),
        'w_down': nrm((DEPTH, D_FF, D), D_FF ** -0.5 * BETA),
    }


def reference(x_prompt, x_sample, state_mlstm_C, state_mlstm_n, state_mlstm_m, state_rglru_h,
              state_rglru_conv, state_rwkv_S, state_rwkv_shift, meta_tokens, w_in_ab, b_if_ab,
              mlstm_norm_g, rg_conv_w, rg_conv_b, rg_wa, rg_ba, rg_wx, rg_bx, rg_lambda, w_out_ab,
              rw_mu, rw_wr, rw_wk, rw_wv, rw_wo, rw_w0, rw_w1, rw_w2, rw_a0, rw_a1, rw_a2, rw_g1,
              rw_g2, rw_kk, rw_ka, rw_rk, rw_lnx_g, rw_lnx_b, ln1_g, ln1_b, ln2_g, ln2_b, w_up, w_down):
    p = dict(w_in_ab=w_in_ab, b_if_ab=b_if_ab, mlstm_norm_g=mlstm_norm_g, rg_conv_w=rg_conv_w,
             rg_conv_b=rg_conv_b, rg_wa=rg_wa, rg_ba=rg_ba, rg_wx=rg_wx, rg_bx=rg_bx,
             rg_lambda=rg_lambda, w_out_ab=w_out_ab, rw_mu=rw_mu, rw_wr=rw_wr, rw_wk=rw_wk,
             rw_wv=rw_wv, rw_wo=rw_wo, rw_w0=rw_w0, rw_w1=rw_w1, rw_w2=rw_w2, rw_a0=rw_a0,
             rw_a1=rw_a1, rw_a2=rw_a2, rw_g1=rw_g1, rw_g2=rw_g2, rw_kk=rw_kk, rw_ka=rw_ka,
             rw_rk=rw_rk, rw_lnx_g=rw_lnx_g, rw_lnx_b=rw_lnx_b, ln1_g=ln1_g, ln1_b=ln1_b,
             ln2_g=ln2_g, ln2_b=ln2_b, w_up=w_up, w_down=w_down)
    B = x_prompt.shape[0]
    dt = x_prompt.dtype
    zero_states = (
        jnp.zeros((N_AB, B, NH_A, HD_A, HD_A), jnp.float32),
        jnp.zeros((N_AB, B, NH_A, HD_A), jnp.float32),
        jnp.zeros((N_AB, B, NH_A), jnp.float32),
        jnp.zeros((N_AB, B, RG_W), jnp.float32),
        jnp.zeros((N_AB, B, CONV_W - 1, RG_W), dt),
        jnp.zeros((N_C, B, NH_C, HD_C, HD_C), jnp.float32),
        jnp.zeros((N_C, B, D_MODEL), dt),
    )
    meta = jnp.broadcast_to(meta_tokens.astype(dt)[None], (B, N_META, D_MODEL))
    hp, ps = trunk(jnp.concatenate([meta, x_prompt], axis=1), zero_states, p, N_META)
    sample_states = (state_mlstm_C, state_mlstm_n, state_mlstm_m, state_rglru_h, state_rglru_conv,
                     state_rwkv_S, state_rwkv_shift)
    hs, ss = trunk(x_sample, sample_states, p, 0)
    return (hp[:, N_META:], hs, ps[0], ps[1], ps[2], ps[3], ps[4], ps[5], ps[6],
            ss[0], ss[1], ss[2], ss[3], ss[4], ss[5], ss[6])
```

```cpp
#include <hip/hip_runtime.h>
#include <cstdio>
#include <cstdint>

#define GAS __attribute__((address_space(1)))
#define LAS __attribute__((address_space(3)))
typedef unsigned short bf16_t;
typedef short bf16x8 __attribute__((ext_vector_type(8)));
typedef short s16x4 __attribute__((ext_vector_type(4)));
typedef float f32x4 __attribute__((ext_vector_type(4)));
typedef float f32x2 __attribute__((ext_vector_type(2)));
typedef unsigned u32x4 __attribute__((ext_vector_type(4)));
typedef unsigned u32x2 __attribute__((ext_vector_type(2)));

constexpr int D = 2048, NB = 4, SEQ = 2048, NMETA = 16, TP = SEQ + NMETA  , DB = 128, DS = 8;
constexpr int MPR = NB * TP  , MSA = DB * DS  , M = MPR + MSA  , MP = 9472  ;
constexpr int NHA = 4, HDA = 256, MIXA = 1024, RGW = 1024, PROJ = 6152, NZ = 6144, DFF = 8192;
constexpr int NHC = 32, HDC = 64;
constexpr float ALPHA = 1.4142135623730951f;
constexpr float LN_EPS = 1e-5f, GN_EPS = 64e-5f;
constexpr int NWAVES = 8, NTHREADS = 512;

constexpr size_t O_YP = 0, O_YS = O_YP + (size_t)NB * SEQ * D, O_PC = O_YS + (size_t)DB * DS * D, O_PN = O_PC + (size_t)NB * NHA * HDA * HDA,
                 O_PM = O_PN + (size_t)NB * NHA * HDA, O_PH = O_PM + NB * NHA, O_PCV = O_PH + (size_t)NB * RGW, O_PS = O_PCV + (size_t)NB * 3 * RGW,
                 O_PX = O_PS + (size_t)NB * NHC * HDC * HDC, O_SC = O_PX + (size_t)NB * D, O_SN = O_SC + (size_t)DB * NHA * HDA * HDA,
                 O_SM = O_SN + (size_t)DB * NHA * HDA, O_SH = O_SM + DB * NHA, O_SCV = O_SH + (size_t)DB * RGW, O_SS = O_SCV + (size_t)DB * 3 * RGW,
                 O_SX = O_SS + (size_t)DB * NHC * HDC * HDC, O_END = O_SX + (size_t)DB * D;
static_assert(O_END == 71725584, "output size");

enum { I_XP = 0, I_XS, I_MC, I_MN, I_MM, I_RH, I_RC, I_RS, I_RX, I_META, I_WIN, I_BIF, I_MNG, I_CVW, I_CVB, I_WA, I_BA, I_WX, I_BX, I_LAM, I_WOUT,
       I_MU, I_WR, I_WK, I_WV, I_WO, I_W0, I_W1, I_W2, I_A0, I_A1, I_A2, I_G1, I_G2, I_KK, I_KA, I_RK, I_LNXG, I_LNXB, I_LN1G, I_LN1B, I_LN2G, I_LN2B, I_WUP, I_WDN, N_IN };
static_assert(N_IN == 45, "inputs");

constexpr size_t MiB = 1u << 20;
constexpr size_t U37 = (size_t)MP * D * 2;
constexpr size_t WS_CTL = 0, CTL_ZERO_BYTES = 1 * MiB;
constexpr size_t WS_WIN = 1 * MiB;
constexpr size_t WS_WOUT = WS_WIN + 24 * MiB;
constexpr size_t WS_WR = WS_WOUT + 8 * MiB, WS_WK = WS_WR + 8 * MiB, WS_WV = WS_WK + 8 * MiB, WS_WO = WS_WV + 8 * MiB;
constexpr size_t WS_L1 = WS_WO + 8 * MiB;
constexpr size_t WS_L2 = WS_L1 + 3 * MiB;
constexpr size_t WS_WUP = WS_L2 + 3 * MiB;
constexpr size_t WS_WDN = WS_WUP + 32 * MiB;
constexpr size_t WS_ZRES = WS_WDN + 32 * MiB;
constexpr size_t WS_HA = WS_ZRES + U37, WS_HB = WS_HA + U37;
constexpr size_t WS_GATES = WS_HB + U37;
constexpr size_t WS_BIG = WS_GATES + 1 * MiB;
constexpr size_t WS_X0 = WS_BIG, WS_ZIN = WS_X0 + U37, WS_HM = WS_ZIN + (size_t)MP * NZ * 2, WS_CAT = WS_HM + (size_t)MP * MIXA * 2;
constexpr size_t WS_U = WS_BIG;
constexpr size_t WS_XS = WS_BIG;
constexpr size_t WS_RKV = WS_XS + 6 * U37;
constexpr size_t WS_LO1 = WS_RKV + 3 * U37;
constexpr size_t WS_WDEC = WS_XS;
constexpr size_t WS_AG = WS_WDEC + 2 * U37;
constexpr size_t WS_GG = WS_AG + U37;
constexpr size_t WS_YCAT = WS_GG + U37;
constexpr size_t WS_END = WS_LO1 + 3 * (size_t)MP * 256 * 2;
constexpr size_t WS_SLAB = WS_RKV;
static_assert(240 * (size_t)262144 <= 3 * U37, "slab overlay");
static_assert(WS_YCAT + U37 <= WS_RKV, "overlay");
static_assert(WS_CAT + U37 <= WS_END && WS_U + (size_t)MP * DFF * 2 <= WS_END, "big region");

constexpr int CW_BAR = 4096;
constexpr int CW_SPLIT = 16384;
constexpr int CW_PROG = 24576;

__device__ __forceinline__ unsigned f2bf(float f) { unsigned u = __builtin_bit_cast(unsigned, f); return (u + 0x7fffu + ((u >> 16) & 1u)) >> 16; }
__device__ __forceinline__ unsigned pk2(float lo, float hi) { return f2bf(lo) | (f2bf(hi) << 16); }
__device__ __forceinline__ float bf2f(unsigned short b) { return __builtin_bit_cast(float, (unsigned)b << 16); }
__device__ __forceinline__ float bflo(unsigned w) { return __builtin_bit_cast(float, w << 16); }
__device__ __forceinline__ float bfhi(unsigned w) { return __builtin_bit_cast(float, w & 0xffff0000u); }
typedef __bf16 bf16x2_hw __attribute__((ext_vector_type(2)));
__device__ __forceinline__ unsigned cvt_pk_bf16(float lo, float hi) { const f32x2 v = {lo, hi}; const bf16x2_hw b = __builtin_convertvector(v, bf16x2_hw); return __builtin_bit_cast(unsigned, b); }
__device__ __forceinline__ void lds_barrier() { asm volatile("s_waitcnt lgkmcnt(0)" ::: "memory"); __builtin_amdgcn_s_barrier(); asm volatile("" ::: "memory"); }
__device__ __forceinline__ float wave_sum(float v) {
#pragma unroll
    for (int o = 1; o < 64; o <<= 1) v += __shfl_xor(v, o);
    return v;
}
__device__ __forceinline__ float sigmoidf_(float x) { return __builtin_amdgcn_rcpf(1.0f + __expf(-x)); }
__device__ __forceinline__ float softplusf_(float x) { return fmaxf(x, 0.f) + __logf(1.0f + __expf(-fabsf(x))); }
__device__ __forceinline__ float sigm3_(float x) { return __builtin_amdgcn_rcpf(1.0f + __expf(-x)); }
__device__ __forceinline__ float wdecayf_(float x) { return __expf(-0.6065306597126334f * sigm3_(x)); }
__device__ __forceinline__ float tanhf_(float x) { const float e = __expf(2.0f * x); return 1.0f - 2.0f * __builtin_amdgcn_rcpf(e + 1.0f); }
#define LDS_WAIT() asm volatile("s_waitcnt lgkmcnt(0)" ::: "memory")
#define VM_WAIT() asm volatile("s_waitcnt vmcnt(0)" ::: "memory")

#define XB_TMO      128
#define XB_XCNT(j)  (256  + 64 * (j))
#define XB_XSUB(j)  (1280 + 64 * (j))
#define XB_XGEN(j)  (2304 + 64 * (j))
#define XB_TOP      3328
#define XB_TOPGEN   3392
#define XCD_BAR_WORDS 3456
#define XB_SPIN_CAP (1u << 18)
__device__ __forceinline__ unsigned xb_ld(unsigned* p)              { return __hip_atomic_load(p, __ATOMIC_RELAXED, __HIP_MEMORY_SCOPE_AGENT); }
__device__ __forceinline__ unsigned xb_add(unsigned* p, unsigned v) { return __hip_atomic_fetch_add(p, v, __ATOMIC_RELAXED, __HIP_MEMORY_SCOPE_AGENT); }
__device__ __forceinline__ unsigned xb_xcc_id() { return (unsigned)__builtin_amdgcn_s_getreg((3 << 11) | 20) & 0xFu; }
#define XB_SPIN(cond, bar) do { unsigned _sp = 0; while (cond) { __builtin_amdgcn_s_sleep(1); \
    if ((++_sp & 255u) == 0u) { if (xb_ld(&(bar)[XB_TMO])) break; if (_sp > XB_SPIN_CAP) { atomicAdd(&(bar)[XB_TMO], 1u); break; } } } } while (0)
struct XcdBarrier { unsigned* bar; unsigned x; volatile LAS unsigned* st; };
__device__ __forceinline__ XcdBarrier xcd_barrier_post(unsigned* bar, volatile LAS unsigned* st) {
    XcdBarrier b; b.bar = bar; b.x = xb_xcc_id(); b.st = st;
    if (threadIdx.x == 0) (void)xb_add(&bar[XB_XCNT(b.x)], 1u);
    return b;
}
__device__ __forceinline__ void xcd_barrier_complete(unsigned* bar, unsigned x, unsigned& nloc, unsigned& nx) {
    const unsigned G = gridDim.x * gridDim.y * gridDim.z;
    unsigned sum, cnt, mine, sp = 0u;
    for (;;) {
        sum = 0u; cnt = 0u; mine = 0u;
#pragma unroll
        for (unsigned j = 0; j < 16; ++j) { const unsigned c = xb_ld(&bar[XB_XCNT(j)]); sum += c; cnt += (c > 0u) ? 1u : 0u; mine = (j == x) ? c : mine; }
        if (sum == G) break;
        __builtin_amdgcn_s_sleep(1);
        if ((++sp & 255u) == 0u) { if (xb_ld(&bar[XB_TMO])) break; if (sp > XB_SPIN_CAP) { atomicAdd(&bar[XB_TMO], 1u); break; } }
    }
    nloc = mine > 0u ? mine : 1u; nx = cnt > 0u ? cnt : 1u;
}
__device__ __forceinline__ void xcd_barrier(const XcdBarrier& b) {
    asm volatile("s_waitcnt vmcnt(0)" ::: "memory");
    __syncthreads();
    if (threadIdx.x == 0) {
        unsigned* bar = b.bar;
        __builtin_amdgcn_s_waitcnt(0);
        unsigned nloc = b.st[0], nx = b.st[1];
        if (nloc == 0u) { xcd_barrier_complete(bar, b.x, nloc, nx); b.st[0] = nloc; b.st[1] = nx; }
        const unsigned old = xb_add(&bar[XB_XSUB(b.x)], 1u);
        const unsigned gen = old / nloc;
        if (old + 1u == (gen + 1u) * nloc) {
            __builtin_amdgcn_fence(__ATOMIC_RELEASE, "agent");
            asm volatile("s_waitcnt vmcnt(0)" ::: "memory");
            const unsigned og = xb_add(&bar[XB_TOP], 1u);
            const unsigned tg = og / nx;
            if (og + 1u == (tg + 1u) * nx) xb_add(&bar[XB_TOPGEN], 1u);
            else XB_SPIN(xb_ld(&bar[XB_TOPGEN]) == tg, bar);
            __builtin_amdgcn_fence(__ATOMIC_ACQUIRE, "agent");
            xb_add(&bar[XB_XGEN(b.x)], 1u);
            asm volatile("s_waitcnt vmcnt(0)" ::: "memory");
        } else {
            XB_SPIN(xb_ld(&bar[XB_XGEN(b.x)]) == gen, bar);
            __builtin_amdgcn_fence(__ATOMIC_ACQUIRE, "agent");
            asm volatile("s_waitcnt vmcnt(0)" ::: "memory");
        }
    }
    __syncthreads();
}

namespace pg8 {
constexpr int BM = 256, BK = 64, HALF = 128, HTB = HALF * BK * 2, STAGE_BYTES = 8 * HTB, NXCD = 8, WGM = 8;
__host__ __device__ __forceinline__ int lds_byte(int r, int c) { const int st = (r >> 4) * 2 + (c >> 5), rr = r & 15, cc = c & 31, ob = rr * 64 + cc * 2; return st * 1024 + (ob ^ (((ob >> 9) & 1) << 5)); }
__host__ __device__ __forceinline__ void stage_rc(int b, int& R, int& C) { const int st = b / 1024, sb = b % 1024, swz = sb ^ (((sb >> 9) & 1) << 5); R = (st >> 1) * 16 + swz / 64; C = (st & 1) * 32 + (swz % 64) / 2; }
__host__ __device__ __forceinline__ int perm32(int rho) { const int n = rho >> 4, i = rho & 15; return 8 * (i >> 2) + 4 * n + (i & 3); }

struct Unit { int pm, pn, job, split, kpart, tail; };
enum { EM_BF16 = 0, EM_RELU2 = 1, EM_TANH = 2, EM_SIGM = 3, EM_RESID = 4, EM_WDEC = 5, EM_ASIG = 6 };
struct JobC { unsigned A, B, out, aux; int nN, ldc, mode, pad; };
struct PhaseC { int njobs, K, lda, totN, split, pad0, pad1, pad2; JobC job[6]; };
__constant__ int c_plist[2][32] = {
    {33, 34, 35, 36, 0, 25, 17, 9, 1, 26, 18, 10, 2, 27, 19, 11, 0, 0, 0, 0, 0, 0, 0, 0, 0, 0, 0, 0, 0, 0, 0, 0},
    {3, 28, 20, 12, 4, 29, 21, 13, 5, 30, 22, 14, 6, 7, 8, 15, 16, 23, 24, 31, 32, 0, 0, 0, 0, 0, 0, 0, 0, 0, 0, 0}};
constexpr int N_EARLY = 16, N_LATE = 21;
static_assert(N_EARLY + N_LATE == MP / 256, "panel lists");
struct Order {
    int nwg, G, c;
    __device__ __forceinline__ void init(int nM, int totN, int G_, int c_) { nwg = nM * totN; G = G_; c = c_; }
    __device__ __forceinline__ bool next(const PhaseC& P, int i, Unit& u) const {
        long L = (long)i * G + c;
        const int nfull = (nwg / G) * G, sp = P.split;
        if (L >= nwg && !(sp > 1 && L >= nfull)) return false;
        u.split = 1; u.kpart = 0; u.tail = 0;
        if (sp > 1 && L >= nfull) { const int j = (int)(L - nfull); if (j >= (nwg - nfull) * sp) return false; u.split = sp; u.kpart = j % sp; u.tail = j / sp; L = nfull + j / sp; }
        if (P.pad0) { u.pm = c_plist[P.pad0 - 1][(int)L / P.totN]; u.pn = (int)L % P.totN; u.job = 0; return true; }
        int wgid = (int)L; { const int q = nwg / NXCD, r = nwg % NXCD, xcd = wgid % NXCD, off = wgid / NXCD; wgid = (xcd < r ? xcd * (q + 1) : r * (q + 1) + (xcd - r) * q) + off; }
        const int nM = MP / BM, nN = P.totN;
        const int nig = WGM * nN, gid = wgid / nig, fm = gid * WGM, gsz = (nM - fm) < WGM ? (nM - fm) : WGM;
        u.pm = fm + ((wgid % nig) % gsz); int pnv = (wgid % nig) / gsz; int job = 0;
        while (pnv >= P.job[job].nN) { pnv -= P.job[job].nN; ++job; }
        u.pn = pnv; u.job = job; return true;
    }
};

template <int MODE>
__device__ __forceinline__ void epilogue_mode(const f32x4 (&acc)[2][2][4][2], char* outp, const void* aux, int ldc, int row0, int col0) {
#pragma unroll
    for (int ai = 0; ai < 2; ++ai)
#pragma unroll
        for (int m = 0; m < 4; ++m) {
            const int row = row0 + ai * HALF + m * 16;
#pragma unroll
            for (int bj = 0; bj < 2; ++bj) {
                const int col = col0 + bj * HALF;
                f32x4 v0 = acc[ai][bj][m][0], v1 = acc[ai][bj][m][1];
                if (MODE == EM_WDEC) {
                    const float* w0 = (const float*)aux; const f32x4 b0 = *(const f32x4*)(w0 + col), b1 = *(const f32x4*)(w0 + col + 4);
#pragma unroll
                    for (int j = 0; j < 4; ++j) { v0[j] = wdecayf_(v0[j] + b0[j]); v1[j] = wdecayf_(v1[j] + b1[j]); }
                    float* o = (float*)outp + (size_t)row * ldc + col; *(f32x4*)o = v0; *(f32x4*)(o + 4) = v1;
                } else {
                    if (MODE == EM_RELU2) {
#pragma unroll
                        for (int j = 0; j < 4; ++j) {
                            const float a0 = v0[j], a1 = v1[j]; int i0 = __builtin_bit_cast(int, a0), i1 = __builtin_bit_cast(int, a1); i0 = i0 > 0 ? i0 : 0; i1 = i1 > 0 ? i1 : 0;
                            const float x0 = __builtin_bit_cast(float, i0), x1 = __builtin_bit_cast(float, i1); v0[j] = x0 * x0; v1[j] = x1 * x1; }
                    } else if (MODE == EM_TANH) {
#pragma unroll
                        for (int j = 0; j < 4; ++j) { v0[j] = tanhf_(v0[j]); v1[j] = tanhf_(v1[j]); }
                    } else if (MODE == EM_SIGM) {
#pragma unroll
                        for (int j = 0; j < 4; ++j) { v0[j] = sigmoidf_(v0[j]); v1[j] = sigmoidf_(v1[j]); }
                    } else if (MODE == EM_ASIG) {
                        const float* a0 = (const float*)aux; const f32x4 b0 = *(const f32x4*)(a0 + col), b1 = *(const f32x4*)(a0 + col + 4);
#pragma unroll
                        for (int j = 0; j < 4; ++j) { v0[j] = sigm3_(v0[j] + b0[j]); v1[j] = sigm3_(v1[j] + b1[j]); }
                    } else if (MODE == EM_RESID) {
                        const u32x4 r = *(const u32x4*)((const bf16_t*)aux + (size_t)row * D + col);
                        v0[0] += ALPHA * bflo(r.x); v0[1] += ALPHA * bfhi(r.x); v0[2] += ALPHA * bflo(r.y); v0[3] += ALPHA * bfhi(r.y);
                        v1[0] += ALPHA * bflo(r.z); v1[1] += ALPHA * bfhi(r.z); v1[2] += ALPHA * bflo(r.w); v1[3] += ALPHA * bfhi(r.w);
                    }
                    u32x4 w; w.x = cvt_pk_bf16(v0[0], v0[1]); w.y = cvt_pk_bf16(v0[2], v0[3]); w.z = cvt_pk_bf16(v1[0], v1[1]); w.w = cvt_pk_bf16(v1[2], v1[3]);
                    *(u32x4*)((bf16_t*)outp + (size_t)row * ldc + col) = w;
                }
            }
        }
}
template <int MODE>
__device__ __forceinline__ void epi_frag(f32x4 v0, f32x4 v1, char* outp, const void* aux, int ldc, int row, int col) {
    if (MODE == EM_RESID) {
        const u32x4 r = *(const u32x4*)((const bf16_t*)aux + (size_t)row * D + col);
        v0[0] += ALPHA * bflo(r.x); v0[1] += ALPHA * bfhi(r.x); v0[2] += ALPHA * bflo(r.y); v0[3] += ALPHA * bfhi(r.y);
        v1[0] += ALPHA * bflo(r.z); v1[1] += ALPHA * bfhi(r.z); v1[2] += ALPHA * bflo(r.w); v1[3] += ALPHA * bfhi(r.w);
    }
    u32x4 w; w.x = cvt_pk_bf16(v0[0], v0[1]); w.y = cvt_pk_bf16(v0[2], v0[3]); w.z = cvt_pk_bf16(v1[0], v1[1]); w.w = cvt_pk_bf16(v1[2], v1[3]);
    *(u32x4*)((bf16_t*)outp + (size_t)row * ldc + col) = w;
}
template <unsigned MM>
__device__ __forceinline__ void epilogue(const f32x4 (&acc)[2][2][4][2], const Unit& u, const PhaseC& P, unsigned char* ws, const float* w0p, const float* a0p, int wr, int wc, int fr, int fq) {
    const int mode = P.job[u.job].mode, ldc = P.job[u.job].ldc;
    char* outp = (char*)ws + P.job[u.job].out; const void* aux = (mode == EM_WDEC) ? (const void*)w0p : (mode == EM_ASIG) ? (const void*)a0p : (const void*)(ws + P.job[u.job].aux);
    const int row0 = u.pm * BM + wr * 64 + fr, col0 = u.pn * BM + wc * 32 + 8 * fq;
    if ((MM & (1u << EM_WDEC)) && mode == EM_WDEC) epilogue_mode<EM_WDEC>(acc, outp, aux, ldc, row0, col0);
    else if ((MM & (1u << EM_RELU2)) && mode == EM_RELU2) epilogue_mode<EM_RELU2>(acc, outp, aux, ldc, row0, col0);
    else if ((MM & (1u << EM_TANH)) && mode == EM_TANH) epilogue_mode<EM_TANH>(acc, outp, aux, ldc, row0, col0);
    else if ((MM & (1u << EM_SIGM)) && mode == EM_SIGM) epilogue_mode<EM_SIGM>(acc, outp, aux, ldc, row0, col0);
    else if ((MM & (1u << EM_ASIG)) && mode == EM_ASIG) epilogue_mode<EM_ASIG>(acc, outp, aux, ldc, row0, col0);
    else if ((MM & (1u << EM_RESID)) && mode == EM_RESID) epilogue_mode<EM_RESID>(acc, outp, aux, ldc, row0, col0);
    else epilogue_mode<EM_BF16>(acc, outp, aux, ldc, row0, col0);
}

__device__ __forceinline__ void wait_panel(int pm, const unsigned* prog, int wid, int lane) {
    if (wid == 0) {
        unsigned spins = 0;
        if (pm >= 33) { while (__hip_atomic_load(prog + 256, __ATOMIC_RELAXED, __HIP_MEMORY_SCOPE_AGENT) < 128u && ++spins < (1u << 22)) __builtin_amdgcn_s_sleep(8); }
        else { const int b = (256 * pm) / TP; const unsigned need = (unsigned)(256 * pm + 256 - TP * b);
            for (;;) { const unsigned v = __hip_atomic_load(prog + b * 32 + (lane & 31), __ATOMIC_RELAXED, __HIP_MEMORY_SCOPE_AGENT);
                if (__all(v >= need) || ++spins >= (1u << 22)) break; __builtin_amdgcn_s_sleep(8); } }
        __builtin_amdgcn_fence(__ATOMIC_ACQUIRE, "agent"); asm volatile("s_waitcnt vmcnt(0)" ::: "memory");
    }
    asm volatile("s_waitcnt lgkmcnt(0)" ::: "memory"); __builtin_amdgcn_s_barrier(); asm volatile("" ::: "memory");
}
template <unsigned MM, int WAITA = 0>
__device__ __forceinline__ void gemm_phase(LAS unsigned char* lds, const PhaseC& P, unsigned char* ws, const float* w0p, const float* a0p, int G, int c, unsigned* cntw, volatile LAS unsigned* flagw, const unsigned* prog = nullptr) {
    const int tid = threadIdx.x, wid = __builtin_amdgcn_readfirstlane(tid >> 6), lane = tid & 63, wr = wid >> 2, wc = wid & 3, fr = lane & 15, fq = lane >> 4;
    const int K = P.K, nt = K / BK, lda = P.lda; const size_t kpartB = (size_t)(K / P.split) * 2;
    Order S; S.init(P.pad0 ? P.pad1 : MP / BM, P.totN, G, c);
    unsigned voffA[2], voffB[2];
#pragma unroll
    for (int i = 0; i < 2; ++i) { int R, C; stage_rc(tid * 16 + i * 8192, R, C); const int Rb = (R & ~31) + perm32(R & 31);
        voffA[i] = (unsigned)(R * lda + C) * 2u; voffB[i] = (unsigned)(Rb * K + C) * 2u; }
    const size_t kstep = (size_t)(BK * 2);
    const size_t hstepA = (size_t)HALF * lda * 2, hstepB = (size_t)HALF * K * 2;
    const size_t tstepA = 2 * hstepA, tstepB = 2 * hstepB;
    const unsigned ldsw = (unsigned)wid * 1024u;
    const int aoff = lds_byte(wr * 64 + fr, fq * 8), boff = lds_byte(wc * 32 + fr, fq * 8);
#define PG8_SA(b, h) (((b) * 2 + (h)) * HTB)
#define PG8_SB(b, h) ((4 + (b) * 2 + (h)) * HTB)
#define PG8_STAGE(bufoff, gbase, voff) do { _Pragma("unroll") for (int _i = 0; _i < 2; ++_i) \
        __builtin_amdgcn_global_load_lds((const unsigned*)((const char*)(gbase) + (voff)[_i]), (LAS unsigned*)(lds + (bufoff) + ldsw + _i * 8192), 16, 0, 0); } while (0)
#define PG8_LDA(dst, b, h) do { _Pragma("unroll") for (int m = 0; m < 4; ++m) _Pragma("unroll") for (int k = 0; k < 2; ++k) dst[m][k] = *(const LAS bf16x8*)(lds + PG8_SA(b, h) + aoff + m * 2048 + k * 1024); } while (0)
#define PG8_LDB(dst, b, h) do { _Pragma("unroll") for (int n = 0; n < 2; ++n) _Pragma("unroll") for (int k = 0; k < 2; ++k) dst[n][k] = *(const LAS bf16x8*)(lds + PG8_SB(b, h) + boff + n * 2048 + k * 1024); } while (0)
#define PG8_MMA(ai, bj, At, Bt) do { __builtin_amdgcn_s_setprio(1); _Pragma("unroll") for (int m = 0; m < 4; ++m) _Pragma("unroll") for (int n = 0; n < 2; ++n) _Pragma("unroll") for (int k = 0; k < 2; ++k) \
        acc[ai][bj][m][n] = __builtin_amdgcn_mfma_f32_16x16x32_bf16(Bt[n][k], At[m][k], acc[ai][bj][m][n], 0, 0, 0); __builtin_amdgcn_s_setprio(0); } while (0)
#define PG8_WAIT_V(n) asm volatile("s_waitcnt vmcnt(" #n ")" ::: "memory")
#define PG8_WAIT_L(n) asm volatile("s_waitcnt lgkmcnt(" #n ")" ::: "memory")
#define PG8_BAR __builtin_amdgcn_s_barrier()
#define PG8_SCHED __builtin_amdgcn_sched_barrier(0)
    Unit cur, nxt; int ui = 0;
    if (!S.next(P, 0, cur)) return;
    if (WAITA) wait_panel(cur.pm, prog, wid, lane);
    f32x4 acc[2][2][4][2];
#pragma unroll
    for (int a = 0; a < 2; ++a)
#pragma unroll
        for (int b = 0; b < 2; ++b)
#pragma unroll
            for (int m = 0; m < 4; ++m)
#pragma unroll
                for (int n = 0; n < 2; ++n) acc[a][b][m][n] = (f32x4){0.f, 0.f, 0.f, 0.f};
    bf16x8 At[4][2], B0[2][2], B1[2][2];
    const char* cA = (const char*)ws + P.job[cur.job].A + (size_t)cur.pm * tstepA + cur.kpart * kpartB; const char* cB = (const char*)ws + P.job[cur.job].B + (size_t)cur.pn * tstepB + cur.kpart * kpartB;
    PG8_STAGE(PG8_SB(0, 0), cB, voffB); PG8_STAGE(PG8_SB(0, 1), cB + hstepB, voffB); PG8_STAGE(PG8_SA(0, 0), cA, voffA); PG8_STAGE(PG8_SA(0, 1), cA + hstepA, voffA);
    if (wr == 1) PG8_BAR;
    PG8_WAIT_V(2); PG8_BAR;
    PG8_STAGE(PG8_SB(1, 0), cB + kstep, voffB); PG8_STAGE(PG8_SA(1, 0), cA + kstep, voffA); PG8_STAGE(PG8_SB(1, 1), cB + hstepB + kstep, voffB);
    PG8_WAIT_V(6); PG8_BAR;
    for (;;) {
        const bool has_next = S.next(P, ui + 1, nxt);
        if (WAITA && has_next) wait_panel(nxt.pm, prog, wid, lane);
        const char* nA = has_next ? (const char*)ws + P.job[nxt.job].A + (size_t)nxt.pm * tstepA + nxt.kpart * kpartB : cA; const char* nB = has_next ? (const char*)ws + P.job[nxt.job].B + (size_t)nxt.pn * tstepB + nxt.kpart * kpartB : cB;
        const int ntc = nt / cur.split;
        for (int t = 0; t < ntc; t += 2) {
            const bool last = (t == ntc - 2);
            const char* a1 = cA + (size_t)(t + 1) * kstep;
            const char* a2 = last ? nA : cA + (size_t)(t + 2) * kstep; const char* b2 = last ? nB : cB + (size_t)(t + 2) * kstep;
            const char* a3 = a2 + kstep; const char* b3 = b2 + kstep;
            PG8_LDB(B0, 0, 0); PG8_LDB(B1, 0, 1); PG8_SCHED; PG8_LDA(At, 0, 0); PG8_STAGE(PG8_SA(1, 1), a1 + hstepA, voffA);
            PG8_WAIT_V(8); PG8_WAIT_L(0); PG8_BAR; PG8_MMA(0, 0, At, B0); PG8_MMA(0, 1, At, B1); PG8_BAR; PG8_SCHED;
            PG8_LDA(At, 0, 1); PG8_STAGE(PG8_SB(0, 0), b2, voffB); PG8_STAGE(PG8_SB(0, 1), b2 + hstepB, voffB); PG8_STAGE(PG8_SA(0, 0), a2, voffA);
            PG8_WAIT_V(8); PG8_WAIT_L(0); PG8_BAR; PG8_MMA(1, 0, At, B0); PG8_MMA(1, 1, At, B1); PG8_BAR; PG8_SCHED;
            PG8_LDB(B0, 1, 0); PG8_LDB(B1, 1, 1); PG8_SCHED; PG8_LDA(At, 1, 0); PG8_STAGE(PG8_SA(0, 1), a2 + hstepA, voffA);
            PG8_WAIT_V(8); PG8_WAIT_L(0); PG8_BAR; PG8_MMA(0, 0, At, B0); PG8_MMA(0, 1, At, B1); PG8_BAR; PG8_SCHED;
            PG8_LDA(At, 1, 1); PG8_STAGE(PG8_SB(1, 0), b3, voffB); PG8_STAGE(PG8_SB(1, 1), b3 + hstepB, voffB); PG8_STAGE(PG8_SA(1, 0), a3, voffA);
            PG8_WAIT_V(8); PG8_WAIT_L(0); PG8_BAR; PG8_MMA(1, 0, At, B0); PG8_MMA(1, 1, At, B1); PG8_BAR; PG8_SCHED;
        }
        if (wr == 0) PG8_BAR;
        if (cur.split > 1) {
            {
                asm volatile("s_nop 15\n\ts_nop 7" ::: "memory");
                f32x4* sp_ = (f32x4*)(ws + WS_SLAB) + (size_t)(cur.tail * cur.split + cur.kpart) * (32 * NTHREADS) + tid;
#pragma unroll
                for (int a = 0; a < 2; ++a)
#pragma unroll
                    for (int b = 0; b < 2; ++b)
#pragma unroll
                        for (int m = 0; m < 4; ++m)
#pragma unroll
                            for (int n = 0; n < 2; ++n) { asm volatile("global_store_dwordx4 %0, %1, off sc1\n\ts_nop 1" :: "v"(sp_), "v"(acc[a][b][m][n]) : "memory"); sp_ += NTHREADS; asm volatile("" : "+v"(sp_)); }
            }
            asm volatile("s_waitcnt vmcnt(0)" ::: "memory");
            PG8_BAR;
            if (tid == 0) {
                __hip_atomic_fetch_add(cntw + cur.tail, 1u, __ATOMIC_RELAXED, __HIP_MEMORY_SCOPE_AGENT);
                unsigned spins = 0;
                while (__hip_atomic_load(cntw + cur.tail, __ATOMIC_RELAXED, __HIP_MEMORY_SCOPE_AGENT) < (unsigned)cur.split && ++spins < (1u << 22)) __builtin_amdgcn_s_sleep(1);
                __builtin_amdgcn_fence(__ATOMIC_ACQUIRE, "agent"); asm volatile("s_waitcnt vmcnt(0)" ::: "memory");
            }
            asm volatile("" ::: "memory"); PG8_BAR; asm volatile("" ::: "memory");
            {
                const int nreg = 32 / cur.split, i0 = cur.kpart * nreg;
                f32x4 red[16];
#pragma unroll
                for (int r = 0; r < 16; ++r) red[r] = (f32x4){0.f, 0.f, 0.f, 0.f};
                for (int p = 0; p < cur.split; ++p) {
                    const f32x4* sl = (const f32x4*)(ws + WS_SLAB) + (size_t)(cur.tail * cur.split + p) * (32 * NTHREADS) + (size_t)i0 * NTHREADS + tid;
#pragma unroll
                    for (int r = 0; r < 16; ++r) { if (r < nreg) red[r] += *sl; sl += NTHREADS; }
                    asm volatile("" : "+v"(sl));
                }
                const int mode = P.job[cur.job].mode, ldc = P.job[cur.job].ldc;
                char* outp = (char*)ws + P.job[cur.job].out; const void* aux = (const void*)(ws + P.job[cur.job].aux);
                const int row0 = cur.pm * BM + wr * 64 + fr, col0 = cur.pn * BM + wc * 32 + 8 * fq;
#pragma unroll
                for (int pr = 0; pr < 8; ++pr) if (2 * pr < nreg) {
                    const int g = (i0 >> 1) + pr, ai = g >> 3, bj = (g >> 2) & 1, m = g & 3;
                    const int row = row0 + ai * HALF + m * 16, col = col0 + bj * HALF;
                    if ((MM & (1u << EM_RESID)) && mode == EM_RESID) epi_frag<EM_RESID>(red[2 * pr], red[2 * pr + 1], outp, aux, ldc, row, col);
                    else epi_frag<EM_BF16>(red[2 * pr], red[2 * pr + 1], outp, aux, ldc, row, col);
                }
            }
            PG8_BAR;
        } else
        epilogue<MM>(acc, cur, P, ws, w0p, a0p, wr, wc, fr, fq);
        if (!has_next) break;
#pragma unroll
        for (int a = 0; a < 2; ++a)
#pragma unroll
            for (int b = 0; b < 2; ++b)
#pragma unroll
                for (int m = 0; m < 4; ++m)
#pragma unroll
                    for (int n = 0; n < 2; ++n) acc[a][b][m][n] = (f32x4){0.f, 0.f, 0.f, 0.f};
        cur = nxt; cA = nA; cB = nB; ++ui;
        if (wr == 1) PG8_BAR;
    }
    PG8_WAIT_V(0);
    PG8_BAR;
#undef PG8_SA
#undef PG8_SB
#undef PG8_STAGE
#undef PG8_LDA
#undef PG8_LDB
#undef PG8_MMA
#undef PG8_WAIT_V
#undef PG8_WAIT_L
#undef PG8_BAR
#undef PG8_SCHED
}
}


#define JOB(A, B, O, AUX, NN, LDC, MODE) {(unsigned)(A), (unsigned)(B), (unsigned)(O), (unsigned)(AUX), (NN), (LDC), (MODE), 0}
#define NOJOB {0u, 0u, 0u, 0u, 1 << 30, 0, 0, 0}
constexpr size_t LO1S = (size_t)MP * 256 * 2;
__constant__ pg8::PhaseC c_ph[8] = {
      {1, D, D, NZ / 256, 2, 0, 0, 0, {JOB(WS_X0, WS_WIN, WS_ZIN, 0, NZ / 256, NZ, pg8::EM_BF16), NOJOB, NOJOB, NOJOB, NOJOB, NOJOB}},
      {1, D, D, D / 256, 4, 0, 0, 0, {JOB(WS_CAT, WS_WOUT, WS_ZRES, WS_X0, D / 256, D, pg8::EM_RESID), NOJOB, NOJOB, NOJOB, NOJOB, NOJOB}},
      {1, D, D, DFF / 256, 1, 0, 0, 0, {JOB(WS_HA, WS_WUP, WS_U, 0, DFF / 256, DFF, pg8::EM_RELU2), NOJOB, NOJOB, NOJOB, NOJOB, NOJOB}},
      {1, DFF, DFF, D / 256, 4, 0, 0, 0, {JOB(WS_U, WS_WDN, WS_ZRES, WS_HA, D / 256, D, pg8::EM_RESID), NOJOB, NOJOB, NOJOB, NOJOB, NOJOB}},
      {6, D, D, 27, 1, 0, 0, 0, {JOB(WS_XS + 0 * U37, WS_WR, WS_RKV + 0 * U37, 0, 8, D, pg8::EM_BF16), JOB(WS_XS + 2 * U37, WS_WK, WS_RKV + 1 * U37, 0, 8, D, pg8::EM_BF16),
                                    JOB(WS_XS + 3 * U37, WS_WV, WS_RKV + 2 * U37, 0, 8, D, pg8::EM_BF16), JOB(WS_XS + 1 * U37, WS_L1, WS_LO1, 0, 1, 256, pg8::EM_TANH),
                                    JOB(WS_XS + 4 * U37, WS_L1 + 1 * MiB, WS_LO1 + LO1S, 0, 1, 256, pg8::EM_BF16), JOB(WS_XS + 5 * U37, WS_L1 + 2 * MiB, WS_LO1 + 2 * LO1S, 0, 1, 256, pg8::EM_SIGM)}},
      {3, 256, 256, 24, 1, 0, 0, 0, {JOB(WS_LO1, WS_L2, WS_WDEC, 0, 8, D, pg8::EM_WDEC), JOB(WS_LO1 + LO1S, WS_L2 + 1 * MiB, WS_AG, 0, 8, D, pg8::EM_ASIG),
                                      JOB(WS_LO1 + 2 * LO1S, WS_L2 + 2 * MiB, WS_GG, 0, 8, D, pg8::EM_BF16), NOJOB, NOJOB, NOJOB}},
      {1, D, D, D / 256, 1, 2, pg8::N_LATE, 0, {JOB(WS_YCAT, WS_WO, WS_ZRES, WS_HB, D / 256, D, pg8::EM_RESID), NOJOB, NOJOB, NOJOB, NOJOB, NOJOB}},
      {1, D, D, D / 256, 1, 1, pg8::N_EARLY, 0, {JOB(WS_YCAT, WS_WO, WS_ZRES, WS_HB, D / 256, D, pg8::EM_RESID), NOJOB, NOJOB, NOJOB, NOJOB, NOJOB}},
};
static_assert(WS_END < (1ull << 32), "ws offsets fit 32 bits");

constexpr int RING_BYTES = 157696;
constexpr int LDSCTL_OFF = RING_BYTES, MISC_OFF = LDSCTL_OFF + 64;
constexpr int LDS_BYTES = RING_BYTES + 512;

struct Args { const float* in[N_IN]; float* out; unsigned char* ws; int ph_lo, ph_hi; };
struct Frame {
    LAS unsigned char* lds;
    float* out; unsigned char* ws;
    int tid, lane, wave, G, gw, NGW;
};

__device__ __forceinline__ void transpose_item(const float* W, int ldw, int klim, int nsrc0, bf16_t* WT, int ldwt, int ndst0, float scale, LAS float* scr, int kb, int nb, int lane) {
    const int k0 = 64 * kb, n0 = 32 * nb;
#pragma unroll 8
    for (int i = 0; i < 32; ++i) { const int kk = 2 * i + (lane >> 5); const int k = k0 + kk;
        scr[kk * 33 + (lane & 31)] = (k < klim) ? W[(size_t)k * ldw + nsrc0 + n0 + (lane & 31)] * scale : 0.f; }
    LDS_WAIT(); asm volatile("" ::: "memory");
    const int c = lane & 7;
#pragma unroll
    for (int j = 0; j < 4; ++j) { const int n = (lane >> 3) + 8 * j; const LAS float* s = scr + (8 * c) * 33 + n;
        u32x4 o; o.x = pk2(s[0 * 33], s[1 * 33]); o.y = pk2(s[2 * 33], s[3 * 33]); o.z = pk2(s[4 * 33], s[5 * 33]); o.w = pk2(s[6 * 33], s[7 * 33]);
        *(GAS u32x4*)(WT + (size_t)(ndst0 + n0 + n) * ldwt + k0 + 8 * c) = o; }
    LDS_WAIT(); asm volatile("" ::: "memory");
}
__device__ __forceinline__ void transpose_item64(const float* W, int ldw, int nsrc0, bf16_t* WT, int ldwt, int ndst0, float scale, LAS float* scr, int kb, int nb, int lane) {
    const int k0 = 64 * kb, n0 = 64 * nb;
    f32x4 v[16];
#pragma unroll
    for (int i = 0; i < 16; ++i) { const int kk = 4 * i + (lane >> 4); v[i] = *(const GAS f32x4*)(W + (size_t)(k0 + kk) * ldw + nsrc0 + n0 + 4 * (lane & 15)); }
#pragma unroll
    for (int i = 0; i < 16; ++i) { const int kk = 4 * i + (lane >> 4); LAS float* d = scr + kk * 65 + 4 * (lane & 15); d[0] = v[i][0] * scale; d[1] = v[i][1] * scale; d[2] = v[i][2] * scale; d[3] = v[i][3] * scale; }
    LDS_WAIT(); asm volatile("" ::: "memory");
    const int c = lane & 7;
#pragma unroll
    for (int j = 0; j < 8; ++j) { const int n = (lane >> 3) + 8 * j; const LAS float* sp = scr + (8 * c) * 65 + n;
        u32x4 o; o.x = pk2(sp[0 * 65], sp[1 * 65]); o.y = pk2(sp[2 * 65], sp[3 * 65]); o.z = pk2(sp[4 * 65], sp[5 * 65]); o.w = pk2(sp[6 * 65], sp[7 * 65]);
        *(GAS u32x4*)(WT + (size_t)(ndst0 + n0 + n) * ldwt + k0 + 8 * c) = o; }
    LDS_WAIT(); asm volatile("" ::: "memory");
}
__device__ __forceinline__ void convert_matrix64(Frame& F, int& cursor, const float* W, int ldw, int K, int nsrc0, int N, bf16_t* WT, int ldwt, int ndst0, float scale, LAS float* scr) {
    const int nblk = N / 64, kblk = K / 64, items = nblk * kblk;
    int first = (F.gw - cursor % F.NGW + F.NGW) % F.NGW;
    for (int it = first; it < items; it += F.NGW) transpose_item64(W, ldw, nsrc0, WT, ldwt, ndst0, scale, scr, it / nblk, it % nblk, F.lane);
    cursor += items;
}
__device__ __forceinline__ void convert_matrix(Frame& F, int& cursor, const float* W, int ldw, int Ksrc, int Kdst, int nsrc0, int N, bf16_t* WT, int ldwt, int ndst0, float scale, LAS float* scr) {
    const int nblk = N / 32, kblk = Kdst / 64, items = nblk * kblk;
    int first = (F.gw - cursor % F.NGW + F.NGW) % F.NGW;
    for (int it = first; it < items; it += F.NGW) transpose_item(W, ldw, Ksrc, nsrc0, WT, ldwt, ndst0, scale, scr, it / nblk, it % nblk, F.lane);
    cursor += items;
}
__device__ __forceinline__ void convert_wup(Frame& F, const Args& args, int layer, int& cursor, LAS float* scr) {
    convert_matrix64(F, cursor, args.in[I_WUP] + (size_t)layer * D * DFF, DFF, D, 0, DFF, (bf16_t*)(F.ws + WS_WUP), D, 0, 1.f, scr);
}
__device__ __forceinline__ void convert_wdn(Frame& F, const Args& args, int layer, int& cursor, LAS float* scr) {
    convert_matrix64(F, cursor, args.in[I_WDN] + (size_t)layer * DFF * D, D, DFF, 0, D, (bf16_t*)(F.ws + WS_WDN), DFF, 0, 1.f, scr);
}
__device__ __forceinline__ void convert_mlp_weights(Frame& F, const Args& args, int layer, int& cursor, LAS float* scr) {
    convert_wup(F, args, layer, cursor, scr); convert_wdn(F, args, layer, cursor, scr);
}
__device__ __forceinline__ void p0_prologue(Frame& F, const Args& args) {
    LAS float* scr = (LAS float*)(F.lds + F.wave * 16896);
    int cursor = 0;
    const float* win = args.in[I_WIN];
    convert_matrix64(F, cursor, win, PROJ, D, 0, 1024, (bf16_t*)(F.ws + WS_WIN), D, 0, 1.f, scr);
    convert_matrix64(F, cursor, win, PROJ, D, 1024, 1024, (bf16_t*)(F.ws + WS_WIN), D, 1024, 0.0625f, scr);
    convert_matrix64(F, cursor, win, PROJ, D, 2048, 2048, (bf16_t*)(F.ws + WS_WIN), D, 2048, 1.f, scr);
    convert_matrix64(F, cursor, win, PROJ, D, 4104, 2048, (bf16_t*)(F.ws + WS_WIN), D, 4096, 1.f, scr);
    convert_matrix64(F, cursor, args.in[I_WOUT], D, D, 0, D, (bf16_t*)(F.ws + WS_WOUT), D, 0, 1.f, scr);
}
__device__ __forceinline__ void convert_rwkv_weights(Frame& F, const Args& args, LAS float* scr) {
    int cursor = 0;
    convert_matrix64(F, cursor, args.in[I_WR], D, D, 0, D, (bf16_t*)(F.ws + WS_WR), D, 0, 1.f, scr);
    convert_matrix64(F, cursor, args.in[I_WK], D, D, 0, D, (bf16_t*)(F.ws + WS_WK), D, 0, 1.f, scr);
    convert_matrix64(F, cursor, args.in[I_WV], D, D, 0, D, (bf16_t*)(F.ws + WS_WV), D, 0, 1.f, scr);
    convert_matrix64(F, cursor, args.in[I_WO], D, D, 0, D, (bf16_t*)(F.ws + WS_WO), D, 0, 1.f, scr);
    convert_matrix(F, cursor, args.in[I_W1], 96, D, D, 0, 96, (bf16_t*)(F.ws + WS_L1), D, 0, 1.f, scr);
    convert_matrix(F, cursor, args.in[I_A1], 96, D, D, 0, 96, (bf16_t*)(F.ws + WS_L1 + 1 * MiB), D, 0, 1.f, scr);
    convert_matrix(F, cursor, args.in[I_G1], 256, D, D, 0, 256, (bf16_t*)(F.ws + WS_L1 + 2 * MiB), D, 0, 1.f, scr);
    convert_matrix(F, cursor, args.in[I_W2], D, 96, 256, 0, D, (bf16_t*)(F.ws + WS_L2), 256, 0, 1.f, scr);
    convert_matrix(F, cursor, args.in[I_A2], D, 96, 256, 0, D, (bf16_t*)(F.ws + WS_L2 + 1 * MiB), 256, 0, 1.f, scr);
    convert_matrix(F, cursor, args.in[I_G2], D, 256, 256, 0, D, (bf16_t*)(F.ws + WS_L2 + 2 * MiB), 256, 0, 1.f, scr);
    for (int p = F.gw * 64 + F.lane; p < 2 * 40960; p += F.NGW * 64) { const int mtx = p / 40960, q = p % 40960;
        *(GAS u32x4*)(F.ws + WS_L1 + (size_t)mtx * MiB + (size_t)96 * D * 2 + (size_t)q * 16) = (u32x4){0u, 0u, 0u, 0u}; }
}
__device__ __forceinline__ int balanced_row(const Frame& F, int it) {
    const int full = (M / F.NGW) * F.NGW;
    if ((it + 1) * F.NGW <= full) return it * F.NGW + F.gw;
    if (it * F.NGW != full) return M;
    const int r2 = F.wave * F.G + F.gw / NWAVES;
    return (full + r2 < M) ? full + r2 : M;
}
__device__ __forceinline__ void p0_rows(Frame& F, const Args& args) {
    LAS f32x4* Glo = (LAS f32x4*)(F.lds); LAS f32x4* Ghi = (LAS f32x4*)(F.lds + 32768);
    const float* win = args.in[I_WIN];
    for (int k = F.tid; k < D; k += NTHREADS) { const f32x4 a = *(const f32x4*)(win + (size_t)k * PROJ + 4096), b = *(const f32x4*)(win + (size_t)k * PROJ + 4100);
        const int l = (k & 255) >> 2, c = k & 3, j = k >> 8, p = (4 * j + c) * 64 + l; Glo[p] = a; Ghi[p] = b; }
    __syncthreads();
    const float* bif = args.in[I_BIF];
    for (int it_ = 0, row = F.gw; row < M; ++it_, row = balanced_row(F, it_)) {
        const float* src;
        if (row < MPR) { const int b = row / TP, t = row % TP; src = (t < NMETA) ? args.in[I_META] + (size_t)t * D : args.in[I_XP] + ((size_t)b * SEQ + (t - NMETA)) * D; }
        else src = args.in[I_XS] + (size_t)(row - MPR) * D;
        f32x4 v[8]; float g[8];
#pragma unroll
        for (int j = 0; j < 8; ++j) v[j] = *(const GAS f32x4*)(src + 4 * F.lane + 256 * j);
#pragma unroll
        for (int q = 0; q < 8; ++q) g[q] = 0.f;
        GAS u32x2* o8 = (GAS u32x2*)(F.ws + WS_X0 + (size_t)row * D * 2) + F.lane;
#pragma unroll
        for (int j = 0; j < 8; ++j) {
            o8[64 * j] = (u32x2){pk2(v[j][0], v[j][1]), pk2(v[j][2], v[j][3])};
#pragma unroll
            for (int c = 0; c < 4; ++c) { const int p = (4 * j + c) * 64 + F.lane; const f32x4 a = Glo[p], b = Ghi[p]; const float x = v[j][c];
                g[0] += x * a[0]; g[1] += x * a[1]; g[2] += x * a[2]; g[3] += x * a[3]; g[4] += x * b[0]; g[5] += x * b[1]; g[6] += x * b[2]; g[7] += x * b[3]; }
            asm volatile("" ::: "memory");
        }
#pragma unroll
        for (int q = 0; q < 8; ++q) g[q] = wave_sum(g[q]);
        if (F.lane == 0) { float* go = (float*)(F.ws + WS_GATES) + (size_t)row * 8;
#pragma unroll
            for (int q = 0; q < 8; ++q) go[q] = g[q] + bif[q]; }
    }
}


__device__ __forceinline__ void unpack8(const u32x4 w, float (&x)[8]) { x[0] = bflo(w.x); x[1] = bfhi(w.x); x[2] = bflo(w.y); x[3] = bfhi(w.y); x[4] = bflo(w.z); x[5] = bfhi(w.z); x[6] = bflo(w.w); x[7] = bfhi(w.w); }
__device__ __forceinline__ u32x4 pack8(const float (&x)[8]) { u32x4 w; w.x = pk2(x[0], x[1]); w.y = pk2(x[2], x[3]); w.z = pk2(x[4], x[5]); w.w = pk2(x[6], x[7]); return w; }
__device__ __forceinline__ void ln_row_load_norm(const bf16_t* zrow, int lane, float (&x)[4][8]) {
    float s = 0.f;
#pragma unroll
    for (int j = 0; j < 4; ++j) { const u32x4 w = *(const GAS u32x4*)(zrow + 8 * lane + 512 * j); unpack8(w, x[j]);
#pragma unroll
        for (int e = 0; e < 8; ++e) s += x[j][e]; }
    const float mean = wave_sum(s) * (1.f / D); float s2 = 0.f;
#pragma unroll
    for (int j = 0; j < 4; ++j)
#pragma unroll
        for (int e = 0; e < 8; ++e) { x[j][e] -= mean; s2 += x[j][e] * x[j][e]; }
    const float rstd = 1.0f / sqrtf(wave_sum(s2) * (1.f / D) + LN_EPS);
#pragma unroll
    for (int j = 0; j < 4; ++j)
#pragma unroll
        for (int e = 0; e < 8; ++e) x[j][e] *= rstd;
}
__device__ __forceinline__ void stage_lds(LAS float* dst, const float* src, int n, int tid) {
    for (int i = tid * 4; i < n; i += NTHREADS * 4) *(LAS f32x4*)(dst + i) = *(const GAS f32x4*)(src + i);
}
__device__ __forceinline__ void ln_affine(const LAS float* gl, int lane, float (&x)[4][8]) {
#pragma unroll
    for (int j = 0; j < 4; ++j) { const int c = 8 * lane + 512 * j; const f32x4 g0 = *(const LAS f32x4*)(gl + c), g1 = *(const LAS f32x4*)(gl + c + 4), b0 = *(const LAS f32x4*)(gl + D + c), b1 = *(const LAS f32x4*)(gl + D + c + 4);
#pragma unroll
        for (int e = 0; e < 4; ++e) { x[j][e] = x[j][e] * g0[e] + b0[e]; x[j][4 + e] = x[j][4 + e] * g1[e] + b1[e]; } }
}
__device__ __forceinline__ void ln_pass(Frame& F, const bf16_t* z, const float* g, const float* b, bf16_t* out) {
    LAS float* gl = (LAS float*)F.lds; stage_lds(gl, g, D, F.tid); stage_lds(gl + D, b, D, F.tid); __syncthreads();
    for (int it_ = 0, row = F.gw; row < M; ++it_, row = balanced_row(F, it_)) {
        float x[4][8]; ln_row_load_norm(z + (size_t)row * D, F.lane, x); ln_affine(gl, F.lane, x);
#pragma unroll
        for (int j = 0; j < 4; ++j) *(GAS u32x4*)(out + (size_t)row * D + 8 * F.lane + 512 * j) = pack8(x[j]);
    }
}
__device__ __forceinline__ void ln_final(Frame& F, const bf16_t* z, const float* g, const float* b) {
    LAS float* gl = (LAS float*)F.lds; stage_lds(gl, g, D, F.tid); stage_lds(gl + D, b, D, F.tid); __syncthreads();
    for (int it_ = 0, row = F.gw; row < M; ++it_, row = balanced_row(F, it_)) {
        float* dst;
        if (row < MPR) { const int bb = row / TP, t = row % TP; if (t < NMETA) continue; dst = F.out + O_YP + ((size_t)bb * SEQ + (t - NMETA)) * D; }
        else dst = F.out + O_YS + (size_t)(row - MPR) * D;
        const bf16_t* zrow = z + (size_t)row * D;
        float x[8][4]; float s = 0.f;
#pragma unroll
        for (int j = 0; j < 8; ++j) { const u32x2 w = *(const GAS u32x2*)(zrow + 4 * F.lane + 256 * j); x[j][0] = bflo(w.x); x[j][1] = bfhi(w.x); x[j][2] = bflo(w.y); x[j][3] = bfhi(w.y);
            s += (x[j][0] + x[j][1]) + (x[j][2] + x[j][3]); }
        const float mean = wave_sum(s) * (1.f / D); float s2 = 0.f;
#pragma unroll
        for (int j = 0; j < 8; ++j)
#pragma unroll
            for (int e = 0; e < 4; ++e) { x[j][e] -= mean; s2 += x[j][e] * x[j][e]; }
        const float rstd = 1.0f / sqrtf(wave_sum(s2) * (1.f / D) + LN_EPS);
#pragma unroll
        for (int j = 0; j < 8; ++j) { const int c = 4 * F.lane + 256 * j; const f32x4 g0 = *(const LAS f32x4*)(gl + c), b0 = *(const LAS f32x4*)(gl + D + c);
            f32x4 o;
#pragma unroll
            for (int e = 0; e < 4; ++e) o[e] = x[j][e] * rstd * g0[e] + b0[e];
            *(GAS f32x4*)(dst + c) = o; }
    }
}
__device__ __forceinline__ void ln_mix_pass(Frame& F, const Args& args, const bf16_t* z, const float* g, const float* b) {
    LAS float* gl = (LAS float*)F.lds; LAS float* mul = gl + 2 * D;
    stage_lds(gl, g, D, F.tid); stage_lds(gl + D, b, D, F.tid); stage_lds(mul, args.in[I_MU], 6 * D, F.tid); __syncthreads();
    const int body = (4 * F.NGW < M) ? 4 * F.NGW : M, vcu_ = F.gw / NWAVES;
#pragma unroll 1
    for (int k = 0; k < 2; ++k) {
        int row0, nr;
        if (k == 0) { row0 = 4 * F.gw; nr = 4; if (row0 >= body) continue; }
        else { const int r2 = F.wave * F.G + vcu_; if (body + r2 >= M) break; row0 = body + r2; nr = 1; }
        int t0, T; const float* xlast = nullptr; float* shift_out;
        if (row0 < MPR) { const int bb = row0 / TP; t0 = row0 % TP; T = TP; shift_out = F.out + O_PX + (size_t)bb * D; }
        else { const int r = row0 - MPR; const int bb = r / DS; t0 = r % DS; T = DS; xlast = args.in[I_RX] + (size_t)bb * D; shift_out = F.out + O_SX + (size_t)bb * D; }
        float prev[4][8], cur[4][8];
        if (t0 == 0) {
#pragma unroll
            for (int j = 0; j < 4; ++j)
#pragma unroll
                for (int e = 0; e < 8; ++e) prev[j][e] = 0.f;
            if (xlast) {
#pragma unroll
                for (int j = 0; j < 4; ++j) { const f32x4 a = *(const GAS f32x4*)(xlast + 8 * F.lane + 512 * j), c = *(const GAS f32x4*)(xlast + 8 * F.lane + 512 * j + 4);
#pragma unroll
                    for (int e = 0; e < 4; ++e) { prev[j][e] = a[e]; prev[j][4 + e] = c[e]; } }
            }
        } else { ln_row_load_norm(z + (size_t)(row0 - 1) * D, F.lane, prev); ln_affine(gl, F.lane, prev); }
#pragma unroll 1
        for (int r = 0; r < nr; ++r) {
            const int row = row0 + r;
            ln_row_load_norm(z + (size_t)row * D, F.lane, cur); ln_affine(gl, F.lane, cur);
#pragma unroll
            for (int j = 0; j < 4; ++j) *(GAS u32x4*)((bf16_t*)(F.ws + WS_HB) + (size_t)row * D + 8 * F.lane + 512 * j) = pack8(cur[j]);
            if (t0 + r == T - 1) {
#pragma unroll
                for (int j = 0; j < 4; ++j) { GAS f32x4* o = (GAS f32x4*)(shift_out + 8 * F.lane + 512 * j); o[0] = (f32x4){cur[j][0], cur[j][1], cur[j][2], cur[j][3]}; o[1] = (f32x4){cur[j][4], cur[j][5], cur[j][6], cur[j][7]}; }
            }
#pragma unroll 1
            for (int mx = 0; mx < 6; ++mx) {
                bf16_t* dst = (bf16_t*)(F.ws + WS_XS + (size_t)mx * U37) + (size_t)row * D;
#pragma unroll
                for (int j = 0; j < 4; ++j) { const int c = 8 * F.lane + 512 * j; const f32x4 m0 = *(const LAS f32x4*)(mul + mx * D + c), m1 = *(const LAS f32x4*)(mul + mx * D + c + 4);
                    float o[8];
#pragma unroll
                    for (int e = 0; e < 4; ++e) { o[e] = cur[j][e] + (prev[j][e] - cur[j][e]) * m0[e]; o[4 + e] = cur[j][4 + e] + (prev[j][4 + e] - cur[j][4 + e]) * m1[e]; }
                    *(GAS u32x4*)(dst + c) = pack8(o); asm volatile("" ::: "memory"); }
            }
#pragma unroll
            for (int j = 0; j < 4; ++j)
#pragma unroll
                for (int e = 0; e < 8; ++e) prev[j][e] = cur[j][e];
        }
    }
}
__device__ __forceinline__ void headnorm_pass(Frame& F, const Args& args) {
    const float* ng = args.in[I_MNG];
    const bf16_t* hm = (const bf16_t*)(F.ws + WS_HM); const bf16_t* zin = (const bf16_t*)(F.ws + WS_ZIN); bf16_t* cat = (bf16_t*)(F.ws + WS_CAT);
    for (int it_ = 0, row = F.gw; row < M; ++it_, row = balanced_row(F, it_)) {
        const int c = 16 * F.lane;
        float x[16], o[16];
        { const u32x4 w0 = *(const GAS u32x4*)(hm + (size_t)row * MIXA + c), w1 = *(const GAS u32x4*)(hm + (size_t)row * MIXA + c + 8);
          float a[8], bq[8]; unpack8(w0, a); unpack8(w1, bq);
#pragma unroll
          for (int e = 0; e < 8; ++e) { x[e] = a[e]; x[8 + e] = bq[e]; } }
        { const u32x4 w0 = *(const GAS u32x4*)(zin + (size_t)row * NZ + 3072 + c), w1 = *(const GAS u32x4*)(zin + (size_t)row * NZ + 3072 + c + 8);
          float a[8], bq[8]; unpack8(w0, a); unpack8(w1, bq);
#pragma unroll
          for (int e = 0; e < 8; ++e) { o[e] = a[e]; o[8 + e] = bq[e]; } }
        float s = 0.f;
#pragma unroll
        for (int e = 0; e < 16; ++e) s += x[e];
        s += __shfl_xor(s, 1); s += __shfl_xor(s, 2); s += __shfl_xor(s, 4); s += __shfl_xor(s, 8);
        const float mean = s * (1.f / 256.f); float s2 = 0.f;
#pragma unroll
        for (int e = 0; e < 16; ++e) { x[e] -= mean; s2 += x[e] * x[e]; }
        s2 += __shfl_xor(s2, 1); s2 += __shfl_xor(s2, 2); s2 += __shfl_xor(s2, 4); s2 += __shfl_xor(s2, 8);
        const float rstd = 1.0f / sqrtf(s2 * (1.f / 256.f) + LN_EPS);
        float y0[8], y1[8];
#pragma unroll
        for (int e = 0; e < 8; ++e) { y0[e] = x[e] * rstd * ng[c + e] * sigmoidf_(o[e]); y1[e] = x[8 + e] * rstd * ng[c + 8 + e] * sigmoidf_(o[8 + e]); }
        *(GAS u32x4*)(cat + (size_t)row * D + c) = pack8(y0); *(GAS u32x4*)(cat + (size_t)row * D + c + 8) = pack8(y1);
    }
}


namespace ml {
constexpr int NVR = 2, NVT = NVR + 1, SLW = 16 * NVR, NSL = HDA / SLW;
constexpr int QS = 144;
constexpr int CS = 272;
constexpr int LO_QH = 0, LO_KH = LO_QH + 128 * QS * 2, LO_VT = LO_KH + 128 * QS * 2, LO_VW = LO_VT + 16 * NVT * QS * 2, LO_CT = LO_VW + 16 * NVT * QS * 2,
              LO_GF = LO_CT + 16 * NVT * CS * 2, LO_GG = LO_GF + 512, LO_GM = LO_GG + 512, LO_SC = LO_GM + 512, GATE_BLK = 1600, LO_END = LO_GF + 2 * GATE_BLK;
constexpr int LO_PS = LO_QH;
static_assert(LO_END <= RING_BYTES, "mlstm lds");
__device__ __forceinline__ bf16x8 ldfrag(const LAS unsigned char* base, int row, int stride_el, int col) { return *(const LAS bf16x8*)(base + ((size_t)row * stride_el + col) * 2); }
__device__ __forceinline__ s16x4 trread(const LAS unsigned char* p) { typedef short v4i16_t __attribute__((ext_vector_type(4))); return __builtin_bit_cast(s16x4, __builtin_amdgcn_ds_read_tr16_b64_v4i16((LAS v4i16_t*)p)); }
}
__device__ __forceinline__ float log_sigmoidf_(float x) { return fminf(x, 0.f) - __logf(1.0f + __expf(-fabsf(x))); }
template <int CTRL> __device__ __forceinline__ float dpp_fill(float fill, float v) { return __builtin_bit_cast(float, __builtin_amdgcn_update_dpp(__builtin_bit_cast(int, fill), __builtin_bit_cast(int, v), CTRL, 0xf, 0xf, false)); }
__device__ __forceinline__ float wave_scan_sum(float v, int lane) {
    v += dpp_fill<0x111>(0.f, v); v += dpp_fill<0x112>(0.f, v); v += dpp_fill<0x114>(0.f, v); v += dpp_fill<0x118>(0.f, v);
    const int b = __builtin_bit_cast(int, v);
    const float t0 = __builtin_bit_cast(float, __builtin_amdgcn_readlane(b, 15)), t1 = __builtin_bit_cast(float, __builtin_amdgcn_readlane(b, 31)), t2 = __builtin_bit_cast(float, __builtin_amdgcn_readlane(b, 47));
    const int q = lane >> 4;
    return v + ((q >= 1 ? t0 : 0.f) + (q >= 2 ? t1 : 0.f) + (q >= 3 ? t2 : 0.f));
}
__device__ __forceinline__ float wave_scan_max(float v, int lane) {
    v = fmaxf(v, dpp_fill<0x111>(-3e38f, v)); v = fmaxf(v, dpp_fill<0x112>(-3e38f, v)); v = fmaxf(v, dpp_fill<0x114>(-3e38f, v)); v = fmaxf(v, dpp_fill<0x118>(-3e38f, v));
    const int b = __builtin_bit_cast(int, v);
    const float t0 = __builtin_bit_cast(float, __builtin_amdgcn_readlane(b, 15)), t1 = __builtin_bit_cast(float, __builtin_amdgcn_readlane(b, 31)), t2 = __builtin_bit_cast(float, __builtin_amdgcn_readlane(b, 47));
    const int q = lane >> 4;
    return fmaxf(v, fmaxf(fmaxf(q >= 1 ? t0 : -3e38f, q >= 2 ? t1 : -3e38f), q >= 3 ? t2 : -3e38f));
}
__device__ __forceinline__ void mlstm_prompt_job(Frame& F, const Args& args, int jid) {
    using namespace ml;
    const int b = jid / (NHA * NSL), h = (jid / NSL) % NHA, sl = jid % NSL;
    const int tid = F.tid, lane = F.lane, w = F.wave, q = lane >> 4, c = lane & 15;
    LAS unsigned char* L = F.lds;
    const bf16_t* zin = (const bf16_t*)(F.ws + WS_ZIN); const float* gates = (const float*)(F.ws + WS_GATES);
    bf16_t* hm = (bf16_t*)(F.ws + WS_HM);
    const int rb = b * TP;
    for (int i = tid; i < (LO_GF - LO_VT) / 4; i += NTHREADS) ((LAS unsigned*)(L + LO_VT))[i] = 0u;
    f32x4 st[2][NVT];
#pragma unroll
    for (int a = 0; a < 2; ++a)
#pragma unroll
        for (int v = 0; v < NVT; ++v) st[a][v] = (f32x4){0.f, 0.f, 0.f, 0.f};
    float m_run = 0.f;
    float gq_i0 = -1e30f, gq_i1 = -1e30f, gq_f0 = 1e30f, gq_f1 = 1e30f, m_gate = 0.f;
#define ML_GATES_LOAD(chn_) do { const int r0n_ = ((chn_) == 0) ? 0 : 16 + 128 * ((chn_) - 1), Lcn_ = ((chn_) == 0) ? 16 : 128; const size_t gr_ = (size_t)(rb + r0n_); \
        gq_i0 = -1e30f; gq_i1 = -1e30f; gq_f0 = 1e30f; gq_f1 = 1e30f; \
        if (2 * lane < Lcn_) { gq_i0 = gates[(gr_ + 2 * lane) * 8 + h]; gq_f0 = gates[(gr_ + 2 * lane) * 8 + 4 + h]; } \
        if (2 * lane + 1 < Lcn_) { gq_i1 = gates[(gr_ + 2 * lane + 1) * 8 + h]; gq_f1 = gates[(gr_ + 2 * lane + 1) * 8 + 4 + h]; } } while (0)
#define ML_GATES_MATH(buf_) do { LAS float* gF_ = (LAS float*)(L + LO_GF + (buf_) * GATE_BLK); LAS float* gG_ = gF_ + 128; LAS float* gM_ = gF_ + 256; LAS float* sc_ = gF_ + 384; \
        const int j0 = 2 * lane, j1 = 2 * lane + 1; \
        const float lf0 = log_sigmoidf_(gq_f0), lf1 = log_sigmoidf_(gq_f1);         \
        const float ps = wave_scan_sum(lf0 + lf1, lane); \
        const float ex = ps - (lf0 + lf1); \
        const float F0 = ex + lf0, F1 = F0 + lf1; \
        const float g0 = gq_i0 - F0, g1 = gq_i1 - F1; \
        const float pm = wave_scan_max(fmaxf(g0, g1), lane); \
        const float pme = dpp_fill<0x138>(-3e38f, pm);                                \
        const float pm0 = fmaxf(pme, g0), pm1 = fmaxf(pm0, g1); \
        const float M0 = fmaxf(m_gate, pm0), M1 = fmaxf(m_gate, pm1); \
        gF_[j0] = F0; gF_[j1] = F1; gG_[j0] = g0; gG_[j1] = g1; gM_[j0] = M0; gM_[j1] = M1; \
        if (lane == 63) { sc_[0] = m_gate; sc_[1] = M1; sc_[2] = __expf(m_gate - M1); sc_[3] = F1 + M1; } \
        m_gate = __builtin_bit_cast(float, __builtin_amdgcn_readlane(__builtin_bit_cast(int, F1 + M1), 63)); } while (0)
    if (w == 0) { ML_GATES_LOAD(0); ML_GATES_MATH(0); }
    __syncthreads();
    for (int ch = 0; ch < 17; ++ch) {
        const int r0 = (ch == 0) ? 0 : 16 + 128 * (ch - 1), Lc = (ch == 0) ? 16 : 128;
        const int grow = rb + r0;
        LAS float* gF = (LAS float*)(L + LO_GF + (ch & 1) * GATE_BLK); LAS float* gG = gF + 128; LAS float* gM = gF + 256; LAS float* sc = gF + 384;
        if (w == 0 && ch + 1 < 17) ML_GATES_LOAD(ch + 1);
        const float m_old = sc[0], Mlast = sc[1], dec = sc[2], m_new = sc[3];
        {
            const int j = tid >> 2, v8 = (tid & 3) * 8;
            float vv[8];
#pragma unroll
            for (int e = 0; e < 8; ++e) vv[e] = 0.f;
            if (j < Lc) unpack8(*(const GAS u32x4*)(zin + (size_t)(grow + j) * NZ + 2048 + h * 256 + sl * SLW + v8), vv);
            const float we = __expf(gG[j] - Mlast);
#pragma unroll
            for (int e = 0; e < 8; ++e) { ((LAS bf16_t*)(L + LO_VT))[(v8 + e) * QS + j] = (bf16_t)f2bf(vv[e]); ((LAS bf16_t*)(L + LO_VW))[(v8 + e) * QS + j] = (bf16_t)f2bf(vv[e] * we); }
            if ((tid & 3) == 0) { ((LAS bf16_t*)(L + LO_VT))[SLW * QS + j] = (j < Lc) ? (bf16_t)0x3F80 : (bf16_t)0; ((LAS bf16_t*)(L + LO_VW))[SLW * QS + j] = (bf16_t)f2bf(we); }
        }
        f32x4 accS[8], accR[NVT];
#pragma unroll
        for (int i = 0; i < 8; ++i) accS[i] = (f32x4){0.f, 0.f, 0.f, 0.f};
#pragma unroll
        for (int i = 0; i < NVT; ++i) accR[i] = (f32x4){0.f, 0.f, 0.f, 0.f};
#pragma unroll
        for (int half = 0; half < 2; ++half) {
#pragma unroll
            for (int i = 0; i < 4; ++i) { const int p = tid + NTHREADS * i, row = p >> 4, c16 = p & 15;
                u32x4 qv = (u32x4){0u, 0u, 0u, 0u}, kv = (u32x4){0u, 0u, 0u, 0u};
                if (row < Lc) { const bf16_t* src = zin + (size_t)(grow + row) * NZ + h * 256 + half * 128 + c16 * 8; qv = *(const GAS u32x4*)src; kv = *(const GAS u32x4*)(src + 1024); }
                *(LAS u32x4*)(L + LO_QH + (row * QS + c16 * 8) * 2) = qv; *(LAS u32x4*)(L + LO_KH + (row * QS + c16 * 8) * 2) = kv; }
            __syncthreads();
#pragma unroll
            for (int ks = 0; ks < 4; ++ks) {
                const bf16x8 qf = ldfrag(L + LO_QH, 16 * w + c, QS, 32 * ks + 8 * q);
#pragma unroll
                for (int jt = 0; jt < 8; ++jt) if (jt <= (w | 1)) { const bf16x8 kf = ldfrag(L + LO_KH, 16 * jt + c, QS, 32 * ks + 8 * q); accS[jt] = __builtin_amdgcn_mfma_f32_16x16x32_bf16(kf, qf, accS[jt], 0, 0, 0); }
#pragma unroll
                for (int vt = 0; vt < NVT; ++vt) { const bf16x8 cf = ldfrag(L + LO_CT, 16 * vt + c, CS, half * 128 + 32 * ks + 8 * q); accR[vt] = __builtin_amdgcn_mfma_f32_16x16x32_bf16(cf, qf, accR[vt], 0, 0, 0); }
                asm volatile("" ::: "memory");
            }
#pragma unroll
            for (int vt = 0; vt < NVT; ++vt) st[half][vt] = st[half][vt] * dec;
#pragma unroll
            for (int ks = 0; ks < 4; ++ks) {
                const LAS unsigned char* kp = L + LO_KH + ((32 * ks + 8 * q + (c >> 2)) * QS + 16 * w + 4 * (c & 3)) * 2;
                const s16x4 t0 = ml::trread(kp), t1 = ml::trread(kp + 4 * QS * 2);
                const bf16x8 kb = (bf16x8){t0[0], t0[1], t0[2], t0[3], t1[0], t1[1], t1[2], t1[3]};
#pragma unroll
                for (int vt = 0; vt < NVT; ++vt) { const bf16x8 vf = ldfrag(L + LO_VW, 16 * vt + c, QS, 32 * ks + 8 * q); st[half][vt] = __builtin_amdgcn_mfma_f32_16x16x32_bf16(vf, kb, st[half][vt], 0, 0, 0); }
            }
            if (half == 0 && w == 0 && ch + 1 < 17) ML_GATES_MATH((ch + 1) & 1);
            __syncthreads();
        }
        {
            int q = lane >> 4, c = lane & 15; asm volatile("" : "+v"(q), "+v"(c));
            const int i = 16 * w + c; const float Mi = gM[i];
#pragma unroll
            for (int jt = 0; jt < 8; ++jt) if (jt <= (w | 1)) {
                float p[4];
#pragma unroll
                for (int r = 0; r < 4; ++r) { const int j = 16 * jt + 4 * q + r; p[r] = (j <= i) ? accS[jt][r] * __expf(gG[j] - Mi) : 0.f; }
                *(LAS u32x2*)(L + LO_PS + (i * QS + 16 * jt + 4 * q) * 2) = (u32x2){pk2(p[0], p[1]), pk2(p[2], p[3])};
            }
#pragma unroll
            for (int half = 0; half < 2; ++half)
#pragma unroll
                for (int vt = 0; vt < NVT; ++vt)
#pragma unroll
                    for (int r = 0; r < 4; ++r) ((LAS bf16_t*)(L + LO_CT))[(16 * vt + 4 * q + r) * CS + half * 128 + 16 * w + c] = (bf16_t)f2bf(st[half][vt][r]);
        }
        __syncthreads();
        {
            f32x4 accN[NVT];
#pragma unroll
            for (int i = 0; i < NVT; ++i) accN[i] = (f32x4){0.f, 0.f, 0.f, 0.f};
#pragma unroll
            for (int ks = 0; ks < 4; ++ks) if (ks <= (w >> 1)) {
                const bf16x8 pf = ldfrag(L + LO_PS, 16 * w + c, QS, 32 * ks + 8 * q);
#pragma unroll
                for (int vt = 0; vt < NVT; ++vt) { const bf16x8 vf = ldfrag(L + LO_VT, 16 * vt + c, QS, 32 * ks + 8 * q); accN[vt] = __builtin_amdgcn_mfma_f32_16x16x32_bf16(vf, pf, accN[vt], 0, 0, 0); }
            }
            const int i = 16 * w + c; const float Mi = gM[i], Fi = gF[i];
            const float inter = __expf(m_old - Mi);
            float den = accN[NVR][0] + inter * accR[NVR][0];
            den = __shfl(den, c);
            const float dd = fmaxf(fabsf(den), __expf(-(Fi + Mi)));
            const float inv = 1.0f / dd;
#pragma unroll
            for (int vt = 0; vt < NVR; ++vt) {
                float hv[4];
#pragma unroll
                for (int r = 0; r < 4; ++r) hv[r] = (accN[vt][r] + inter * accR[vt][r]) * inv;
                if (i < Lc) *(GAS u32x2*)(hm + (size_t)(grow + i) * MIXA + h * 256 + sl * SLW + 16 * vt + 4 * q) = (u32x2){pk2(hv[0], hv[1]), pk2(hv[2], hv[3])};
            }
        }
        m_run = m_new;
        __syncthreads();
    }
#undef ML_GATES_LOAD
#undef ML_GATES_MATH
    float* out = F.out;
#pragma unroll
    for (int half = 0; half < 2; ++half) {
        const int dk = half * 128 + 16 * w + c;
#pragma unroll
        for (int vt = 0; vt < NVR; ++vt) *(GAS f32x4*)(out + O_PC + (((size_t)(b * NHA + h) * HDA + dk) * HDA) + sl * SLW + 16 * vt + 4 * q) = st[half][vt];
        if (sl == 0 && q == 0) out[O_PN + (size_t)(b * NHA + h) * HDA + dk] = st[half][NVR][0];
    }
    if (sl == 0 && tid == 0) out[O_PM + b * NHA + h] = m_run;
    __syncthreads();
}

__device__ __forceinline__ void mlstm_sample_job(Frame& F, const Args& args, int jid) {
    const int b = jid >> 2, h = jid & 3;
    const int tid = F.tid, lane = F.lane, w = F.wave;
    LAS float* qs = (LAS float*)(F.lds);
    LAS float* ks = qs + 2048;
    LAS float* vs = ks + 2048;
    LAS float* kw = vs + 2048;
    LAS float* sm = kw + 2048;
    LAS float* gv = sm + 128;
    LAS float* red = gv + 64;
    const bf16_t* zin = (const bf16_t*)(F.ws + WS_ZIN); const float* gates = (const float*)(F.ws + WS_GATES);
    const int row0 = MPR + b * DS;
    const float* C0 = args.in[I_MC] + (size_t)(b * NHA + h) * HDA * HDA; const float* n0 = args.in[I_MN] + (size_t)(b * NHA + h) * HDA;
    const float m0 = args.in[I_MM][b * NHA + h];
    float gl[16];
#pragma unroll
    for (int j = 0; j < 16; ++j) gl[j] = 0.f;
    if (tid == NTHREADS - 64) {
#pragma unroll
        for (int j = 0; j < 8; ++j) { gl[j] = gates[(size_t)(row0 + j) * 8 + h]; gl[8 + j] = gates[(size_t)(row0 + j) * 8 + 4 + h]; }
    }
    for (int i = tid; i < 3 * 8 * 32; i += NTHREADS) { const int which = i / 256, r = (i % 256) / 32, c8 = (i % 32) * 8;
        const u32x4 wv = *(const GAS u32x4*)(zin + (size_t)(row0 + r) * NZ + which * 1024 + h * 256 + c8); float x[8]; unpack8(wv, x);
        LAS float* dst = qs + which * 2048 + r * 256 + c8;
#pragma unroll
        for (int e = 0; e < 8; ++e) dst[e] = x[e]; }
    {
        if (tid == NTHREADS - 64) {
            float Fv[8], gg[8], Mi[8]; float cum = 0.f, pmx = -3e38f;
#pragma unroll
            for (int j = 0; j < 8; ++j) { const float ig = gl[j]; cum += log_sigmoidf_(gl[8 + j]); Fv[j] = cum; gg[j] = ig - cum; pmx = fmaxf(pmx, gg[j]); Mi[j] = fmaxf(m0, pmx); }
            const float Ml = Mi[7];
#pragma unroll
            for (int j = 0; j < 8; ++j) { gv[j] = Fv[j]; gv[8 + j] = gg[j]; gv[16 + j] = Mi[j]; gv[24 + j] = __expf(m0 - Mi[j]); gv[32 + j] = __expf(-(Fv[j] + Mi[j])); gv[40 + j] = __expf(gg[j] - Ml); }
            gv[48] = __expf(m0 - Ml); gv[49] = Fv[7] + Ml;
        }
    }
    __syncthreads();
    f32x4 cvA[8], cvB[8];
#define MS_LOAD(cv_, kb_) do { _Pragma("unroll") for (int u = 0; u < 8; ++u) cv_[u] = *(const GAS f32x4*)(C0 + (size_t)(32 * w + (kb_) + u) * HDA + 4 * lane); } while (0)
    MS_LOAD(cvA, 0); MS_LOAD(cvB, 8);
    for (int i = tid; i < 2048; i += NTHREADS) kw[i] = ks[i] * gv[40 + (i >> 8)];
    {
        const int i = w, j = lane >> 3, part = lane & 7;
        float d = 0.f, dn = 0.f;
        for (int k = part * 32; k < part * 32 + 32; ++k) { const float qv = qs[i * 256 + k]; d += qv * ks[j * 256 + k]; if (j == 0) dn += qv * n0[k]; }
        d += __shfl_xor(d, 1); d += __shfl_xor(d, 2); d += __shfl_xor(d, 4);
        dn += __shfl_xor(dn, 1); dn += __shfl_xor(dn, 2); dn += __shfl_xor(dn, 4);
        if (part == 0) { sm[i * 16 + j] = (j <= i) ? d * __expf(gv[8 + j] - gv[16 + i]) : 0.f; if (j == 0) sm[i * 16 + 8] = dn; }
    }
    lds_barrier();
    const float dec = gv[48];
    f32x4 vr[8], hacc[8];
#pragma unroll
    for (int j = 0; j < 8; ++j) { vr[j] = *(const LAS f32x4*)(vs + j * 256 + 4 * lane); hacc[j] = (f32x4){0.f, 0.f, 0.f, 0.f}; }
    float* Cout = F.out + O_SC + (size_t)(b * NHA + h) * HDA * HDA;
#define MS_USE(cv_, kb_) do { _Pragma("unroll") for (int u = 0; u < 8; ++u) { const int k = 32 * w + (kb_) + u; \
            f32x4 cn = cv_[u] * dec; \
            _Pragma("unroll") for (int j = 0; j < 8; ++j) { hacc[j] += cv_[u] * qs[j * 256 + k]; cn += vr[j] * kw[j * 256 + k]; } \
            *(GAS f32x4*)(Cout + (size_t)k * HDA + 4 * lane) = cn; } } while (0)
    MS_USE(cvA, 0);  MS_LOAD(cvA, 16);
    MS_USE(cvB, 8);  MS_LOAD(cvB, 24);
    MS_USE(cvA, 16);
    MS_USE(cvB, 24);
#undef MS_LOAD
#undef MS_USE
#pragma unroll
    for (int j = 0; j < 8; ++j) *(LAS f32x4*)(red + (w * 8 + j) * 256 + 4 * lane) = hacc[j];
    __syncthreads();
    {
        const int i = tid >> 6; f32x4 qc = (f32x4){0.f, 0.f, 0.f, 0.f};
#pragma unroll
        for (int ww = 0; ww < 8; ++ww) qc += *(const LAS f32x4*)(red + (ww * 8 + i) * 256 + 4 * lane);
        f32x4 num = qc * gv[24 + i]; float den = gv[24 + i] * sm[i * 16 + 8];
#pragma unroll
        for (int j = 0; j < 8; ++j) { const float sij = sm[i * 16 + j]; num += vr[j] * sij; den += sij; }
        const float inv = 1.0f / fmaxf(fabsf(den), gv[32 + i]);
        num = num * inv;
        *(GAS u32x2*)((bf16_t*)(F.ws + WS_HM) + (size_t)(row0 + i) * MIXA + h * 256 + 4 * lane) = (u32x2){pk2(num[0], num[1]), pk2(num[2], num[3])};
    }
    if (tid < 256) { float nn = dec * n0[tid];
#pragma unroll
        for (int j = 0; j < 8; ++j) nn += kw[j * 256 + tid];
        F.out[O_SN + (size_t)(b * NHA + h) * HDA + tid] = nn; }
    if (tid == 0) F.out[O_SM + b * NHA + h] = gv[49];
    __syncthreads();
}


namespace rg {
constexpr int XS = 128, AS = 144, HS = 132;
constexpr int O_XP = 0, O_XC = O_XP + 176 * XS * 2, O_WA = O_XC + 128 * AS * 2, O_WX = O_WA + 32 * AS * 2, O_AL = O_WX + 32 * AS * 2, O_UL = O_AL + 32 * HS * 4, O_CR = O_UL + 32 * HS * 4, O_ENDL = O_CR + 128;
static_assert(O_ENDL <= RING_BYTES, "rglru lds");
}
__device__ __forceinline__ float gelu_tanh_(float x) { const float u = 0.7978845608028654f * (x + 0.044715f * x * x * x); return 0.5f * x * (1.0f + tanhf_(u)); }

__device__ __forceinline__ void rglru_job(Frame& F, const Args& args, int kind, int sq, int n, int qt) {
    using namespace rg;
    const int tid = F.tid, lane = F.lane, w = F.wave, q = lane >> 4, c = lane & 15;
    LAS unsigned char* L = F.lds;
    LAS bf16_t* xp = (LAS bf16_t*)(L + O_XP); LAS bf16_t* xc = (LAS bf16_t*)(L + O_XC);
    LAS float* aL = (LAS float*)(L + O_AL); LAS float* uL = (LAS float*)(L + O_UL); LAS float* carry = (LAS float*)(L + O_CR);
    const bf16_t* zin = (const bf16_t*)(F.ws + WS_ZIN); bf16_t* cat = (bf16_t*)(F.ws + WS_CAT);
    const int cb0 = n * 128;
    const int c0 = cb0 + qt * 32;
    for (int i = tid; i < 2 * 32 * 128; i += NTHREADS) { const int which = i >> 12, cc = (i >> 7) & 31, ii = i & 127;
        const float v = args.in[which ? I_WX : I_WA][((size_t)n * 128 + ii) * 128 + qt * 32 + cc];
        ((LAS bf16_t*)(L + (which ? O_WX : O_WA)))[cc * AS + ii] = (bf16_t)f2bf(v); }
    const int chn = tid & 127;
    const int rq = tid >> 4, cq = tid & 15;
    float cw[4][8], cbias[8];
#pragma unroll
    for (int j = 0; j < 4; ++j)
#pragma unroll
        for (int e = 0; e < 8; ++e) cw[j][e] = args.in[I_CVW][j * RGW + cb0 + 8 * cq + e];
#pragma unroll
    for (int e = 0; e < 8; ++e) cbias[e] = args.in[I_CVB][cb0 + 8 * cq + e];
    float bav[2], bxv[2], spv[2];
#pragma unroll
    for (int e = 0; e < 2; ++e) { const int cg = c0 + 16 * e + c; bav[e] = args.in[I_BA][cg]; bxv[e] = args.in[I_BX][cg]; spv[e] = softplusf_(-args.in[I_LAM][cg]); }
    if (tid < 32) carry[tid] = 0.f;
    const int ntiles = kind ? 1 : 17;
    const int T = kind ? DS : TP;
    u32x4 pre[5];
#define RG_PREFETCH(t0_) do { _Pragma("unroll") for (int i_ = 0; i_ < 5; ++i_) { const int p_ = tid + NTHREADS * i_; const int r_ = p_ >> 4, c16_ = p_ & 15; const int tok_ = (t0_) - 3 + r_; \
        pre[i_] = (u32x4){0u, 0u, 0u, 0u}; if (p_ < 131 * 16 && tok_ >= 0 && tok_ < TP) pre[i_] = *(const GAS u32x4*)(zin + (size_t)(sq * TP + tok_) * NZ + 4096 + cb0 + c16_ * 8); } } while (0)
    if (kind == 0) RG_PREFETCH(0);
    for (int ti = 0; ti < ntiles; ++ti) {
        const int t0 = ti * 128;
        const int nv = kind ? 128 : ((TP - t0) < 128 ? (TP - t0) : 128);
        __syncthreads();
        if (kind == 0) {
#pragma unroll
            for (int i = 0; i < 5; ++i) { const int p = tid + NTHREADS * i; if (p < 131 * 16) *(LAS u32x4*)(xp + (p >> 4) * XS + (p & 15) * 8) = pre[i]; }
        } else {
            for (int p = tid; p < 176 * 16; p += NTHREADS) { const int r = p >> 4, c16 = p & 15; const int sg = r / 11, lr = r % 11; const int bq = sq * 16 + sg;
                u32x4 v;
                if (lr < 3) { const float* src = args.in[I_RC] + ((size_t)bq * 3 + lr) * RGW + cb0 + c16 * 8; const f32x4 a = *(const GAS f32x4*)src, bb = *(const GAS f32x4*)(src + 4);
                    v.x = pk2(a[0], a[1]); v.y = pk2(a[2], a[3]); v.z = pk2(bb[0], bb[1]); v.w = pk2(bb[2], bb[3]); }
                else v = *(const GAS u32x4*)(zin + (size_t)(MPR + bq * DS + lr - 3) * NZ + 4096 + cb0 + c16 * 8);
                *(LAS u32x4*)(xp + r * XS + c16 * 8) = v; }
        }
        u32x4 gpre = (u32x4){0u, 0u, 0u, 0u};
        { const int rho = tid >> 2, c8 = (tid & 3) * 8;
          if (rho < nv) { const int grow = kind ? (MPR + (sq * 16 + (rho >> 3)) * DS + (rho & 7)) : (sq * TP + t0 + rho); gpre = *(const GAS u32x4*)(zin + (size_t)grow * NZ + 5120 + c0 + c8); } }
        __syncthreads();
        if (kind == 0 && ti + 1 < ntiles) RG_PREFETCH(t0 + 128);
        {
            const int rho0 = 4 * rq; const int idx0 = kind ? ((rho0 >> 3) * 11 + (rho0 & 7)) : rho0;
            float xr[7][8];
#pragma unroll
            for (int j = 0; j < 7; ++j) unpack8(*(const LAS u32x4*)(xp + (idx0 + j) * XS + 8 * cq), xr[j]);
#pragma unroll
            for (int r = 0; r < 4; ++r) { float o[8];
#pragma unroll
                for (int e = 0; e < 8; ++e) o[e] = cbias[e] + cw[0][e] * xr[r][e] + cw[1][e] * xr[r + 1][e] + cw[2][e] * xr[r + 2][e] + cw[3][e] * xr[r + 3][e];
                *(LAS u32x4*)(xc + (rho0 + r) * AS + 8 * cq) = pack8(o); }
        }
        __syncthreads();
        f32x4 acc[4];
#pragma unroll
        for (int i = 0; i < 4; ++i) acc[i] = (f32x4){0.f, 0.f, 0.f, 0.f};
#pragma unroll
        for (int ks = 0; ks < 4; ++ks) {
            const bf16x8 xf = *(const LAS bf16x8*)(xc + (16 * w + c) * AS + 32 * ks + 8 * q);
#pragma unroll
            for (int nt = 0; nt < 4; ++nt) { const bf16x8 wf = *(const LAS bf16x8*)((LAS bf16_t*)(L + ((nt >> 1) ? O_WX : O_WA)) + (16 * (nt & 1) + c) * AS + 32 * ks + 8 * q);
                acc[nt] = __builtin_amdgcn_mfma_f32_16x16x32_bf16(xf, wf, acc[nt], 0, 0, 0); }
        }
#pragma unroll
        for (int e = 0; e < 2; ++e) {
            f32x4 av, uv;
#pragma unroll
            for (int r = 0; r < 4; ++r) { const int t = 16 * w + 4 * q + r;
                const float rr = sigmoidf_(acc[e][r] + bav[e]), gi = sigmoidf_(acc[2 + e][r] + bxv[e]);
                const float la = -8.0f * rr * spv[e]; const float a = __expf(la); const float mult = sqrtf(fmaxf(1.0f - a * a, 0.f));
                const float xv = bf2f(xc[t * AS + qt * 32 + 16 * e + c]);
                const bool valid = t < nv;
                av[r] = valid ? a : 1.0f; uv[r] = valid ? mult * gi * xv : 0.f; }
            *(LAS f32x4*)(aL + (16 * e + c) * HS + 16 * w + 4 * q) = av; *(LAS f32x4*)(uL + (16 * e + c) * HS + 16 * w + 4 * q) = uv;
        }
        __syncthreads();
        {
            const int sg = tid & 15, ch = tid >> 4;
            float a8[8], u8[8];
            { const f32x4 a0 = *(const LAS f32x4*)(aL + ch * HS + 8 * sg), a1 = *(const LAS f32x4*)(aL + ch * HS + 8 * sg + 4), u0 = *(const LAS f32x4*)(uL + ch * HS + 8 * sg), u1 = *(const LAS f32x4*)(uL + ch * HS + 8 * sg + 4);
#pragma unroll
              for (int e = 0; e < 4; ++e) { a8[e] = a0[e]; a8[4 + e] = a1[e]; u8[e] = u0[e]; u8[4 + e] = u1[e]; } }
            float hin;
            if (kind == 0) {
                float A = 1.f, H = 0.f;
#pragma unroll
                for (int k = 0; k < 8; ++k) { H = a8[k] * H + u8[k]; A *= a8[k]; }
#pragma unroll
                for (int d = 1; d < 16; d <<= 1) { const float Ap = __shfl_up(A, d, 16), Hp = __shfl_up(H, d, 16); if (sg >= d) { H = A * Hp + H; A = A * Ap; } }
                float Ae = __shfl_up(A, 1, 16), He = __shfl_up(H, 1, 16); if (sg == 0) { Ae = 1.f; He = 0.f; }
                hin = Ae * carry[ch] + He;
            } else {
                hin = args.in[I_RH][(size_t)(sq * 16 + sg) * RGW + c0 + ch];
            }
            float hcur = hin; float h8[8];
#pragma unroll
            for (int k = 0; k < 8; ++k) { hcur = a8[k] * hcur + u8[k]; h8[k] = hcur; }
            __syncthreads();
            *(LAS f32x4*)(uL + ch * HS + 8 * sg) = (f32x4){h8[0], h8[1], h8[2], h8[3]}; *(LAS f32x4*)(uL + ch * HS + 8 * sg + 4) = (f32x4){h8[4], h8[5], h8[6], h8[7]};
            if (kind == 0) { if (sg == 15) carry[ch] = hcur; }
            else F.out[O_SH + (size_t)(sq * 16 + sg) * RGW + c0 + ch] = hcur;
            if (kind == 0 && ti == ntiles - 1 && sg == 15) F.out[O_PH + (size_t)sq * RGW + c0 + ch] = hcur;
        }
        __syncthreads();
        {
            const int rho = tid >> 2, c8 = (tid & 3) * 8;
            if (rho < nv) {
                const int grow = kind ? (MPR + (sq * 16 + (rho >> 3)) * DS + (rho & 7)) : (sq * TP + t0 + rho);
                float gr[8], o[8]; unpack8(gpre, gr);
#pragma unroll
                for (int e = 0; e < 8; ++e) o[e] = uL[(c8 + e) * HS + rho] * gelu_tanh_(gr[e]);
                *(GAS u32x4*)(cat + (size_t)grow * D + 1024 + c0 + c8) = pack8(o);
            }
        }
        if (qt == 0) {
            if (kind == 0) { if (ti == ntiles - 1 && tid < 384) { const int i3 = tid >> 7; F.out[O_PCV + ((size_t)sq * 3 + i3) * RGW + cb0 + chn] = bf2f(xp[(nv + i3) * XS + chn]); } }
            else { for (int p = tid; p < 16 * 3 * 128; p += NTHREADS) { const int sg = p / 384, i3 = (p % 384) >> 7, ch2 = p & 127; F.out[O_SCV + ((size_t)(sq * 16 + sg) * 3 + i3) * RGW + cb0 + ch2] = bf2f(xp[(sg * 11 + 8 + i3) * XS + ch2]); } }
        }
    }
#undef RG_PREFETCH
    __syncthreads();
    (void)T;
}


namespace rw {
constexpr int TB = 64;
constexpr int O_W = 0, O_A = O_W + TB * 64 * 4, O_B = O_A + TB * 64 * 4, O_K = O_B + TB * 64 * 4, O_R = O_K + TB * 64 * 4, O_V = O_R + TB * 64 * 4, O_Y = O_V + TB * 64 * 4, O_CB = O_Y + TB * 64 * 4, O_WC = O_CB + TB * 4, O_SP = O_WC + 256, O_ENDL = O_SP + 8 * 64 * 4;
static_assert(O_ENDL <= RING_BYTES, "rwkv lds");
}
__device__ __forceinline__ float row16_sum(float v) {
    v += __builtin_bit_cast(float, __builtin_amdgcn_update_dpp(0, __builtin_bit_cast(int, v), 0x128, 0xf, 0xf, false));
    v += __builtin_bit_cast(float, __builtin_amdgcn_update_dpp(0, __builtin_bit_cast(int, v), 0x124, 0xf, 0xf, false));
    v += __builtin_bit_cast(float, __builtin_amdgcn_update_dpp(0, __builtin_bit_cast(int, v), 0x122, 0xf, 0xf, false));
    v += __builtin_bit_cast(float, __builtin_amdgcn_update_dpp(0, __builtin_bit_cast(int, v), 0x121, 0xf, 0xf, false));
    return v;
}
template <int CTRL> __device__ __forceinline__ float dppf(float v) { return __builtin_bit_cast(float, __builtin_amdgcn_update_dpp(0, __builtin_bit_cast(int, v), CTRL, 0xf, 0xf, false)); }
#define RS_STAGE(n, bit, XCH) do { _Pragma("unroll") for (int j_ = 0; j_ < (n); ++j_) { \
        const float lo_ = ya[j_], hi_ = ya[j_ + (n)]; const float keep_ = (bit) ? hi_ : lo_, send_ = (bit) ? lo_ : hi_; ya[j_] = keep_ + XCH(send_); \
        const float lo2_ = yb[j_], hi2_ = yb[j_ + (n)]; const float keep2_ = (bit) ? hi2_ : lo2_, send2_ = (bit) ? lo2_ : hi2_; yb[j_] = keep2_ + XCH(send2_); } } while (0)
__device__ __forceinline__ float xch1(float v) { return dppf<0xB1>(v); }
__device__ __forceinline__ float xch2(float v) { return dppf<0x4E>(v); }
__device__ __forceinline__ float xch8(float v) { return dppf<0x128>(v); }
__device__ __forceinline__ float xch4(float v) { return dppf<0x1B>(dppf<0x141>(v)); }

__device__ __forceinline__ void rwkv_job(Frame& F, const Args& args, int rowbase, int T, int h, const float* S0, float* Sout) {
    using namespace rw;
    const int tid = F.tid, lane = F.lane, w = F.wave, rp = lane >> 4, kp = lane & 15;
    LAS unsigned char* L = F.lds;
    LAS float* Wl = (LAS float*)(L + O_W); LAS float* Al = (LAS float*)(L + O_A); LAS float* Bl = (LAS float*)(L + O_B); LAS float* Kl = (LAS float*)(L + O_K);
    LAS float* Rl = (LAS float*)(L + O_R); LAS float* Vl = (LAS float*)(L + O_V); LAS float* Yl = (LAS float*)(L + O_Y); LAS float* CBl = (LAS float*)(L + O_CB); LAS float* WCl = (LAS float*)(L + O_WC); LAS float* SPl = (LAS float*)(L + O_SP);
    const bf16_t* rb = (const bf16_t*)(F.ws + WS_RKV); const bf16_t* kb = rb + (size_t)MP * D; const bf16_t* vb = kb + (size_t)MP * D;
    const float* wd = (const float*)(F.ws + WS_WDEC); const bf16_t* ab = (const bf16_t*)(F.ws + WS_AG); const bf16_t* gb = (const bf16_t*)(F.ws + WS_GG);
    bf16_t* ycat = (bf16_t*)(F.ws + WS_YCAT);
    const int r0 = 8 * w + 2 * rp;
    f32x4 Sa, Sb;
    if (S0) { Sa = *(const GAS f32x4*)(S0 + (size_t)r0 * 64 + 4 * kp); Sb = *(const GAS f32x4*)(S0 + (size_t)(r0 + 1) * 64 + 4 * kp); }
    else { Sa = (f32x4){0.f, 0.f, 0.f, 0.f}; Sb = Sa; }
    const bool b0 = kp & 1, b1 = kp & 2, b2 = kp & 4, b3 = kp & 8;
    const int jmap = 8 * (kp & 1) + 4 * ((kp >> 1) & 1) + 2 * ((kp >> 3) & 1) + ((kp >> 2) & 1);
    const int tt = tid >> 3, part = tid & 7, hk = h * 64 + 8 * part;
    float ckk[8], cka[8], crk[8], clg[8], clb[8];
#pragma unroll
    for (int e = 0; e < 8; ++e) { ckk[e] = args.in[I_KK][hk + e]; cka[e] = args.in[I_KA][hk + e]; crk[e] = args.in[I_RK][hk + e]; clg[e] = args.in[I_LNXG][hk + e]; clb[e] = args.in[I_LNXB][hk + e]; }
    u32x4 q_r = (u32x4){0u, 0u, 0u, 0u}, q_k = q_r, q_v = q_r, q_a = q_r, q_g = q_r; f32x4 q_w0 = (f32x4){0.f, 0.f, 0.f, 0.f}, q_w1 = q_w0;
#define RW_PREFETCH(tb_) do { if ((tb_) + tt < T) { const size_t row_ = (size_t)(rowbase + (tb_) + tt); \
        q_r = *(const GAS u32x4*)(rb + row_ * D + hk); q_k = *(const GAS u32x4*)(kb + row_ * D + hk); q_v = *(const GAS u32x4*)(vb + row_ * D + hk); q_a = *(const GAS u32x4*)(ab + row_ * D + hk); \
        q_g = *(const GAS u32x4*)(gb + row_ * D + hk); q_w0 = *(const GAS f32x4*)(wd + row_ * D + hk); q_w1 = *(const GAS f32x4*)(wd + row_ * D + hk + 4); } } while (0)
    RW_PREFETCH(0);
    for (int tb = 0; tb < T; tb += TB) {
        const int nvt = (T - tb) < TB ? (T - tb) : TB;
        __syncthreads();
        float gcur[8];
        {
            const int o = tt * 64 + 8 * part;
            if (tt < nvt) {
                float r[8], k[8], v[8], a[8], wv[8];
                unpack8(q_r, r); unpack8(q_k, k); unpack8(q_v, v); unpack8(q_a, a); unpack8(q_g, gcur);
#pragma unroll
                for (int e = 0; e < 4; ++e) { wv[e] = q_w0[e]; wv[4 + e] = q_w1[e]; }
                float kkv[8], ss = 0.f, cb = 0.f, kp2[8];
#pragma unroll
                for (int e = 0; e < 8; ++e) { kkv[e] = k[e] * ckk[e]; ss += kkv[e] * kkv[e]; kp2[e] = k[e] * (1.0f + (a[e] - 1.0f) * cka[e]); cb += r[e] * kp2[e] * crk[e]; }
                ss += __shfl_xor(ss, 1); ss += __shfl_xor(ss, 2); ss += __shfl_xor(ss, 4);
                cb += __shfl_xor(cb, 1); cb += __shfl_xor(cb, 2); cb += __shfl_xor(cb, 4);
                const float inv = 1.0f / fmaxf(sqrtf(ss), 1e-12f);
#pragma unroll
                for (int e = 0; e < 8; ++e) { const float kk = kkv[e] * inv; Wl[o + e] = wv[e]; Al[o + e] = -kk; Bl[o + e] = kk * a[e]; Kl[o + e] = kp2[e]; Rl[o + e] = r[e]; Vl[o + e] = v[e]; }
                if (part == 0) CBl[tt] = cb;
            } else {
#pragma unroll
                for (int e = 0; e < 8; ++e) { Wl[o + e] = 1.f; Al[o + e] = 0.f; Bl[o + e] = 0.f; Kl[o + e] = 0.f; Rl[o + e] = 0.f; Vl[o + e] = 0.f; gcur[e] = 0.f; }
            }
        }
        RW_PREFETCH(tb + TB);
        __syncthreads();
        {
            const int kk_ = tid & 63, sg_ = tid >> 6;
            float wseg[8]; float pr = 1.f;
#pragma unroll
            for (int e = 0; e < 8; ++e) { wseg[e] = Wl[(8 * sg_ + e) * 64 + kk_]; pr *= wseg[e]; }
            SPl[sg_ * 64 + kk_] = pr;
            __syncthreads();
            float wc = 1.f;
#pragma unroll
            for (int q_ = 0; q_ < 8; ++q_) if (q_ < sg_) wc *= SPl[q_ * 64 + kk_];
#pragma unroll
            for (int e = 0; e < 8; ++e) { const int o_ = (8 * sg_ + e) * 64 + kk_;
                Al[o_] *= wc; wc *= wseg[e]; const float iw = 1.0f / wc; Bl[o_] *= iw; Kl[o_] *= iw; Rl[o_] *= wc; }
            if (sg_ == 7) WCl[kk_] = wc;
        }
        __syncthreads();
        const int ngrp = (nvt + 15) >> 4;
#define RW_LOAD(P, t_) do { P##a = *(const LAS f32x4*)(Al + (t_) * 64 + 4 * kp); P##b = *(const LAS f32x4*)(Bl + (t_) * 64 + 4 * kp); \
            P##k = *(const LAS f32x4*)(Kl + (t_) * 64 + 4 * kp); P##r = *(const LAS f32x4*)(Rl + (t_) * 64 + 4 * kp); P##v = *(const LAS f32x2*)(Vl + (t_) * 64 + r0); } while (0)
        f32x4 ca, cbv, ck, cr; f32x2 cv;
        f32x4 n0_a, n0_b, n0_k, n0_r; f32x2 n0_v;
        { RW_LOAD(n0_, 0); ca = n0_a; cbv = n0_b; ck = n0_k; cr = n0_r; cv = n0_v; }
#ifdef RW_DUPSTEPS
        const f32x4 Sa_sv = Sa, Sb_sv = Sb;
        for (int rep_ = 0; rep_ < 2; ++rep_) { if (rep_) { Sa = Sa_sv; Sb = Sb_sv; RW_LOAD(n0_, 0); ca = n0_a; cbv = n0_b; ck = n0_k; cr = n0_r; cv = n0_v; }
#endif
        for (int g = 0; g < ngrp; ++g) {
            float ya[16], yb[16];
#pragma unroll
            for (int j = 0; j < 16; ++j) {
                const int t = 16 * g + j;
                f32x4 na, nb, nk, nr; f32x2 nv;
                RW_LOAD(n, t + 1);
                __builtin_amdgcn_sched_barrier(0);
                const f32x2 a_lo = (f32x2){ca[0], ca[1]}, a_hi = (f32x2){ca[2], ca[3]};
                f32x2 qa = (f32x2){Sa[0], Sa[1]} * a_lo; qa = (f32x2){Sa[2], Sa[3]} * a_hi + qa;
                f32x2 qb = (f32x2){Sb[0], Sb[1]} * a_lo; qb = (f32x2){Sb[2], Sb[3]} * a_hi + qb;
                float pa = qa[0] + qa[1], pb = qb[0] + qb[1];
                const f32x4 ta = Sa + ck * cv[0], tbv = Sb + ck * cv[1];
                pa = row16_sum(pa); pb = row16_sum(pb);
                Sa = ta + cbv * pa; Sb = tbv + cbv * pb;
                const f32x2 r_lo = (f32x2){cr[0], cr[1]}, r_hi = (f32x2){cr[2], cr[3]};
                f32x2 za = (f32x2){Sa[0], Sa[1]} * r_lo; za = (f32x2){Sa[2], Sa[3]} * r_hi + za;
                f32x2 zb = (f32x2){Sb[0], Sb[1]} * r_lo; zb = (f32x2){Sb[2], Sb[3]} * r_hi + zb;
                ya[j] = za[0] + za[1]; yb[j] = zb[0] + zb[1];
                ca = na; cbv = nb; ck = nk; cr = nr; cv = nv;
                __builtin_amdgcn_sched_barrier(0);
            }
            RS_STAGE(8, b0, xch1); RS_STAGE(4, b1, xch2); RS_STAGE(2, b3, xch8); RS_STAGE(1, b2, xch4);
            *(LAS f32x2*)(Yl + (16 * g + jmap) * 64 + r0) = (f32x2){ya[0], yb[0]};
        }
#ifdef RW_DUPSTEPS
        }
#endif
#undef RW_LOAD
        { const f32x4 wl = *(const LAS f32x4*)(WCl + 4 * kp); Sa = Sa * wl; Sb = Sb * wl; }
        __syncthreads();
        if (tt < nvt) {
            const size_t row = (size_t)(rowbase + tb + tt);
            float y[8]; float s = 0.f;
#pragma unroll
            for (int e = 0; e < 8; ++e) { y[e] = Yl[tt * 64 + 8 * part + e]; s += y[e]; }
            s += __shfl_xor(s, 1); s += __shfl_xor(s, 2); s += __shfl_xor(s, 4);
            const float mu = s * (1.f / 64.f); float s2 = 0.f;
#pragma unroll
            for (int e = 0; e < 8; ++e) { y[e] -= mu; s2 += y[e] * y[e]; }
            s2 += __shfl_xor(s2, 1); s2 += __shfl_xor(s2, 2); s2 += __shfl_xor(s2, 4);
            const float rstd = 1.0f / sqrtf(s2 * (1.f / 64.f) + GN_EPS);
            float o[8];
            const float cb = CBl[tt];
#pragma unroll
            for (int e = 0; e < 8; ++e) o[e] = (y[e] * rstd * clg[e] + clb[e] + cb * Vl[tt * 64 + 8 * part + e]) * gcur[e];
            *(GAS u32x4*)(ycat + row * D + hk) = pack8(o);
        }
    }
#undef RW_PREFETCH
    *(GAS f32x4*)(Sout + (size_t)r0 * 64 + 4 * kp) = Sa; *(GAS f32x4*)(Sout + (size_t)(r0 + 1) * 64 + 4 * kp) = Sb;
    __syncthreads();
}


namespace rwc {
constexpr int TB = 64, LD = 66, LDG = 34, LDT = 18;
constexpr int LDB = 72;
constexpr int O_W = 0, O_B = O_W + TB * LD * 4, O_K = O_B + TB * LD * 4, O_V = O_K + TB * LD * 4, O_SB = O_V + TB * LD * 4,
              O_AB = O_SB + 64 * LDB * 2, O_RB = O_AB + TB * LDB * 2, O_BB = O_RB + TB * LDB * 2, O_KB = O_BB + TB * LDB * 2, O_U = O_KB + TB * LDB * 2, O_G = O_U + 16 * LD * 4, O_T = O_G + 4 * 32 * LDG * 4,
              O_WC = O_T + 4 * 16 * LDT * 4, O_CB = O_WC + 4 * 64 * 4, O_VT = O_CB + TB * 4, O_UT = O_VT + 64 * LDB * 2, O_ENDL = O_UT + 64 * 24 * 2;
constexpr int LDU = 24;
constexpr int O_BT = O_B, O_KT = O_K;
constexpr int O_A = O_U;
static_assert(O_A + TB * LD * 4 <= O_WC, "rwkv temp alias");
static_assert(O_ENDL <= RING_BYTES, "rwkv chunk lds");
template <int K> __device__ __forceinline__ f32x4 mm(f32x4 acc, const LAS float* pa, int sak, const LAS float* pb, int sbk) {
    float a[K / 4], b[K / 4];
#pragma unroll
    for (int s4 = 0; s4 < K / 4; ++s4) { a[s4] = pa[4 * s4 * sak]; b[s4] = pb[4 * s4 * sbk]; }
    __builtin_amdgcn_sched_barrier(0);
#pragma unroll
    for (int s4 = 0; s4 < K / 4; ++s4) acc = __builtin_amdgcn_mfma_f32_16x16x4f32(a[s4], b[s4], acc, 0, 0, 0);
    return acc;
}
}
template <bool PUB, bool BAT = false>
__device__ __forceinline__ void rwkv_job_c(Frame& F, const Args& args, int rowbase, int T, int h, const float* S0, float* Sout, unsigned* prog = nullptr, size_t sstride = 0) {
    using namespace rwc;
    const int tid = F.tid, lane = F.lane, w = F.wave, q0 = lane >> 4, c0 = lane & 15;
    LAS unsigned char* L = F.lds;
    LAS float* Wl = (LAS float*)(L + O_W); LAS float* Al = (LAS float*)(L + O_A); LAS float* Bl = (LAS float*)(L + O_B); LAS float* Kl = (LAS float*)(L + O_K);
    LAS bf16_t* Bb = (LAS bf16_t*)(L + O_BB); LAS bf16_t* Kb = (LAS bf16_t*)(L + O_KB); LAS bf16_t* BTb = (LAS bf16_t*)(L + O_BT); LAS bf16_t* KTb = (LAS bf16_t*)(L + O_KT); LAS bf16_t* VTb = (LAS bf16_t*)(L + O_VT); LAS bf16_t* UTb = (LAS bf16_t*)(L + O_UT); LAS float* Vl = (LAS float*)(L + O_V); LAS bf16_t* Sb = (LAS bf16_t*)(L + O_SB); LAS bf16_t* Ab = (LAS bf16_t*)(L + O_AB); LAS bf16_t* Rb = (LAS bf16_t*)(L + O_RB); LAS float* UL = (LAS float*)(L + O_U);
    LAS float* GL = (LAS float*)(L + O_G); LAS float* TL = (LAS float*)(L + O_T); LAS float* WCl = (LAS float*)(L + O_WC); LAS float* CBl = (LAS float*)(L + O_CB);
    LAS float* Yl = Wl;
    const bf16_t* rb = (const bf16_t*)(F.ws + WS_RKV); const bf16_t* kb = rb + (size_t)MP * D; const bf16_t* vb = kb + (size_t)MP * D;
    const float* wd = (const float*)(F.ws + WS_WDEC); const bf16_t* ab = (const bf16_t*)(F.ws + WS_AG); const bf16_t* gb = (const bf16_t*)(F.ws + WS_GG);
    bf16_t* ycat = (bf16_t*)(F.ws + WS_YCAT);
    const int rt = w >> 1, kh = w & 1;
    f32x4 st[2];
#pragma unroll
    for (int e = 0; e < 2; ++e)
#pragma unroll
        for (int r = 0; r < 4; ++r) st[e][r] = S0 ? S0[(size_t)(16 * rt + 4 * q0 + r) * 64 + 16 * (2 * kh + e) + c0] : 0.f;
    const int tt = tid >> 3, part = tid & 7, hk = h * 64 + 8 * part;
    float ckk[8], cka[8], crk[8], clg[8], clb[8];
#pragma unroll
    for (int e = 0; e < 8; ++e) { ckk[e] = args.in[I_KK][hk + e]; cka[e] = args.in[I_KA][hk + e]; crk[e] = args.in[I_RK][hk + e]; clg[e] = args.in[I_LNXG][hk + e]; clb[e] = args.in[I_LNXB][hk + e]; }
    u32x4 q_r = (u32x4){0u, 0u, 0u, 0u}, q_k = q_r, q_v = q_r, q_a = q_r, q_g = q_r; f32x4 q_w0 = (f32x4){0.f, 0.f, 0.f, 0.f}, q_w1 = q_w0;
#define RW_PREFETCH(tb_) do { if (BAT ? ((tb_) == 0 && (tt & 15) < DS) : ((tb_) + tt < T)) { const size_t row_ = BAT ? (size_t)(rowbase + (tt >> 4) * DS + (tt & 15)) : (size_t)(rowbase + (tb_) + tt); \
        q_r = *(const GAS u32x4*)(rb + row_ * D + hk); q_k = *(const GAS u32x4*)(kb + row_ * D + hk); q_v = *(const GAS u32x4*)(vb + row_ * D + hk); q_a = *(const GAS u32x4*)(ab + row_ * D + hk); \
        q_g = *(const GAS u32x4*)(gb + row_ * D + hk); q_w0 = *(const GAS f32x4*)(wd + row_ * D + hk); q_w1 = *(const GAS f32x4*)(wd + row_ * D + hk + 4); } } while (0)
    RW_PREFETCH(0);
    for (int tb = 0; tb < T; tb += TB) {
        int q = q0, c = c0; asm volatile("" : "+v"(q), "+v"(c));
        const int nvt = (T - tb) < TB ? (T - tb) : TB;
        const int nch = (nvt + 15) >> 4;
        __syncthreads();
        float gcur[8];
        {
            const int o = tt * LD + 8 * part;
            if (BAT ? ((tt & 15) < DS) : (tt < nvt)) {
                float r[8], k[8], v[8], a[8], wv[8];
                unpack8(q_r, r); unpack8(q_k, k); unpack8(q_v, v); unpack8(q_a, a); unpack8(q_g, gcur);
#pragma unroll
                for (int e = 0; e < 4; ++e) { wv[e] = q_w0[e]; wv[4 + e] = q_w1[e]; }
                float kkv[8], ss = 0.f, cb = 0.f, kp2[8];
#pragma unroll
                for (int e = 0; e < 8; ++e) { kkv[e] = k[e] * ckk[e]; ss += kkv[e] * kkv[e]; kp2[e] = k[e] * (1.0f + (a[e] - 1.0f) * cka[e]); cb += r[e] * kp2[e] * crk[e]; }
                ss += __shfl_xor(ss, 1); ss += __shfl_xor(ss, 2); ss += __shfl_xor(ss, 4);
                cb += __shfl_xor(cb, 1); cb += __shfl_xor(cb, 2); cb += __shfl_xor(cb, 4);
                const float inv = 1.0f / fmaxf(sqrtf(ss), 1e-12f);
#pragma unroll
                for (int e = 0; e < 8; ++e) { const float kk = kkv[e] * inv; Wl[o + e] = wv[e]; Al[o + e] = -kk; Bl[o + e] = kk * a[e]; Kl[o + e] = kp2[e]; Vl[o + e] = v[e]; }
                *(LAS u32x4*)(Rb + tt * LDB + 8 * part) = q_r;
                if (part == 0) CBl[tt] = cb;
            } else {
#pragma unroll
                for (int e = 0; e < 8; ++e) { Wl[o + e] = 1.f; Al[o + e] = 0.f; Bl[o + e] = 0.f; Kl[o + e] = 0.f; Vl[o + e] = 0.f; gcur[e] = 0.f; }
                *(LAS u32x4*)(Rb + tt * LDB + 8 * part) = (u32x4){0u, 0u, 0u, 0u};
            }
        }
        RW_PREFETCH(tb + TB);
        __syncthreads();
        {
            const int kk_ = tid & 63, sg_ = tid >> 6;
            float bin[8], kin[8];
            {
                unsigned vt[4];
#pragma unroll
                for (int e = 0; e < 8; ++e) { const int o_ = (8 * sg_ + e) * LD + kk_; bin[e] = Bl[o_]; kin[e] = Kl[o_]; const unsigned vb_ = f2bf(Vl[o_]); if (e & 1) vt[e >> 1] |= vb_ << 16; else vt[e >> 1] = vb_; }
                *(LAS u32x4*)(VTb + kk_ * LDB + 8 * sg_) = (u32x4){vt[0], vt[1], vt[2], vt[3]};
            }
            __syncthreads();
            float wseg[8]; float wc = 1.f;
#pragma unroll
            for (int e = 0; e < 8; ++e) wseg[e] = Wl[(8 * sg_ + e) * LD + kk_];
            if (sg_ & 1) {
#pragma unroll
                for (int e = 0; e < 8; ++e) wc *= Wl[(8 * (sg_ - 1) + e) * LD + kk_];
            }
            unsigned bt[4], kt4[4];
#pragma unroll
            for (int e = 0; e < 8; ++e) { const int o_ = (8 * sg_ + e) * LD + kk_; const int ob_ = (8 * sg_ + e) * LDB + kk_;
                const float av = Al[o_] * wc; wc *= wseg[e]; const float iw = __builtin_amdgcn_rcpf(wc); const float bv = bin[e] * iw, kv = kin[e] * iw, rv = bf2f(Rb[ob_]) * wc;
                const unsigned bb_ = f2bf(bv), kb_ = f2bf(kv);
                Ab[ob_] = (bf16_t)f2bf(av); Rb[ob_] = (bf16_t)f2bf(rv); Bb[ob_] = (bf16_t)bb_; Kb[ob_] = (bf16_t)kb_;
                if (e & 1) { bt[e >> 1] |= bb_ << 16; kt4[e >> 1] |= kb_ << 16; } else { bt[e >> 1] = bb_; kt4[e >> 1] = kb_; } }
            *(LAS u32x4*)(BTb + kk_ * LDB + 8 * sg_) = (u32x4){bt[0], bt[1], bt[2], bt[3]};
            *(LAS u32x4*)(KTb + kk_ * LDB + 8 * sg_) = (u32x4){kt4[0], kt4[1], kt4[2], kt4[3]};
            if (sg_ & 1) WCl[(sg_ >> 1) * 64 + kk_] = wc;
        }
        __syncthreads();
        {
            const int gc = w >> 1, mt = w & 1; const int t0 = 16 * gc;
            const LAS bf16_t* pa = (mt ? Rb : Ab) + (t0 + c) * LDB + 8 * q;
            const bf16x8 a0 = *(const LAS bf16x8*)pa, a1 = *(const LAS bf16x8*)(pa + 32);
#pragma unroll
            for (int nt = 0; nt < 2; ++nt) {
                const LAS bf16_t* pb = (nt ? Kb : Bb) + (t0 + c) * LDB + 8 * q;
                const bf16x8 b0 = *(const LAS bf16x8*)pb, b1 = *(const LAS bf16x8*)(pb + 32);
                f32x4 g = __builtin_amdgcn_mfma_f32_16x16x32_bf16(a0, b0, (f32x4){0.f, 0.f, 0.f, 0.f}, 0, 0, 0);
                g = __builtin_amdgcn_mfma_f32_16x16x32_bf16(a1, b1, g, 0, 0, 0);
#pragma unroll
                for (int r = 0; r < 4; ++r) { const int t = 4 * q + r; const bool keep = mt ? (c <= t) : (c < t); GL[gc * 32 * LDG + (16 * mt + t) * LDG + 16 * nt + c] = keep ? g[r] : 0.f; }
            }
        }
        __syncthreads();
        if (w == 0) {
            float tr[16];
            const LAS float* Lg = GL + q * 32 * LDG;
#pragma unroll
            for (int t = 0; t < 16; ++t) { float acc = (t == c) ? 1.f : 0.f;
#pragma unroll
                for (int i = 0; i < t; ++i) acc += Lg[t * LDG + i] * tr[i];
                tr[t] = acc; TL[q * 16 * LDT + t * LDT + c] = acc; }
        }
#pragma unroll
        for (int e = 0; e < 2; ++e)
#pragma unroll
            for (int r = 0; r < 4; ++r) Sb[(16 * rt + 4 * q + r) * LDB + 16 * (2 * kh + e) + c] = (bf16_t)f2bf(st[e][r]);
        if (PUB) asm volatile("s_waitcnt vmcnt(0)" ::: "memory");
        __syncthreads();
        if (PUB && tid == 0 && tb > 0) __hip_atomic_store(prog, (unsigned)tb, __ATOMIC_RELAXED, __HIP_MEMORY_SCOPE_AGENT);
        for (int ch = 0; ch < nch; ++ch) {
            const int t0 = 16 * ch;
            const int xm = w >> 2, nt = w & 3;
            f32x4 x;
            {
                const LAS bf16_t* xa = (xm ? Rb : Ab) + (t0 + c) * LDB + 8 * q; const LAS bf16_t* xs = Sb + (16 * nt + c) * LDB + 8 * q;
                const bf16x8 a0 = *(const LAS bf16x8*)xa, a1 = *(const LAS bf16x8*)(xa + 32), s0 = *(const LAS bf16x8*)xs, s1 = *(const LAS bf16x8*)(xs + 32);
                x = __builtin_amdgcn_mfma_f32_16x16x32_bf16(a0, s0, (f32x4){0.f, 0.f, 0.f, 0.f}, 0, 0, 0);
                x = __builtin_amdgcn_mfma_f32_16x16x32_bf16(a1, s1, x, 0, 0, 0);
            }
            const LAS float* Gc = GL + ch * 32 * LDG;
            if (xm == 0) {
                x = mm<16>(x, Gc + c * LDG + 16 + q, 1, Vl + (t0 + q) * LD + 16 * nt + c, LD);
#pragma unroll
                for (int r = 0; r < 4; ++r) UL[(4 * q + r) * LD + 16 * nt + c] = x[r];
                f32x4 u = mm<16>((f32x4){0.f, 0.f, 0.f, 0.f}, TL + ch * 16 * LDT + c * LDT + q, 1, UL + q * LD + 16 * nt + c, LD);
#pragma unroll
                for (int r = 0; r < 4; ++r) UL[(4 * q + r) * LD + 16 * nt + c] = u[r];
                *(LAS u32x2*)(UTb + (16 * nt + c) * LDU + 4 * q) = (u32x2){pk2(u[0], u[1]), pk2(u[2], u[3])};
            }
            __syncthreads();
            if (xm == 1) {
                x = mm<16>(x, Gc + (16 + c) * LDG + q, 1, UL + q * LD + 16 * nt + c, LD);
                x = mm<16>(x, Gc + (16 + c) * LDG + 16 + q, 1, Vl + (t0 + q) * LD + 16 * nt + c, LD);
#pragma unroll
                for (int r = 0; r < 4; ++r) Yl[(t0 + 4 * q + r) * LD + 16 * nt + c] = x[r];
            }
            {
                const LAS bf16_t* pf = (q < 2) ? UTb + (16 * rt + c) * LDU + 8 * q : VTb + (16 * rt + c) * LDB + t0 + 8 * (q - 2);
                const bf16x8 uvf = *(const LAS bf16x8*)pf;
#pragma unroll
                for (int e = 0; e < 2; ++e) {
                    const int kt = 2 * kh + e;
                    const LAS bf16_t* ps = (q < 2) ? BTb + (16 * kt + c) * LDB + t0 + 8 * q : KTb + (16 * kt + c) * LDB + t0 + 8 * (q - 2);
                    const bf16x8 bkf = *(const LAS bf16x8*)ps;
                    st[e] = __builtin_amdgcn_mfma_f32_16x16x32_bf16(uvf, bkf, st[e], 0, 0, 0);
                    const float wcv = WCl[ch * 64 + 16 * kt + c];
                    st[e] = st[e] * wcv;
                }
            }
            if (BAT) {
#pragma unroll
                for (int e = 0; e < 2; ++e)
#pragma unroll
                    for (int r = 0; r < 4; ++r) Sout[(size_t)ch * sstride + (size_t)(16 * rt + 4 * q + r) * 64 + 16 * (2 * kh + e) + c] = st[e][r];
                if (ch + 1 < nch) {
#pragma unroll
                    for (int e = 0; e < 2; ++e)
#pragma unroll
                        for (int r = 0; r < 4; ++r) st[e][r] = S0[(size_t)(ch + 1) * sstride + (size_t)(16 * rt + 4 * q + r) * 64 + 16 * (2 * kh + e) + c];
                }
            }
            if (ch + 1 < nch) {
#pragma unroll
                for (int e = 0; e < 2; ++e)
#pragma unroll
                    for (int r = 0; r < 4; ++r) Sb[(16 * rt + 4 * q + r) * LDB + 16 * (2 * kh + e) + c] = (bf16_t)f2bf(st[e][r]);
            }
            __syncthreads();
        }
        if (BAT ? ((tt & 15) < DS) : (tt < nvt)) {
            const size_t row = BAT ? (size_t)(rowbase + (tt >> 4) * DS + (tt & 15)) : (size_t)(rowbase + tb + tt);
            float y[8]; float s = 0.f;
#pragma unroll
            for (int e = 0; e < 8; ++e) { y[e] = Yl[tt * LD + 8 * part + e]; s += y[e]; }
            s += __shfl_xor(s, 1); s += __shfl_xor(s, 2); s += __shfl_xor(s, 4);
            const float mu = s * (1.f / 64.f); float s2 = 0.f;
#pragma unroll
            for (int e = 0; e < 8; ++e) { y[e] -= mu; s2 += y[e] * y[e]; }
            s2 += __shfl_xor(s2, 1); s2 += __shfl_xor(s2, 2); s2 += __shfl_xor(s2, 4);
            const float rstd = 1.0f / sqrtf(s2 * (1.f / 64.f) + GN_EPS);
            float o[8];
            const float cb = CBl[tt];
#pragma unroll
            for (int e = 0; e < 8; ++e) o[e] = (y[e] * rstd * clg[e] + clb[e] + cb * Vl[tt * LD + 8 * part + e]) * gcur[e];
            if (PUB) { const u32x4 yv = pack8(o); const bf16_t* yp = ycat + row * D + hk; asm volatile("global_store_dwordx4 %0, %1, off sc1" :: "v"(yp), "v"(yv) : "memory"); }
            else *(GAS u32x4*)(ycat + row * D + hk) = pack8(o);
        }
    }
#undef RW_PREFETCH
    if (!BAT)
#pragma unroll
    for (int e = 0; e < 2; ++e)
#pragma unroll
        for (int r = 0; r < 4; ++r) Sout[(size_t)(16 * rt + 4 * q0 + r) * 64 + 16 * (2 * kh + e) + c0] = st[e][r];
    if (PUB) asm volatile("s_waitcnt vmcnt(0)" ::: "memory");
    __syncthreads();
    if (PUB && tid == 0) __hip_atomic_store(prog, (unsigned)T, __ATOMIC_RELAXED, __HIP_MEMORY_SCOPE_AGENT);
}
__global__ void __launch_bounds__(NTHREADS, 2) mega_fwd(Args args) {
    extern __shared__ __attribute__((aligned(16))) unsigned char lds_raw[];
    Frame F;
    F.lds = (LAS unsigned char*)lds_raw;
    F.out = args.out; F.ws = args.ws;
    F.tid = threadIdx.x; F.lane = F.tid & 63; F.wave = __builtin_amdgcn_readfirstlane(F.tid >> 6);
    F.G = gridDim.x; { const int bx = blockIdx.x; const int vcu = (F.G % 8 == 0) ? (bx % 8) * (F.G / 8) + bx / 8 : bx; F.gw = vcu * NWAVES + F.wave; }
    F.NGW = F.G * NWAVES;
    volatile LAS unsigned* MISC = (volatile LAS unsigned*)(F.lds + MISC_OFF);
    for (int u = F.tid; u < (LDS_BYTES - LDSCTL_OFF) / 4; u += NTHREADS) ((LAS unsigned*)(F.lds + LDSCTL_OFF))[u] = 0u;
    __syncthreads();
    unsigned* ctl = (unsigned*)(F.ws + WS_CTL);
    XcdBarrier bar = xcd_barrier_post(ctl + CW_BAR, MISC + 8);
    const int lo = args.ph_lo, hi = args.ph_hi;
#ifndef PHASE_MASK
#define PHASE_MASK 0x1ffffu
#endif
#define IN(k) (((PHASE_MASK >> (k)) & 1u) && lo <= (k) && (k) < hi)
#define SEAM(k) do { if (IN(k) && IN((k) + 1)) xcd_barrier(bar); } while (0)
#ifndef DUP_MASK
#define DUP_MASK 0u
#endif
#define RUNPH(k, ...) if (IN(k)) { __VA_ARGS__; if ((DUP_MASK >> (k)) & 1u) { xcd_barrier(bar); __VA_ARGS__; } }

    const int vcu = F.gw >> 3;
    unsigned char* ws = F.ws;
    RUNPH(0, { p0_prologue(F, args); __syncthreads(); p0_rows(F, args); })
    SEAM(0);
    RUNPH(1, pg8::gemm_phase<1u << pg8::EM_BF16>(F.lds, c_ph[0], ws, args.in[I_W0], args.in[I_A0], F.G, (int)blockIdx.x, ctl + CW_SPLIT + 1 * 256, MISC + 16);)
    SEAM(1);
    RUNPH(2, {    \
        if (vcu < 128) { mlstm_prompt_job(F, args, vcu); } \
        else { for (int j = vcu - 128; j < 384; j += 128) { if (j < 128) rglru_job(F, args, 0, j >> 5, (j >> 2) & 7, j & 3); else { const int k = j - 128; rglru_job(F, args, 1, k >> 5, (k >> 2) & 7, k & 3); } } \
               for (int j = vcu - 128; j < DB * NHA; j += 128) mlstm_sample_job(F, args, j); } \
    })
    SEAM(2);
    RUNPH(3, headnorm_pass(F, args);)
    SEAM(3);
    RUNPH(4, { pg8::gemm_phase<1u << pg8::EM_RESID>(F.lds, c_ph[1], ws, args.in[I_W0], args.in[I_A0], F.G, (int)blockIdx.x, ctl + CW_SPLIT + 4 * 256, MISC + 16); \
        constexpr int BUSY4 = ((MP / 256) * (D / 256) - 256) * 4;       \
        if ((int)blockIdx.x >= BUSY4) { Frame F2 = F; F2.gw = ((int)blockIdx.x - BUSY4) * NWAVES + F.wave; F2.NGW = (F.G - BUSY4) * NWAVES; int cursor = 0; convert_wup(F2, args, 0, cursor, (LAS float*)(F.lds + F.wave * 16896)); } })
    SEAM(4);
    RUNPH(5, ln_pass(F, (const bf16_t*)(ws + WS_ZRES), args.in[I_LN1G], args.in[I_LN1B], (bf16_t*)(ws + WS_HA));)
    SEAM(5);
    RUNPH(6, { pg8::gemm_phase<1u << pg8::EM_RELU2>(F.lds, c_ph[2], ws, args.in[I_W0], args.in[I_A0], F.G, (int)blockIdx.x, ctl + CW_SPLIT + 6 * 256, MISC + 16); \
        constexpr int BUSY6 = (MP / 256) * (DFF / 256) - 4 * 256;       \
        if ((int)blockIdx.x >= BUSY6) { Frame F2 = F; F2.gw = ((int)blockIdx.x - BUSY6) * NWAVES + F.wave; F2.NGW = (F.G - BUSY6) * NWAVES; int cursor = 0; convert_wdn(F2, args, 0, cursor, (LAS float*)(F.lds + F.wave * 16896)); } })
    SEAM(6);
    RUNPH(7, { pg8::gemm_phase<1u << pg8::EM_RESID>(F.lds, c_ph[3], ws, args.in[I_W0], args.in[I_A0], F.G, (int)blockIdx.x, ctl + CW_SPLIT + 7 * 256, MISC + 16); \
        constexpr int BUSY = ((MP / 256) * (D / 256) - 256) * 4;        \
        if ((int)blockIdx.x >= BUSY) { Frame F2 = F; F2.gw = ((int)blockIdx.x - BUSY) * NWAVES + F.wave; F2.NGW = (F.G - BUSY) * NWAVES; convert_rwkv_weights(F2, args, (LAS float*)(F.lds + F.wave * 16896)); } })
    SEAM(7);
    RUNPH(8, ln_mix_pass(F, args, (const bf16_t*)(ws + WS_ZRES), args.in[I_LN2G], args.in[I_LN2B]);)
    SEAM(8);
    RUNPH(9, pg8::gemm_phase<(1u << pg8::EM_BF16) | (1u << pg8::EM_TANH) | (1u << pg8::EM_SIGM)>(F.lds, c_ph[4], ws, args.in[I_W0], args.in[I_A0], F.G, (int)blockIdx.x, ctl + CW_SPLIT + 9 * 256, MISC + 16);)
    SEAM(9);
    RUNPH(10, pg8::gemm_phase<(1u << pg8::EM_BF16) | (1u << pg8::EM_WDEC) | (1u << pg8::EM_ASIG)>(F.lds, c_ph[5], ws, args.in[I_W0], args.in[I_A0], F.G, (int)blockIdx.x, ctl + CW_SPLIT + 10 * 256, MISC + 16);)
    SEAM(10);
    RUNPH(11, {   \
        const int rep_a = ((DUP_MASK >> 17) & 1u) ? 2 : 1; const int rep_b = ((DUP_MASK >> 18) & 1u) ? 2 : 1; \
        if (vcu < NB * NHC) { const int bb = vcu >> 5; const int h = vcu & 31; for (int rep = 0; rep < rep_a; ++rep) rwkv_job_c<true>(F, args, bb * TP, TP, h, nullptr, F.out + O_PS + (size_t)(bb * NHC + h) * HDC * HDC, ctl + CW_PROG + vcu); } \
        else { for (int rep = 0; rep < rep_b; ++rep) for (int j = vcu - NB * NHC; j < (DB / 4) * NHC; j += F.G - NB * NHC) { const int bb = 4 * (j >> 5); const int h = j & 31; \
            rwkv_job_c<false, true>(F, args, MPR + bb * DS, 64, h, args.in[I_RS] + (size_t)(bb * NHC + h) * HDC * HDC, F.out + O_SS + (size_t)(bb * NHC + h) * HDC * HDC, nullptr, (size_t)NHC * HDC * HDC); } \
              \
            asm volatile("s_waitcnt vmcnt(0)" ::: "memory"); __syncthreads(); \
            if (F.tid == 0) { __builtin_amdgcn_fence(__ATOMIC_RELEASE, "agent"); asm volatile("s_waitcnt vmcnt(0)" ::: "memory"); __hip_atomic_fetch_add(ctl + CW_PROG + 256, 1u, __ATOMIC_RELAXED, __HIP_MEMORY_SCOPE_AGENT); } \
            Frame F2 = F; F2.gw = (vcu - NB * NHC) * NWAVES + F.wave; F2.NGW = (F.G - NB * NHC) * NWAVES; int cursor = 0; \
            convert_wup(F2, args, 1, cursor, (LAS float*)(F.lds + F.wave * 16896)); \
            __syncthreads(); \
            pg8::gemm_phase<1u << pg8::EM_RESID, 1>(F.lds, c_ph[7], ws, args.in[I_W0], args.in[I_A0], F.G - NB * NHC, vcu - NB * NHC, ctl + CW_SPLIT + 11 * 256, MISC + 16, ctl + CW_PROG); } \
    })
    SEAM(11);
    RUNPH(12, { pg8::gemm_phase<1u << pg8::EM_RESID>(F.lds, c_ph[6], ws, args.in[I_W0], args.in[I_A0], F.G, (int)blockIdx.x, ctl + CW_SPLIT + 12 * 256, MISC + 16); \
        constexpr int BUSY12 = pg8::N_LATE * (D / 256);                \
        if ((int)blockIdx.x >= BUSY12) { Frame F2 = F; F2.gw = ((int)blockIdx.x - BUSY12) * NWAVES + F.wave; F2.NGW = (F.G - BUSY12) * NWAVES; int cursor = 0; \
            convert_wdn(F2, args, 1, cursor, (LAS float*)(F.lds + F.wave * 16896)); } })
    SEAM(12);
    RUNPH(13, ln_pass(F, (const bf16_t*)(ws + WS_ZRES), args.in[I_LN1G] + D, args.in[I_LN1B] + D, (bf16_t*)(ws + WS_HA));)
    SEAM(13);
    RUNPH(14, pg8::gemm_phase<1u << pg8::EM_RELU2>(F.lds, c_ph[2], ws, args.in[I_W0], args.in[I_A0], F.G, (int)blockIdx.x, ctl + CW_SPLIT + 14 * 256, MISC + 16);)
    SEAM(14);
    RUNPH(15, pg8::gemm_phase<1u << pg8::EM_RESID>(F.lds, c_ph[3], ws, args.in[I_W0], args.in[I_A0], F.G, (int)blockIdx.x, ctl + CW_SPLIT + 15 * 256, MISC + 16);)
    SEAM(15);
    RUNPH(16, ln_final(F, (const bf16_t*)(ws + WS_ZRES), args.in[I_LN2G] + D, args.in[I_LN2B] + D);)
#undef IN
#undef SEAM
}

constexpr int N_PHASES = 17;
extern "C" void kernel_launch(void* const* d_in, const int* in_sizes, int n_in, void* d_out, int out_size, void* d_ws, size_t ws_size, hipStream_t stream) {
    static int grid = 0;
    if (grid == 0) {
        if (n_in != N_IN || (size_t)out_size != O_END || ws_size < WS_END) { fprintf(stderr, "kernel_launch: unexpected sizes n_in %d out %d ws %zu (need %zu)\n", n_in, out_size, ws_size, (size_t)WS_END); grid = -1; return; }
        int dev = 0, cus = 0;
        if (hipGetDevice(&dev) != hipSuccess || hipDeviceGetAttribute(&cus, hipDeviceAttributeMultiprocessorCount, dev) != hipSuccess) { grid = -1; return; }
        if (hipFuncSetAttribute((const void*)mega_fwd, hipFuncAttributeMaxDynamicSharedMemorySize, LDS_BYTES) != hipSuccess) { fprintf(stderr, "kernel_launch: hipFuncSetAttribute failed\n"); grid = -1; return; }
        grid = cus;
    }
    if (grid < 0) return;
    (void)hipMemsetAsync((char*)d_ws + WS_CTL, 0, CTL_ZERO_BYTES, stream);
    Args a{};
    for (int i = 0; i < N_IN; ++i) a.in[i] = (const float*)d_in[i];
    a.out = (float*)d_out; a.ws = (unsigned char*)d_ws;
    a.ph_lo = 0; a.ph_hi = N_PHASES;
    hipLaunchKernelGGL(mega_fwd, dim3(grid), dim3(NTHREADS), LDS_BYTES, stream, a);
}
```

```cpp
#include <hip/hip_runtime.h>
#include <cstdio>
#include <cstdint>

#define GAS __attribute__((address_space(1)))
#define LAS __attribute__((address_space(3)))
typedef unsigned short bf16_t;
typedef short bf16x8 __attribute__((ext_vector_type(8)));
typedef short s16x4 __attribute__((ext_vector_type(4)));
typedef float f32x4 __attribute__((ext_vector_type(4)));
typedef float f32x2 __attribute__((ext_vector_type(2)));
typedef unsigned u32x4 __attribute__((ext_vector_type(4)));
typedef unsigned u32x2 __attribute__((ext_vector_type(2)));

constexpr int D = 2048, NB = 4, SEQ = 2048, NMETA = 16, TP = SEQ + NMETA  , DB = 128, DS = 8;
constexpr int MPR = NB * TP  , MSA = DB * DS  , M = MPR + MSA  , MP = 9472  ;
constexpr int NHA = 4, HDA = 256, MIXA = 1024, RGW = 1024, PROJ = 6152, NZ = 6144, DFF = 8192;
constexpr int NHC = 32, HDC = 64;
constexpr float ALPHA = 1.4142135623730951f;
constexpr float LN_EPS = 1e-5f, GN_EPS = 64e-5f;
constexpr int NWAVES = 8, NTHREADS = 512;

constexpr size_t O_YP = 0, O_YS = O_YP + (size_t)NB * SEQ * D, O_PC = O_YS + (size_t)DB * DS * D, O_PN = O_PC + (size_t)NB * NHA * HDA * HDA,
                 O_PM = O_PN + (size_t)NB * NHA * HDA, O_PH = O_PM + NB * NHA, O_PCV = O_PH + (size_t)NB * RGW, O_PS = O_PCV + (size_t)NB * 3 * RGW,
                 O_PX = O_PS + (size_t)NB * NHC * HDC * HDC, O_SC = O_PX + (size_t)NB * D, O_SN = O_SC + (size_t)DB * NHA * HDA * HDA,
                 O_SM = O_SN + (size_t)DB * NHA * HDA, O_SH = O_SM + DB * NHA, O_SCV = O_SH + (size_t)DB * RGW, O_SS = O_SCV + (size_t)DB * 3 * RGW,
                 O_SX = O_SS + (size_t)DB * NHC * HDC * HDC, O_END = O_SX + (size_t)DB * D;
static_assert(O_END == 71725584, "output size");

enum { I_XP = 0, I_XS, I_MC, I_MN, I_MM, I_RH, I_RC, I_RS, I_RX, I_META, I_WIN, I_BIF, I_MNG, I_CVW, I_CVB, I_WA, I_BA, I_WX, I_BX, I_LAM, I_WOUT,
       I_MU, I_WR, I_WK, I_WV, I_WO, I_W0, I_W1, I_W2, I_A0, I_A1, I_A2, I_G1, I_G2, I_KK, I_KA, I_RK, I_LNXG, I_LNXB, I_LN1G, I_LN1B, I_LN2G, I_LN2B, I_WUP, I_WDN, N_IN };
static_assert(N_IN == 45, "inputs");

constexpr size_t MiB = 1u << 20;
constexpr size_t U37 = (size_t)MP * D * 2;
constexpr size_t WS_CTL = 0, CTL_ZERO_BYTES = 1 * MiB;
constexpr size_t WS_WIN = 1 * MiB;
constexpr size_t WS_WOUT = WS_WIN + 24 * MiB;
constexpr size_t WS_WR = WS_WOUT + 8 * MiB, WS_WK = WS_WR + 8 * MiB, WS_WV = WS_WK + 8 * MiB, WS_WO = WS_WV + 8 * MiB;
constexpr size_t WS_L1 = WS_WO + 8 * MiB;
constexpr size_t WS_L2 = WS_L1 + 3 * MiB;
constexpr size_t WS_WUP = WS_L2 + 3 * MiB;
constexpr size_t WS_WDN = WS_WUP + 32 * MiB;
constexpr size_t WS_ZRES = WS_WDN + 32 * MiB;
constexpr size_t WS_HA = WS_ZRES + U37, WS_HB = WS_HA + U37;
constexpr size_t WS_GATES = WS_HB + U37;
constexpr size_t WS_BIG = WS_GATES + 1 * MiB;
constexpr size_t WS_X0 = WS_BIG, WS_ZIN = WS_X0 + U37, WS_HM = WS_ZIN + (size_t)MP * NZ * 2, WS_CAT = WS_HM + (size_t)MP * MIXA * 2;
constexpr size_t WS_U = WS_BIG;
constexpr size_t WS_XS = WS_BIG;
constexpr size_t WS_RKV = WS_XS + 6 * U37;
constexpr size_t WS_LO1 = WS_RKV + 3 * U37;
constexpr size_t WS_WDEC = WS_XS;
constexpr size_t WS_AG = WS_WDEC + 2 * U37;
constexpr size_t WS_GG = WS_AG + U37;
constexpr size_t WS_YCAT = WS_GG + U37;
constexpr size_t WS_END = WS_LO1 + 3 * (size_t)MP * 256 * 2;
constexpr size_t WS_SLAB = WS_RKV;
static_assert(240 * (size_t)262144 <= 3 * U37, "slab overlay");
static_assert(WS_YCAT + U37 <= WS_RKV, "overlay");
static_assert(WS_CAT + U37 <= WS_END && WS_U + (size_t)MP * DFF * 2 <= WS_END, "big region");

constexpr int CW_BAR = 4096;
constexpr int CW_SPLIT = 16384;
constexpr int CW_PROG = 24576;

__device__ __forceinline__ unsigned f2bf(float f) { unsigned u = __builtin_bit_cast(unsigned, f); return (u + 0x7fffu + ((u >> 16) & 1u)) >> 16; }
__device__ __forceinline__ unsigned pk2(float lo, float hi) { return f2bf(lo) | (f2bf(hi) << 16); }
__device__ __forceinline__ float bf2f(unsigned short b) { return __builtin_bit_cast(float, (unsigned)b << 16); }
__device__ __forceinline__ float bflo(unsigned w) { return __builtin_bit_cast(float, w << 16); }
__device__ __forceinline__ float bfhi(unsigned w) { return __builtin_bit_cast(float, w & 0xffff0000u); }
typedef __bf16 bf16x2_hw __attribute__((ext_vector_type(2)));
__device__ __forceinline__ unsigned cvt_pk_bf16(float lo, float hi) { const f32x2 v = {lo, hi}; const bf16x2_hw b = __builtin_convertvector(v, bf16x2_hw); return __builtin_bit_cast(unsigned, b); }
__device__ __forceinline__ void lds_barrier() { asm volatile("s_waitcnt lgkmcnt(0)" ::: "memory"); __builtin_amdgcn_s_barrier(); asm volatile("" ::: "memory"); }
__device__ __forceinline__ float wave_sum(float v) {
#pragma unroll
    for (int o = 1; o < 64; o <<= 1) v += __shfl_xor(v, o);
    return v;
}
__device__ __forceinline__ float sigmoidf_(float x) { return __builtin_amdgcn_rcpf(1.0f + __expf(-x)); }
__device__ __forceinline__ float softplusf_(float x) { return fmaxf(x, 0.f) + __logf(1.0f + __expf(-fabsf(x))); }
__device__ __forceinline__ float sigm3_(float x) { return __builtin_amdgcn_rcpf(1.0f + __expf(-x)); }
__device__ __forceinline__ float wdecayf_(float x) { return __expf(-0.6065306597126334f * sigm3_(x)); }
__device__ __forceinline__ float tanhf_(float x) { const float e = __expf(2.0f * x); return 1.0f - 2.0f * __builtin_amdgcn_rcpf(e + 1.0f); }
#define LDS_WAIT() asm volatile("s_waitcnt lgkmcnt(0)" ::: "memory")
#define VM_WAIT() asm volatile("s_waitcnt vmcnt(0)" ::: "memory")

#define XB_TMO      128
#define XB_XCNT(j)  (256  + 64 * (j))
#define XB_XSUB(j)  (1280 + 64 * (j))
#define XB_XGEN(j)  (2304 + 64 * (j))
#define XB_TOP      3328
#define XB_TOPGEN   3392
#define XCD_BAR_WORDS 3456
#define XB_SPIN_CAP (1u << 18)
__device__ __forceinline__ unsigned xb_ld(unsigned* p)              { return __hip_atomic_load(p, __ATOMIC_RELAXED, __HIP_MEMORY_SCOPE_AGENT); }
__device__ __forceinline__ unsigned xb_add(unsigned* p, unsigned v) { return __hip_atomic_fetch_add(p, v, __ATOMIC_RELAXED, __HIP_MEMORY_SCOPE_AGENT); }
__device__ __forceinline__ unsigned xb_xcc_id() { return (unsigned)__builtin_amdgcn_s_getreg((3 << 11) | 20) & 0xFu; }
#define XB_SPIN(cond, bar) do { unsigned _sp = 0; while (cond) { __builtin_amdgcn_s_sleep(1); \
    if ((++_sp & 255u) == 0u) { if (xb_ld(&(bar)[XB_TMO])) break; if (_sp > XB_SPIN_CAP) { atomicAdd(&(bar)[XB_TMO], 1u); break; } } } } while (0)
struct XcdBarrier { unsigned* bar; unsigned x; volatile LAS unsigned* st; };
__device__ __forceinline__ XcdBarrier xcd_barrier_post(unsigned* bar, volatile LAS unsigned* st) {
    XcdBarrier b; b.bar = bar; b.x = xb_xcc_id(); b.st = st;
    if (threadIdx.x == 0) (void)xb_add(&bar[XB_XCNT(b.x)], 1u);
    return b;
}
__device__ __forceinline__ void xcd_barrier_complete(unsigned* bar, unsigned x, unsigned& nloc, unsigned& nx) {
    const unsigned G = gridDim.x * gridDim.y * gridDim.z;
    unsigned sum, cnt, mine, sp = 0u;
    for (;;) {
        sum = 0u; cnt = 0u; mine = 0u;
#pragma unroll
        for (unsigned j = 0; j < 16; ++j) { const unsigned c = xb_ld(&bar[XB_XCNT(j)]); sum += c; cnt += (c > 0u) ? 1u : 0u; mine = (j == x) ? c : mine; }
        if (sum == G) break;
        __builtin_amdgcn_s_sleep(1);
        if ((++sp & 255u) == 0u) { if (xb_ld(&bar[XB_TMO])) break; if (sp > XB_SPIN_CAP) { atomicAdd(&bar[XB_TMO], 1u); break; } }
    }
    nloc = mine > 0u ? mine : 1u; nx = cnt > 0u ? cnt : 1u;
}
__device__ __forceinline__ void xcd_barrier(const XcdBarrier& b) {
    asm volatile("s_waitcnt vmcnt(0)" ::: "memory");
    __syncthreads();
    if (threadIdx.x == 0) {
        unsigned* bar = b.bar;
        __builtin_amdgcn_s_waitcnt(0);
        unsigned nloc = b.st[0], nx = b.st[1];
        if (nloc == 0u) { xcd_barrier_complete(bar, b.x, nloc, nx); b.st[0] = nloc; b.st[1] = nx; }
        const unsigned old = xb_add(&bar[XB_XSUB(b.x)], 1u);
        const unsigned gen = old / nloc;
        if (old + 1u == (gen + 1u) * nloc) {
            __builtin_amdgcn_fence(__ATOMIC_RELEASE, "agent");
            asm volatile("s_waitcnt vmcnt(0)" ::: "memory");
            const unsigned og = xb_add(&bar[XB_TOP], 1u);
            const unsigned tg = og / nx;
            if (og + 1u == (tg + 1u) * nx) xb_add(&bar[XB_TOPGEN], 1u);
            else XB_SPIN(xb_ld(&bar[XB_TOPGEN]) == tg, bar);
            __builtin_amdgcn_fence(__ATOMIC_ACQUIRE, "agent");
            xb_add(&bar[XB_XGEN(b.x)], 1u);
            asm volatile("s_waitcnt vmcnt(0)" ::: "memory");
        } else {
            XB_SPIN(xb_ld(&bar[XB_XGEN(b.x)]) == gen, bar);
            __builtin_amdgcn_fence(__ATOMIC_ACQUIRE, "agent");
            asm volatile("s_waitcnt vmcnt(0)" ::: "memory");
        }
    }
    __syncthreads();
}

namespace pg8 {
constexpr int BM = 256, BK = 64, HALF = 128, HTB = HALF * BK * 2, STAGE_BYTES = 8 * HTB, NXCD = 8, WGM = 8;
__host__ __device__ __forceinline__ int lds_byte(int r, int c) { const int st = (r >> 4) * 2 + (c >> 5), rr = r & 15, cc = c & 31, ob = rr * 64 + cc * 2; return st * 1024 + (ob ^ (((ob >> 9) & 1) << 5)); }
__host__ __device__ __forceinline__ void stage_rc(int b, int& R, int& C) { const int st = b / 1024, sb = b % 1024, swz = sb ^ (((sb >> 9) & 1) << 5); R = (st >> 1) * 16 + swz / 64; C = (st & 1) * 32 + (swz % 64) / 2; }
__host__ __device__ __forceinline__ int perm32(int rho) { const int n = rho >> 4, i = rho & 15; return 8 * (i >> 2) + 4 * n + (i & 3); }

struct Unit { int pm, pn, job, split, kpart, tail; };
enum { EM_BF16 = 0, EM_RELU2 = 1, EM_TANH = 2, EM_SIGM = 3, EM_RESID = 4, EM_WDEC = 5, EM_ASIG = 6 };
struct JobC { unsigned A, B, out, aux; int nN, ldc, mode, pad; };
struct PhaseC { int njobs, K, lda, totN, split, pad0, pad1, pad2; JobC job[6]; };
__constant__ int c_plist[2][32] = {
    {33, 34, 35, 36, 0, 25, 17, 9, 1, 26, 18, 10, 2, 27, 19, 11, 0, 0, 0, 0, 0, 0, 0, 0, 0, 0, 0, 0, 0, 0, 0, 0},
    {3, 28, 20, 12, 4, 29, 21, 13, 5, 30, 22, 14, 6, 7, 8, 15, 16, 23, 24, 31, 32, 0, 0, 0, 0, 0, 0, 0, 0, 0, 0, 0}};
constexpr int N_EARLY = 16, N_LATE = 21;
static_assert(N_EARLY + N_LATE == MP / 256, "panel lists");
struct Order {
    int nwg, G, c;
    __device__ __forceinline__ void init(int nM, int totN, int G_, int c_) { nwg = nM * totN; G = G_; c = c_; }
    __device__ __forceinline__ bool next(const PhaseC& P, int i, Unit& u) const {
        long L = (long)i * G + c;
        const int nfull = (nwg / G) * G, sp = P.split;
        if (L >= nwg && !(sp > 1 && L >= nfull)) return false;
        u.split = 1; u.kpart = 0; u.tail = 0;
        if (sp > 1 && L >= nfull) { const int j = (int)(L - nfull); if (j >= (nwg - nfull) * sp) return false; u.split = sp; u.kpart = j % sp; u.tail = j / sp; L = nfull + j / sp; }
        if (P.pad0) { u.pm = c_plist[P.pad0 - 1][(int)L / P.totN]; u.pn = (int)L % P.totN; u.job = 0; return true; }
        int wgid = (int)L; { const int q = nwg / NXCD, r = nwg % NXCD, xcd = wgid % NXCD, off = wgid / NXCD; wgid = (xcd < r ? xcd * (q + 1) : r * (q + 1) + (xcd - r) * q) + off; }
        const int nM = MP / BM, nN = P.totN;
        const int nig = WGM * nN, gid = wgid / nig, fm = gid * WGM, gsz = (nM - fm) < WGM ? (nM - fm) : WGM;
        u.pm = fm + ((wgid % nig) % gsz); int pnv = (wgid % nig) / gsz; int job = 0;
        while (pnv >= P.job[job].nN) { pnv -= P.job[job].nN; ++job; }
        u.pn = pnv; u.job = job; return true;
    }
};

template <int MODE>
__device__ __forceinline__ void epilogue_mode(const f32x4 (&acc)[2][2][4][2], char* outp, const void* aux, int ldc, int row0, int col0) {
#pragma unroll
    for (int ai = 0; ai < 2; ++ai)
#pragma unroll
        for (int m = 0; m < 4; ++m) {
            const int row = row0 + ai * HALF + m * 16;
#pragma unroll
            for (int bj = 0; bj < 2; ++bj) {
                const int col = col0 + bj * HALF;
                f32x4 v0 = acc[ai][bj][m][0], v1 = acc[ai][bj][m][1];
                if (MODE == EM_WDEC) {
                    const float* w0 = (const float*)aux; const f32x4 b0 = *(const f32x4*)(w0 + col), b1 = *(const f32x4*)(w0 + col + 4);
#pragma unroll
                    for (int j = 0; j < 4; ++j) { v0[j] = wdecayf_(v0[j] + b0[j]); v1[j] = wdecayf_(v1[j] + b1[j]); }
                    float* o = (float*)outp + (size_t)row * ldc + col; *(f32x4*)o = v0; *(f32x4*)(o + 4) = v1;
                } else {
                    if (MODE == EM_RELU2) {
#pragma unroll
                        for (int j = 0; j < 4; ++j) {
                            const float a0 = v0[j], a1 = v1[j]; int i0 = __builtin_bit_cast(int, a0), i1 = __builtin_bit_cast(int, a1); i0 = i0 > 0 ? i0 : 0; i1 = i1 > 0 ? i1 : 0;
                            const float x0 = __builtin_bit_cast(float, i0), x1 = __builtin_bit_cast(float, i1); v0[j] = x0 * x0; v1[j] = x1 * x1; }
                    } else if (MODE == EM_TANH) {
#pragma unroll
                        for (int j = 0; j < 4; ++j) { v0[j] = tanhf_(v0[j]); v1[j] = tanhf_(v1[j]); }
                    } else if (MODE == EM_SIGM) {
#pragma unroll
                        for (int j = 0; j < 4; ++j) { v0[j] = sigmoidf_(v0[j]); v1[j] = sigmoidf_(v1[j]); }
                    } else if (MODE == EM_ASIG) {
                        const float* a0 = (const float*)aux; const f32x4 b0 = *(const f32x4*)(a0 + col), b1 = *(const f32x4*)(a0 + col + 4);
#pragma unroll
                        for (int j = 0; j < 4; ++j) { v0[j] = sigm3_(v0[j] + b0[j]); v1[j] = sigm3_(v1[j] + b1[j]); }
                    } else if (MODE == EM_RESID) {
                        const u32x4 r = *(const u32x4*)((const bf16_t*)aux + (size_t)row * D + col);
                        v0[0] += ALPHA * bflo(r.x); v0[1] += ALPHA * bfhi(r.x); v0[2] += ALPHA * bflo(r.y); v0[3] += ALPHA * bfhi(r.y);
                        v1[0] += ALPHA * bflo(r.z); v1[1] += ALPHA * bfhi(r.z); v1[2] += ALPHA * bflo(r.w); v1[3] += ALPHA * bfhi(r.w);
                    }
                    u32x4 w; w.x = cvt_pk_bf16(v0[0], v0[1]); w.y = cvt_pk_bf16(v0[2], v0[3]); w.z = cvt_pk_bf16(v1[0], v1[1]); w.w = cvt_pk_bf16(v1[2], v1[3]);
                    *(u32x4*)((bf16_t*)outp + (size_t)row * ldc + col) = w;
                }
            }
        }
}
template <int MODE>
__device__ __forceinline__ void epi_frag(f32x4 v0, f32x4 v1, char* outp, const void* aux, int ldc, int row, int col) {
    if (MODE == EM_RESID) {
        const u32x4 r = *(const u32x4*)((const bf16_t*)aux + (size_t)row * D + col);
        v0[0] += ALPHA * bflo(r.x); v0[1] += ALPHA * bfhi(r.x); v0[2] += ALPHA * bflo(r.y); v0[3] += ALPHA * bfhi(r.y);
        v1[0] += ALPHA * bflo(r.z); v1[1] += ALPHA * bfhi(r.z); v1[2] += ALPHA * bflo(r.w); v1[3] += ALPHA * bfhi(r.w);
    }
    u32x4 w; w.x = cvt_pk_bf16(v0[0], v0[1]); w.y = cvt_pk_bf16(v0[2], v0[3]); w.z = cvt_pk_bf16(v1[0], v1[1]); w.w = cvt_pk_bf16(v1[2], v1[3]);
    *(u32x4*)((bf16_t*)outp + (size_t)row * ldc + col) = w;
}
template <unsigned MM>
__device__ __forceinline__ void epilogue(const f32x4 (&acc)[2][2][4][2], const Unit& u, const PhaseC& P, unsigned char* ws, const float* w0p, const float* a0p, int wr, int wc, int fr, int fq) {
    const int mode = P.job[u.job].mode, ldc = P.job[u.job].ldc;
    char* outp = (char*)ws + P.job[u.job].out; const void* aux = (mode == EM_WDEC) ? (const void*)w0p : (mode == EM_ASIG) ? (const void*)a0p : (const void*)(ws + P.job[u.job].aux);
    const int row0 = u.pm * BM + wr * 64 + fr, col0 = u.pn * BM + wc * 32 + 8 * fq;
    if ((MM & (1u << EM_WDEC)) && mode == EM_WDEC) epilogue_mode<EM_WDEC>(acc, outp, aux, ldc, row0, col0);
    else if ((MM & (1u << EM_RELU2)) && mode == EM_RELU2) epilogue_mode<EM_RELU2>(acc, outp, aux, ldc, row0, col0);
    else if ((MM & (1u << EM_TANH)) && mode == EM_TANH) epilogue_mode<EM_TANH>(acc, outp, aux, ldc, row0, col0);
    else if ((MM & (1u << EM_SIGM)) && mode == EM_SIGM) epilogue_mode<EM_SIGM>(acc, outp, aux, ldc, row0, col0);
    else if ((MM & (1u << EM_ASIG)) && mode == EM_ASIG) epilogue_mode<EM_ASIG>(acc, outp, aux, ldc, row0, col0);
    else if ((MM & (1u << EM_RESID)) && mode == EM_RESID) epilogue_mode<EM_RESID>(acc, outp, aux, ldc, row0, col0);
    else epilogue_mode<EM_BF16>(acc, outp, aux, ldc, row0, col0);
}

__device__ __forceinline__ void wait_panel(int pm, const unsigned* prog, int wid, int lane) {
    if (wid == 0) {
        unsigned spins = 0;
        if (pm >= 33) { while (__hip_atomic_load(prog + 256, __ATOMIC_RELAXED, __HIP_MEMORY_SCOPE_AGENT) < 128u && ++spins < (1u << 22)) __builtin_amdgcn_s_sleep(8); }
        else { const int b = (256 * pm) / TP; const unsigned need = (unsigned)(256 * pm + 256 - TP * b);
            for (;;) { const unsigned v = __hip_atomic_load(prog + b * 32 + (lane & 31), __ATOMIC_RELAXED, __HIP_MEMORY_SCOPE_AGENT);
                if (__all(v >= need) || ++spins >= (1u << 22)) break; __builtin_amdgcn_s_sleep(8); } }
        __builtin_amdgcn_fence(__ATOMIC_ACQUIRE, "agent"); asm volatile("s_waitcnt vmcnt(0)" ::: "memory");
    }
    asm volatile("s_waitcnt lgkmcnt(0)" ::: "memory"); __builtin_amdgcn_s_barrier(); asm volatile("" ::: "memory");
}
template <unsigned MM, int WAITA = 0>
__device__ __forceinline__ void gemm_phase(LAS unsigned char* lds, const PhaseC& P, unsigned char* ws, const float* w0p, const float* a0p, int G, int c, unsigned* cntw, volatile LAS unsigned* flagw, const unsigned* prog = nullptr) {
    const int tid = threadIdx.x, wid = __builtin_amdgcn_readfirstlane(tid >> 6), lane = tid & 63, wr = wid >> 2, wc = wid & 3, fr = lane & 15, fq = lane >> 4;
    const int K = P.K, nt = K / BK, lda = P.lda; const size_t kpartB = (size_t)(K / P.split) * 2;
    Order S; S.init(P.pad0 ? P.pad1 : MP / BM, P.totN, G, c);
    unsigned voffA[2], voffB[2];
#pragma unroll
    for (int i = 0; i < 2; ++i) { int R, C; stage_rc(tid * 16 + i * 8192, R, C); const int Rb = (R & ~31) + perm32(R & 31);
        voffA[i] = (unsigned)(R * lda + C) * 2u; voffB[i] = (unsigned)(Rb * K + C) * 2u; }
    const size_t kstep = (size_t)(BK * 2);
    const size_t hstepA = (size_t)HALF * lda * 2, hstepB = (size_t)HALF * K * 2;
    const size_t tstepA = 2 * hstepA, tstepB = 2 * hstepB;
    const unsigned ldsw = (unsigned)wid * 1024u;
    const int aoff = lds_byte(wr * 64 + fr, fq * 8), boff = lds_byte(wc * 32 + fr, fq * 8);
#define PG8_SA(b, h) (((b) * 2 + (h)) * HTB)
#define PG8_SB(b, h) ((4 + (b) * 2 + (h)) * HTB)
#define PG8_STAGE(bufoff, gbase, voff) do { _Pragma("unroll") for (int _i = 0; _i < 2; ++_i) \
        __builtin_amdgcn_global_load_lds((const unsigned*)((const char*)(gbase) + (voff)[_i]), (LAS unsigned*)(lds + (bufoff) + ldsw + _i * 8192), 16, 0, 0); } while (0)
#define PG8_LDA(dst, b, h) do { _Pragma("unroll") for (int m = 0; m < 4; ++m) _Pragma("unroll") for (int k = 0; k < 2; ++k) dst[m][k] = *(const LAS bf16x8*)(lds + PG8_SA(b, h) + aoff + m * 2048 + k * 1024); } while (0)
#define PG8_LDB(dst, b, h) do { _Pragma("unroll") for (int n = 0; n < 2; ++n) _Pragma("unroll") for (int k = 0; k < 2; ++k) dst[n][k] = *(const LAS bf16x8*)(lds + PG8_SB(b, h) + boff + n * 2048 + k * 1024); } while (0)
#define PG8_MMA(ai, bj, At, Bt) do { __builtin_amdgcn_s_setprio(1); _Pragma("unroll") for (int m = 0; m < 4; ++m) _Pragma("unroll") for (int n = 0; n < 2; ++n) _Pragma("unroll") for (int k = 0; k < 2; ++k) \
        acc[ai][bj][m][n] = __builtin_amdgcn_mfma_f32_16x16x32_bf16(Bt[n][k], At[m][k], acc[ai][bj][m][n], 0, 0, 0); __builtin_amdgcn_s_setprio(0); } while (0)
#define PG8_WAIT_V(n) asm volatile("s_waitcnt vmcnt(" #n ")" ::: "memory")
#define PG8_WAIT_L(n) asm volatile("s_waitcnt lgkmcnt(" #n ")" ::: "memory")
#define PG8_BAR __builtin_amdgcn_s_barrier()
#define PG8_SCHED __builtin_amdgcn_sched_barrier(0)
    Unit cur, nxt; int ui = 0;
    if (!S.next(P, 0, cur)) return;
    if (WAITA) wait_panel(cur.pm, prog, wid, lane);
    f32x4 acc[2][2][4][2];
#pragma unroll
    for (int a = 0; a < 2; ++a)
#pragma unroll
        for (int b = 0; b < 2; ++b)
#pragma unroll
            for (int m = 0; m < 4; ++m)
#pragma unroll
                for (int n = 0; n < 2; ++n) acc[a][b][m][n] = (f32x4){0.f, 0.f, 0.f, 0.f};
    bf16x8 At[4][2], B0[2][2], B1[2][2];
    const char* cA = (const char*)ws + P.job[cur.job].A + (size_t)cur.pm * tstepA + cur.kpart * kpartB; const char* cB = (const char*)ws + P.job[cur.job].B + (size_t)cur.pn * tstepB + cur.kpart * kpartB;
    PG8_STAGE(PG8_SB(0, 0), cB, voffB); PG8_STAGE(PG8_SB(0, 1), cB + hstepB, voffB); PG8_STAGE(PG8_SA(0, 0), cA, voffA); PG8_STAGE(PG8_SA(0, 1), cA + hstepA, voffA);
    if (wr == 1) PG8_BAR;
    PG8_WAIT_V(2); PG8_BAR;
    PG8_STAGE(PG8_SB(1, 0), cB + kstep, voffB); PG8_STAGE(PG8_SA(1, 0), cA + kstep, voffA); PG8_STAGE(PG8_SB(1, 1), cB + hstepB + kstep, voffB);
    PG8_WAIT_V(6); PG8_BAR;
    for (;;) {
        const bool has_next = S.next(P, ui + 1, nxt);
        if (WAITA && has_next) wait_panel(nxt.pm, prog, wid, lane);
        const char* nA = has_next ? (const char*)ws + P.job[nxt.job].A + (size_t)nxt.pm * tstepA + nxt.kpart * kpartB : cA; const char* nB = has_next ? (const char*)ws + P.job[nxt.job].B + (size_t)nxt.pn * tstepB + nxt.kpart * kpartB : cB;
        const int ntc = nt / cur.split;
        for (int t = 0; t < ntc; t += 2) {
            const bool last = (t == ntc - 2);
            const char* a1 = cA + (size_t)(t + 1) * kstep;
            const char* a2 = last ? nA : cA + (size_t)(t + 2) * kstep; const char* b2 = last ? nB : cB + (size_t)(t + 2) * kstep;
            const char* a3 = a2 + kstep; const char* b3 = b2 + kstep;
            PG8_LDB(B0, 0, 0); PG8_LDB(B1, 0, 1); PG8_SCHED; PG8_LDA(At, 0, 0); PG8_STAGE(PG8_SA(1, 1), a1 + hstepA, voffA);
            PG8_WAIT_V(8); PG8_WAIT_L(0); PG8_BAR; PG8_MMA(0, 0, At, B0); PG8_MMA(0, 1, At, B1); PG8_BAR; PG8_SCHED;
            PG8_LDA(At, 0, 1); PG8_STAGE(PG8_SB(0, 0), b2, voffB); PG8_STAGE(PG8_SB(0, 1), b2 + hstepB, voffB); PG8_STAGE(PG8_SA(0, 0), a2, voffA);
            PG8_WAIT_V(8); PG8_WAIT_L(0); PG8_BAR; PG8_MMA(1, 0, At, B0); PG8_MMA(1, 1, At, B1); PG8_BAR; PG8_SCHED;
            PG8_LDB(B0, 1, 0); PG8_LDB(B1, 1, 1); PG8_SCHED; PG8_LDA(At, 1, 0); PG8_STAGE(PG8_SA(0, 1), a2 + hstepA, voffA);
            PG8_WAIT_V(8); PG8_WAIT_L(0); PG8_BAR; PG8_MMA(0, 0, At, B0); PG8_MMA(0, 1, At, B1); PG8_BAR; PG8_SCHED;
            PG8_LDA(At, 1, 1); PG8_STAGE(PG8_SB(1, 0), b3, voffB); PG8_STAGE(PG8_SB(1, 1), b3 + hstepB, voffB); PG8_STAGE(PG8_SA(1, 0), a3, voffA);
            PG8_WAIT_V(8); PG8_WAIT_L(0); PG8_BAR; PG8_MMA(1, 0, At, B0); PG8_MMA(1, 1, At, B1); PG8_BAR; PG8_SCHED;
        }
        if (wr == 0) PG8_BAR;
        if (cur.split > 1) {
            {
                asm volatile("s_nop 15\n\ts_nop 7" ::: "memory");
                f32x4* sp_ = (f32x4*)(ws + WS_SLAB) + (size_t)(cur.tail * cur.split + cur.kpart) * (32 * NTHREADS) + tid;
#pragma unroll
                for (int a = 0; a < 2; ++a)
#pragma unroll
                    for (int b = 0; b < 2; ++b)
#pragma unroll
                        for (int m = 0; m < 4; ++m)
#pragma unroll
                            for (int n = 0; n < 2; ++n) { asm volatile("global_store_dwordx4 %0, %1, off sc1\n\ts_nop 1" :: "v"(sp_), "v"(acc[a][b][m][n]) : "memory"); sp_ += NTHREADS; asm volatile("" : "+v"(sp_)); }
            }
            asm volatile("s_waitcnt vmcnt(0)" ::: "memory");
            PG8_BAR;
            if (tid == 0) {
                __hip_atomic_fetch_add(cntw + cur.tail, 1u, __ATOMIC_RELAXED, __HIP_MEMORY_SCOPE_AGENT);
                unsigned spins = 0;
                while (__hip_atomic_load(cntw + cur.tail, __ATOMIC_RELAXED, __HIP_MEMORY_SCOPE_AGENT) < (unsigned)cur.split && ++spins < (1u << 22)) __builtin_amdgcn_s_sleep(1);
                __builtin_amdgcn_fence(__ATOMIC_ACQUIRE, "agent"); asm volatile("s_waitcnt vmcnt(0)" ::: "memory");
            }
            asm volatile("" ::: "memory"); PG8_BAR; asm volatile("" ::: "memory");
            {
                const int nreg = 32 / cur.split, i0 = cur.kpart * nreg;
                f32x4 red[16];
#pragma unroll
                for (int r = 0; r < 16; ++r) red[r] = (f32x4){0.f, 0.f, 0.f, 0.f};
                for (int p = 0; p < cur.split; ++p) {
                    const f32x4* sl = (const f32x4*)(ws + WS_SLAB) + (size_t)(cur.tail * cur.split + p) * (32 * NTHREADS) + (size_t)i0 * NTHREADS + tid;
#pragma unroll
                    for (int r = 0; r < 16; ++r) { if (r < nreg) red[r] += *sl; sl += NTHREADS; }
                    asm volatile("" : "+v"(sl));
                }
                const int mode = P.job[cur.job].mode, ldc = P.job[cur.job].ldc;
                char* outp = (char*)ws + P.job[cur.job].out; const void* aux = (const void*)(ws + P.job[cur.job].aux);
                const int row0 = cur.pm * BM + wr * 64 + fr, col0 = cur.pn * BM + wc * 32 + 8 * fq;
#pragma unroll
                for (int pr = 0; pr < 8; ++pr) if (2 * pr < nreg) {
                    const int g = (i0 >> 1) + pr, ai = g >> 3, bj = (g >> 2) & 1, m = g & 3;
                    const int row = row0 + ai * HALF + m * 16, col = col0 + bj * HALF;
                    if ((MM & (1u << EM_RESID)) && mode == EM_RESID) epi_frag<EM_RESID>(red[2 * pr], red[2 * pr + 1], outp, aux, ldc, row, col);
                    else epi_frag<EM_BF16>(red[2 * pr], red[2 * pr + 1], outp, aux, ldc, row, col);
                }
            }
            PG8_BAR;
        } else
        epilogue<MM>(acc, cur, P, ws, w0p, a0p, wr, wc, fr, fq);
        if (!has_next) break;
#pragma unroll
        for (int a = 0; a < 2; ++a)
#pragma unroll
            for (int b = 0; b < 2; ++b)
#pragma unroll
                for (int m = 0; m < 4; ++m)
#pragma unroll
                    for (int n = 0; n < 2; ++n) acc[a][b][m][n] = (f32x4){0.f, 0.f, 0.f, 0.f};
        cur = nxt; cA = nA; cB = nB; ++ui;
        if (wr == 1) PG8_BAR;
    }
    PG8_WAIT_V(0);
    PG8_BAR;
#undef PG8_SA
#undef PG8_SB
#undef PG8_STAGE
#undef PG8_LDA
#undef PG8_LDB
#undef PG8_MMA
#undef PG8_WAIT_V
#undef PG8_WAIT_L
#undef PG8_BAR
#undef PG8_SCHED
}
}


#define JOB(A, B, O, AUX, NN, LDC, MODE) {(unsigned)(A), (unsigned)(B), (unsigned)(O), (unsigned)(AUX), (NN), (LDC), (MODE), 0}
#define NOJOB {0u, 0u, 0u, 0u, 1 << 30, 0, 0, 0}
constexpr size_t LO1S = (size_t)MP * 256 * 2;
__constant__ pg8::PhaseC c_ph[8] = {
      {1, D, D, NZ / 256, 2, 0, 0, 0, {JOB(WS_X0, WS_WIN, WS_ZIN, 0, NZ / 256, NZ, pg8::EM_BF16), NOJOB, NOJOB, NOJOB, NOJOB, NOJOB}},
      {1, D, D, D / 256, 4, 0, 0, 0, {JOB(WS_CAT, WS_WOUT, WS_ZRES, WS_X0, D / 256, D, pg8::EM_RESID), NOJOB, NOJOB, NOJOB, NOJOB, NOJOB}},
      {1, D, D, DFF / 256, 1, 0, 0, 0, {JOB(WS_HA, WS_WUP, WS_U, 0, DFF / 256, DFF, pg8::EM_RELU2), NOJOB, NOJOB, NOJOB, NOJOB, NOJOB}},
      {1, DFF, DFF, D / 256, 4, 0, 0, 0, {JOB(WS_U, WS_WDN, WS_ZRES, WS_HA, D / 256, D, pg8::EM_RESID), NOJOB, NOJOB, NOJOB, NOJOB, NOJOB}},
      {6, D, D, 27, 1, 0, 0, 0, {JOB(WS_XS + 0 * U37, WS_WR, WS_RKV + 0 * U37, 0, 8, D, pg8::EM_BF16), JOB(WS_XS + 2 * U37, WS_WK, WS_RKV + 1 * U37, 0, 8, D, pg8::EM_BF16),
                                    JOB(WS_XS + 3 * U37, WS_WV, WS_RKV + 2 * U37, 0, 8, D, pg8::EM_BF16), JOB(WS_XS + 1 * U37, WS_L1, WS_LO1, 0, 1, 256, pg8::EM_TANH),
                                    JOB(WS_XS + 4 * U37, WS_L1 + 1 * MiB, WS_LO1 + LO1S, 0, 1, 256, pg8::EM_BF16), JOB(WS_XS + 5 * U37, WS_L1 + 2 * MiB, WS_LO1 + 2 * LO1S, 0, 1, 256, pg8::EM_SIGM)}},
      {3, 256, 256, 24, 1, 0, 0, 0, {JOB(WS_LO1, WS_L2, WS_WDEC, 0, 8, D, pg8::EM_WDEC), JOB(WS_LO1 + LO1S, WS_L2 + 1 * MiB, WS_AG, 0, 8, D, pg8::EM_ASIG),
                                      JOB(WS_LO1 + 2 * LO1S, WS_L2 + 2 * MiB, WS_GG, 0, 8, D, pg8::EM_BF16), NOJOB, NOJOB, NOJOB}},
      {1, D, D, D / 256, 1, 2, pg8::N_LATE, 0, {JOB(WS_YCAT, WS_WO, WS_ZRES, WS_HB, D / 256, D, pg8::EM_RESID), NOJOB, NOJOB, NOJOB, NOJOB, NOJOB}},
      {1, D, D, D / 256, 1, 1, pg8::N_EARLY, 0, {JOB(WS_YCAT, WS_WO, WS_ZRES, WS_HB, D / 256, D, pg8::EM_RESID), NOJOB, NOJOB, NOJOB, NOJOB, NOJOB}},
};
static_assert(WS_END < (1ull << 32), "ws offsets fit 32 bits");

constexpr int RING_BYTES = 158720;
constexpr int LDSCTL_OFF = RING_BYTES, MISC_OFF = LDSCTL_OFF + 64;
constexpr int LDS_BYTES = RING_BYTES + 512;

struct Args { const float* in[N_IN]; float* out; unsigned char* ws; int ph_lo, ph_hi; };
struct Frame {
    LAS unsigned char* lds;
    float* out; unsigned char* ws;
    int tid, lane, wave, G, gw, NGW;
};

__device__ __forceinline__ void transpose_item(const float* W, int ldw, int klim, int nsrc0, bf16_t* WT, int ldwt, int ndst0, float scale, LAS float* scr, int kb, int nb, int lane) {
    const int k0 = 64 * kb, n0 = 32 * nb;
#pragma unroll 8
    for (int i = 0; i < 32; ++i) { const int kk = 2 * i + (lane >> 5); const int k = k0 + kk;
        scr[kk * 33 + (lane & 31)] = (k < klim) ? W[(size_t)k * ldw + nsrc0 + n0 + (lane & 31)] * scale : 0.f; }
    LDS_WAIT(); asm volatile("" ::: "memory");
    const int c = lane & 7;
#pragma unroll
    for (int j = 0; j < 4; ++j) { const int n = (lane >> 3) + 8 * j; const LAS float* s = scr + (8 * c) * 33 + n;
        u32x4 o; o.x = pk2(s[0 * 33], s[1 * 33]); o.y = pk2(s[2 * 33], s[3 * 33]); o.z = pk2(s[4 * 33], s[5 * 33]); o.w = pk2(s[6 * 33], s[7 * 33]);
        *(GAS u32x4*)(WT + (size_t)(ndst0 + n0 + n) * ldwt + k0 + 8 * c) = o; }
    LDS_WAIT(); asm volatile("" ::: "memory");
}
__device__ __forceinline__ void transpose_item64(const float* W, int ldw, int nsrc0, bf16_t* WT, int ldwt, int ndst0, float scale, LAS float* scr, int kb, int nb, int lane) {
    const int k0 = 64 * kb, n0 = 64 * nb;
    f32x4 v[16];
#pragma unroll
    for (int i = 0; i < 16; ++i) { const int kk = 4 * i + (lane >> 4); v[i] = *(const GAS f32x4*)(W + (size_t)(k0 + kk) * ldw + nsrc0 + n0 + 4 * (lane & 15)); }
#pragma unroll
    for (int i = 0; i < 16; ++i) { const int kk = 4 * i + (lane >> 4); LAS float* d = scr + kk * 65 + 4 * (lane & 15); d[0] = v[i][0] * scale; d[1] = v[i][1] * scale; d[2] = v[i][2] * scale; d[3] = v[i][3] * scale; }
    LDS_WAIT(); asm volatile("" ::: "memory");
    const int c = lane & 7;
#pragma unroll
    for (int j = 0; j < 8; ++j) { const int n = (lane >> 3) + 8 * j; const LAS float* sp = scr + (8 * c) * 65 + n;
        u32x4 o; o.x = pk2(sp[0 * 65], sp[1 * 65]); o.y = pk2(sp[2 * 65], sp[3 * 65]); o.z = pk2(sp[4 * 65], sp[5 * 65]); o.w = pk2(sp[6 * 65], sp[7 * 65]);
        *(GAS u32x4*)(WT + (size_t)(ndst0 + n0 + n) * ldwt + k0 + 8 * c) = o; }
    LDS_WAIT(); asm volatile("" ::: "memory");
}
__device__ __forceinline__ void convert_matrix64(Frame& F, int& cursor, const float* W, int ldw, int K, int nsrc0, int N, bf16_t* WT, int ldwt, int ndst0, float scale, LAS float* scr) {
    const int nblk = N / 64, kblk = K / 64, items = nblk * kblk;
    int first = (F.gw - cursor % F.NGW + F.NGW) % F.NGW;
    for (int it = first; it < items; it += F.NGW) transpose_item64(W, ldw, nsrc0, WT, ldwt, ndst0, scale, scr, it / nblk, it % nblk, F.lane);
    cursor += items;
}
__device__ __forceinline__ void convert_matrix(Frame& F, int& cursor, const float* W, int ldw, int Ksrc, int Kdst, int nsrc0, int N, bf16_t* WT, int ldwt, int ndst0, float scale, LAS float* scr) {
    const int nblk = N / 32, kblk = Kdst / 64, items = nblk * kblk;
    int first = (F.gw - cursor % F.NGW + F.NGW) % F.NGW;
    for (int it = first; it < items; it += F.NGW) transpose_item(W, ldw, Ksrc, nsrc0, WT, ldwt, ndst0, scale, scr, it / nblk, it % nblk, F.lane);
    cursor += items;
}
__device__ __forceinline__ void convert_wup(Frame& F, const Args& args, int layer, int& cursor, LAS float* scr) {
    convert_matrix64(F, cursor, args.in[I_WUP] + (size_t)layer * D * DFF, DFF, D, 0, DFF, (bf16_t*)(F.ws + WS_WUP), D, 0, 1.f, scr);
}
__device__ __forceinline__ void convert_wdn(Frame& F, const Args& args, int layer, int& cursor, LAS float* scr) {
    convert_matrix64(F, cursor, args.in[I_WDN] + (size_t)layer * DFF * D, D, DFF, 0, D, (bf16_t*)(F.ws + WS_WDN), DFF, 0, 1.f, scr);
}
__device__ __forceinline__ void convert_mlp_weights(Frame& F, const Args& args, int layer, int& cursor, LAS float* scr) {
    convert_wup(F, args, layer, cursor, scr); convert_wdn(F, args, layer, cursor, scr);
}
__device__ __forceinline__ void p0_prologue(Frame& F, const Args& args) {
    LAS float* scr = (LAS float*)(F.lds + F.wave * 16896);
    int cursor = 0;
    const float* win = args.in[I_WIN];
    convert_matrix64(F, cursor, win, PROJ, D, 0, 1024, (bf16_t*)(F.ws + WS_WIN), D, 0, 1.f, scr);
    convert_matrix64(F, cursor, win, PROJ, D, 1024, 1024, (bf16_t*)(F.ws + WS_WIN), D, 1024, 0.0625f, scr);
    convert_matrix64(F, cursor, win, PROJ, D, 2048, 2048, (bf16_t*)(F.ws + WS_WIN), D, 2048, 1.f, scr);
    convert_matrix64(F, cursor, win, PROJ, D, 4104, 2048, (bf16_t*)(F.ws + WS_WIN), D, 4096, 1.f, scr);
    convert_matrix64(F, cursor, args.in[I_WOUT], D, D, 0, D, (bf16_t*)(F.ws + WS_WOUT), D, 0, 1.f, scr);
}
__device__ __forceinline__ void convert_rwkv_weights(Frame& F, const Args& args, LAS float* scr) {
    int cursor = 0;
    convert_matrix64(F, cursor, args.in[I_WR], D, D, 0, D, (bf16_t*)(F.ws + WS_WR), D, 0, 1.f, scr);
    convert_matrix64(F, cursor, args.in[I_WK], D, D, 0, D, (bf16_t*)(F.ws + WS_WK), D, 0, 1.f, scr);
    convert_matrix64(F, cursor, args.in[I_WV], D, D, 0, D, (bf16_t*)(F.ws + WS_WV), D, 0, 1.f, scr);
    convert_matrix64(F, cursor, args.in[I_WO], D, D, 0, D, (bf16_t*)(F.ws + WS_WO), D, 0, 1.f, scr);
    convert_matrix(F, cursor, args.in[I_W1], 96, D, D, 0, 96, (bf16_t*)(F.ws + WS_L1), D, 0, 1.f, scr);
    convert_matrix(F, cursor, args.in[I_A1], 96, D, D, 0, 96, (bf16_t*)(F.ws + WS_L1 + 1 * MiB), D, 0, 1.f, scr);
    convert_matrix(F, cursor, args.in[I_G1], 256, D, D, 0, 256, (bf16_t*)(F.ws + WS_L1 + 2 * MiB), D, 0, 1.f, scr);
    convert_matrix(F, cursor, args.in[I_W2], D, 96, 256, 0, D, (bf16_t*)(F.ws + WS_L2), 256, 0, 1.f, scr);
    convert_matrix(F, cursor, args.in[I_A2], D, 96, 256, 0, D, (bf16_t*)(F.ws + WS_L2 + 1 * MiB), 256, 0, 1.f, scr);
    convert_matrix(F, cursor, args.in[I_G2], D, 256, 256, 0, D, (bf16_t*)(F.ws + WS_L2 + 2 * MiB), 256, 0, 1.f, scr);
    for (int p = F.gw * 64 + F.lane; p < 2 * 40960; p += F.NGW * 64) { const int mtx = p / 40960, q = p % 40960;
        *(GAS u32x4*)(F.ws + WS_L1 + (size_t)mtx * MiB + (size_t)96 * D * 2 + (size_t)q * 16) = (u32x4){0u, 0u, 0u, 0u}; }
}
__device__ __forceinline__ int balanced_row(const Frame& F, int it) {
    const int full = (M / F.NGW) * F.NGW;
    if ((it + 1) * F.NGW <= full) return it * F.NGW + F.gw;
    if (it * F.NGW != full) return M;
    const int r2 = F.wave * F.G + F.gw / NWAVES;
    return (full + r2 < M) ? full + r2 : M;
}
__device__ __forceinline__ void p0_rows(Frame& F, const Args& args) {
    LAS f32x4* Glo = (LAS f32x4*)(F.lds); LAS f32x4* Ghi = (LAS f32x4*)(F.lds + 32768);
    const float* win = args.in[I_WIN];
    for (int k = F.tid; k < D; k += NTHREADS) { const f32x4 a = *(const f32x4*)(win + (size_t)k * PROJ + 4096), b = *(const f32x4*)(win + (size_t)k * PROJ + 4100);
        const int l = (k & 255) >> 2, c = k & 3, j = k >> 8, p = (4 * j + c) * 64 + l; Glo[p] = a; Ghi[p] = b; }
    __syncthreads();
    const float* bif = args.in[I_BIF];
    for (int it_ = 0, row = F.gw; row < M; ++it_, row = balanced_row(F, it_)) {
        const float* src;
        if (row < MPR) { const int b = row / TP, t = row % TP; src = (t < NMETA) ? args.in[I_META] + (size_t)t * D : args.in[I_XP] + ((size_t)b * SEQ + (t - NMETA)) * D; }
        else src = args.in[I_XS] + (size_t)(row - MPR) * D;
        f32x4 v[8]; float g[8];
#pragma unroll
        for (int j = 0; j < 8; ++j) v[j] = *(const GAS f32x4*)(src + 4 * F.lane + 256 * j);
#pragma unroll
        for (int q = 0; q < 8; ++q) g[q] = 0.f;
        GAS u32x2* o8 = (GAS u32x2*)(F.ws + WS_X0 + (size_t)row * D * 2) + F.lane;
#pragma unroll
        for (int j = 0; j < 8; ++j) {
            o8[64 * j] = (u32x2){pk2(v[j][0], v[j][1]), pk2(v[j][2], v[j][3])};
#pragma unroll
            for (int c = 0; c < 4; ++c) { const int p = (4 * j + c) * 64 + F.lane; const f32x4 a = Glo[p], b = Ghi[p]; const float x = v[j][c];
                g[0] += x * a[0]; g[1] += x * a[1]; g[2] += x * a[2]; g[3] += x * a[3]; g[4] += x * b[0]; g[5] += x * b[1]; g[6] += x * b[2]; g[7] += x * b[3]; }
            asm volatile("" ::: "memory");
        }
#pragma unroll
        for (int q = 0; q < 8; ++q) g[q] = wave_sum(g[q]);
        if (F.lane == 0) { float* go = (float*)(F.ws + WS_GATES) + (size_t)row * 8;
#pragma unroll
            for (int q = 0; q < 8; ++q) go[q] = g[q] + bif[q]; }
    }
}


__device__ __forceinline__ void unpack8(const u32x4 w, float (&x)[8]) { x[0] = bflo(w.x); x[1] = bfhi(w.x); x[2] = bflo(w.y); x[3] = bfhi(w.y); x[4] = bflo(w.z); x[5] = bfhi(w.z); x[6] = bflo(w.w); x[7] = bfhi(w.w); }
__device__ __forceinline__ u32x4 pack8(const float (&x)[8]) { u32x4 w; w.x = pk2(x[0], x[1]); w.y = pk2(x[2], x[3]); w.z = pk2(x[4], x[5]); w.w = pk2(x[6], x[7]); return w; }
__device__ __forceinline__ void ln_row_load_norm(const bf16_t* zrow, int lane, float (&x)[4][8]) {
    float s = 0.f;
#pragma unroll
    for (int j = 0; j < 4; ++j) { const u32x4 w = *(const GAS u32x4*)(zrow + 8 * lane + 512 * j); unpack8(w, x[j]);
#pragma unroll
        for (int e = 0; e < 8; ++e) s += x[j][e]; }
    const float mean = wave_sum(s) * (1.f / D); float s2 = 0.f;
#pragma unroll
    for (int j = 0; j < 4; ++j)
#pragma unroll
        for (int e = 0; e < 8; ++e) { x[j][e] -= mean; s2 += x[j][e] * x[j][e]; }
    const float rstd = 1.0f / sqrtf(wave_sum(s2) * (1.f / D) + LN_EPS);
#pragma unroll
    for (int j = 0; j < 4; ++j)
#pragma unroll
        for (int e = 0; e < 8; ++e) x[j][e] *= rstd;
}
__device__ __forceinline__ void stage_lds(LAS float* dst, const float* src, int n, int tid) {
    for (int i = tid * 4; i < n; i += NTHREADS * 4) *(LAS f32x4*)(dst + i) = *(const GAS f32x4*)(src + i);
}
__device__ __forceinline__ void ln_affine(const LAS float* gl, int lane, float (&x)[4][8]) {
#pragma unroll
    for (int j = 0; j < 4; ++j) { const int c = 8 * lane + 512 * j; const f32x4 g0 = *(const LAS f32x4*)(gl + c), g1 = *(const LAS f32x4*)(gl + c + 4), b0 = *(const LAS f32x4*)(gl + D + c), b1 = *(const LAS f32x4*)(gl + D + c + 4);
#pragma unroll
        for (int e = 0; e < 4; ++e) { x[j][e] = x[j][e] * g0[e] + b0[e]; x[j][4 + e] = x[j][4 + e] * g1[e] + b1[e]; } }
}
__device__ __forceinline__ void ln_pass(Frame& F, const bf16_t* z, const float* g, const float* b, bf16_t* out) {
    LAS float* gl = (LAS float*)F.lds; stage_lds(gl, g, D, F.tid); stage_lds(gl + D, b, D, F.tid); __syncthreads();
    for (int it_ = 0, row = F.gw; row < M; ++it_, row = balanced_row(F, it_)) {
        float x[4][8]; ln_row_load_norm(z + (size_t)row * D, F.lane, x); ln_affine(gl, F.lane, x);
#pragma unroll
        for (int j = 0; j < 4; ++j) *(GAS u32x4*)(out + (size_t)row * D + 8 * F.lane + 512 * j) = pack8(x[j]);
    }
}
__device__ __forceinline__ void ln_final(Frame& F, const bf16_t* z, const float* g, const float* b) {
    LAS float* gl = (LAS float*)F.lds; stage_lds(gl, g, D, F.tid); stage_lds(gl + D, b, D, F.tid); __syncthreads();
    for (int it_ = 0, row = F.gw; row < M; ++it_, row = balanced_row(F, it_)) {
        float* dst;
        if (row < MPR) { const int bb = row / TP, t = row % TP; if (t < NMETA) continue; dst = F.out + O_YP + ((size_t)bb * SEQ + (t - NMETA)) * D; }
        else dst = F.out + O_YS + (size_t)(row - MPR) * D;
        const bf16_t* zrow = z + (size_t)row * D;
        float x[8][4]; float s = 0.f;
#pragma unroll
        for (int j = 0; j < 8; ++j) { const u32x2 w = *(const GAS u32x2*)(zrow + 4 * F.lane + 256 * j); x[j][0] = bflo(w.x); x[j][1] = bfhi(w.x); x[j][2] = bflo(w.y); x[j][3] = bfhi(w.y);
            s += (x[j][0] + x[j][1]) + (x[j][2] + x[j][3]); }
        const float mean = wave_sum(s) * (1.f / D); float s2 = 0.f;
#pragma unroll
        for (int j = 0; j < 8; ++j)
#pragma unroll
            for (int e = 0; e < 4; ++e) { x[j][e] -= mean; s2 += x[j][e] * x[j][e]; }
        const float rstd = 1.0f / sqrtf(wave_sum(s2) * (1.f / D) + LN_EPS);
#pragma unroll
        for (int j = 0; j < 8; ++j) { const int c = 4 * F.lane + 256 * j; const f32x4 g0 = *(const LAS f32x4*)(gl + c), b0 = *(const LAS f32x4*)(gl + D + c);
            f32x4 o;
#pragma unroll
            for (int e = 0; e < 4; ++e) o[e] = x[j][e] * rstd * g0[e] + b0[e];
            *(GAS f32x4*)(dst + c) = o; }
    }
}
__device__ __forceinline__ void ln_mix_pass(Frame& F, const Args& args, const bf16_t* z, const float* g, const float* b) {
    LAS float* gl = (LAS float*)F.lds; LAS float* mul = gl + 2 * D;
    stage_lds(gl, g, D, F.tid); stage_lds(gl + D, b, D, F.tid); stage_lds(mul, args.in[I_MU], 6 * D, F.tid); __syncthreads();
    const int body = (4 * F.NGW < M) ? 4 * F.NGW : M, vcu_ = F.gw / NWAVES;
#pragma unroll 1
    for (int k = 0; k < 2; ++k) {
        int row0, nr;
        if (k == 0) { row0 = 4 * F.gw; nr = 4; if (row0 >= body) continue; }
        else { const int r2 = F.wave * F.G + vcu_; if (body + r2 >= M) break; row0 = body + r2; nr = 1; }
        int t0, T; const float* xlast = nullptr; float* shift_out;
        if (row0 < MPR) { const int bb = row0 / TP; t0 = row0 % TP; T = TP; shift_out = F.out + O_PX + (size_t)bb * D; }
        else { const int r = row0 - MPR; const int bb = r / DS; t0 = r % DS; T = DS; xlast = args.in[I_RX] + (size_t)bb * D; shift_out = F.out + O_SX + (size_t)bb * D; }
        float prev[4][8], cur[4][8];
        if (t0 == 0) {
#pragma unroll
            for (int j = 0; j < 4; ++j)
#pragma unroll
                for (int e = 0; e < 8; ++e) prev[j][e] = 0.f;
            if (xlast) {
#pragma unroll
                for (int j = 0; j < 4; ++j) { const f32x4 a = *(const GAS f32x4*)(xlast + 8 * F.lane + 512 * j), c = *(const GAS f32x4*)(xlast + 8 * F.lane + 512 * j + 4);
#pragma unroll
                    for (int e = 0; e < 4; ++e) { prev[j][e] = a[e]; prev[j][4 + e] = c[e]; } }
            }
        } else { ln_row_load_norm(z + (size_t)(row0 - 1) * D, F.lane, prev); ln_affine(gl, F.lane, prev); }
#pragma unroll 1
        for (int r = 0; r < nr; ++r) {
            const int row = row0 + r;
            ln_row_load_norm(z + (size_t)row * D, F.lane, cur); ln_affine(gl, F.lane, cur);
#pragma unroll
            for (int j = 0; j < 4; ++j) *(GAS u32x4*)((bf16_t*)(F.ws + WS_HB) + (size_t)row * D + 8 * F.lane + 512 * j) = pack8(cur[j]);
            if (t0 + r == T - 1) {
#pragma unroll
                for (int j = 0; j < 4; ++j) { GAS f32x4* o = (GAS f32x4*)(shift_out + 8 * F.lane + 512 * j); o[0] = (f32x4){cur[j][0], cur[j][1], cur[j][2], cur[j][3]}; o[1] = (f32x4){cur[j][4], cur[j][5], cur[j][6], cur[j][7]}; }
            }
#pragma unroll 1
            for (int mx = 0; mx < 6; ++mx) {
                bf16_t* dst = (bf16_t*)(F.ws + WS_XS + (size_t)mx * U37) + (size_t)row * D;
#pragma unroll
                for (int j = 0; j < 4; ++j) { const int c = 8 * F.lane + 512 * j; const f32x4 m0 = *(const LAS f32x4*)(mul + mx * D + c), m1 = *(const LAS f32x4*)(mul + mx * D + c + 4);
                    float o[8];
#pragma unroll
                    for (int e = 0; e < 4; ++e) { o[e] = cur[j][e] + (prev[j][e] - cur[j][e]) * m0[e]; o[4 + e] = cur[j][4 + e] + (prev[j][4 + e] - cur[j][4 + e]) * m1[e]; }
                    *(GAS u32x4*)(dst + c) = pack8(o); asm volatile("" ::: "memory"); }
            }
#pragma unroll
            for (int j = 0; j < 4; ++j)
#pragma unroll
                for (int e = 0; e < 8; ++e) prev[j][e] = cur[j][e];
        }
    }
}
__device__ __forceinline__ void headnorm_pass(Frame& F, const Args& args) {
    const float* ng = args.in[I_MNG];
    const bf16_t* hm = (const bf16_t*)(F.ws + WS_HM); const bf16_t* zin = (const bf16_t*)(F.ws + WS_ZIN); bf16_t* cat = (bf16_t*)(F.ws + WS_CAT);
    for (int it_ = 0, row = F.gw; row < M; ++it_, row = balanced_row(F, it_)) {
        const int c = 16 * F.lane;
        float x[16], o[16];
        { const u32x4 w0 = *(const GAS u32x4*)(hm + (size_t)row * MIXA + c), w1 = *(const GAS u32x4*)(hm + (size_t)row * MIXA + c + 8);
          float a[8], bq[8]; unpack8(w0, a); unpack8(w1, bq);
#pragma unroll
          for (int e = 0; e < 8; ++e) { x[e] = a[e]; x[8 + e] = bq[e]; } }
        { const u32x4 w0 = *(const GAS u32x4*)(zin + (size_t)row * NZ + 3072 + c), w1 = *(const GAS u32x4*)(zin + (size_t)row * NZ + 3072 + c + 8);
          float a[8], bq[8]; unpack8(w0, a); unpack8(w1, bq);
#pragma unroll
          for (int e = 0; e < 8; ++e) { o[e] = a[e]; o[8 + e] = bq[e]; } }
        float s = 0.f;
#pragma unroll
        for (int e = 0; e < 16; ++e) s += x[e];
        s += __shfl_xor(s, 1); s += __shfl_xor(s, 2); s += __shfl_xor(s, 4); s += __shfl_xor(s, 8);
        const float mean = s * (1.f / 256.f); float s2 = 0.f;
#pragma unroll
        for (int e = 0; e < 16; ++e) { x[e] -= mean; s2 += x[e] * x[e]; }
        s2 += __shfl_xor(s2, 1); s2 += __shfl_xor(s2, 2); s2 += __shfl_xor(s2, 4); s2 += __shfl_xor(s2, 8);
        const float rstd = 1.0f / sqrtf(s2 * (1.f / 256.f) + LN_EPS);
        float y0[8], y1[8];
#pragma unroll
        for (int e = 0; e < 8; ++e) { y0[e] = x[e] * rstd * ng[c + e] * sigmoidf_(o[e]); y1[e] = x[8 + e] * rstd * ng[c + 8 + e] * sigmoidf_(o[8 + e]); }
        *(GAS u32x4*)(cat + (size_t)row * D + c) = pack8(y0); *(GAS u32x4*)(cat + (size_t)row * D + c + 8) = pack8(y1);
    }
}


namespace ml {
constexpr int NVR = 2, NVT = NVR + 1, SLW = 16 * NVR, NSL = HDA / SLW;
constexpr int QS = 144;
constexpr int CS = 272;
constexpr int LO_QH = 0, LO_KH = LO_QH + 128 * QS * 2, LO_VT = LO_KH + 128 * QS * 2, LO_VW = LO_VT + 16 * NVT * QS * 2, LO_CT = LO_VW + 16 * NVT * QS * 2,
              LO_GF = LO_CT + 16 * NVT * CS * 2, LO_GG = LO_GF + 512, LO_GM = LO_GG + 512, LO_SC = LO_GM + 512, GATE_BLK = 1600, LO_END = LO_GF + 2 * GATE_BLK;
constexpr int LO_PS = LO_QH;
static_assert(LO_END <= RING_BYTES, "mlstm lds");
__device__ __forceinline__ bf16x8 ldfrag(const LAS unsigned char* base, int row, int stride_el, int col) { return *(const LAS bf16x8*)(base + ((size_t)row * stride_el + col) * 2); }
__device__ __forceinline__ s16x4 trread(const LAS unsigned char* p) { typedef short v4i16_t __attribute__((ext_vector_type(4))); return __builtin_bit_cast(s16x4, __builtin_amdgcn_ds_read_tr16_b64_v4i16((LAS v4i16_t*)p)); }
}
__device__ __forceinline__ float log_sigmoidf_(float x) { return fminf(x, 0.f) - __logf(1.0f + __expf(-fabsf(x))); }
template <int CTRL> __device__ __forceinline__ float dpp_fill(float fill, float v) { return __builtin_bit_cast(float, __builtin_amdgcn_update_dpp(__builtin_bit_cast(int, fill), __builtin_bit_cast(int, v), CTRL, 0xf, 0xf, false)); }
__device__ __forceinline__ float wave_scan_sum(float v, int lane) {
    v += dpp_fill<0x111>(0.f, v); v += dpp_fill<0x112>(0.f, v); v += dpp_fill<0x114>(0.f, v); v += dpp_fill<0x118>(0.f, v);
    const int b = __builtin_bit_cast(int, v);
    const float t0 = __builtin_bit_cast(float, __builtin_amdgcn_readlane(b, 15)), t1 = __builtin_bit_cast(float, __builtin_amdgcn_readlane(b, 31)), t2 = __builtin_bit_cast(float, __builtin_amdgcn_readlane(b, 47));
    const int q = lane >> 4;
    return v + ((q >= 1 ? t0 : 0.f) + (q >= 2 ? t1 : 0.f) + (q >= 3 ? t2 : 0.f));
}
__device__ __forceinline__ float wave_scan_max(float v, int lane) {
    v = fmaxf(v, dpp_fill<0x111>(-3e38f, v)); v = fmaxf(v, dpp_fill<0x112>(-3e38f, v)); v = fmaxf(v, dpp_fill<0x114>(-3e38f, v)); v = fmaxf(v, dpp_fill<0x118>(-3e38f, v));
    const int b = __builtin_bit_cast(int, v);
    const float t0 = __builtin_bit_cast(float, __builtin_amdgcn_readlane(b, 15)), t1 = __builtin_bit_cast(float, __builtin_amdgcn_readlane(b, 31)), t2 = __builtin_bit_cast(float, __builtin_amdgcn_readlane(b, 47));
    const int q = lane >> 4;
    return fmaxf(v, fmaxf(fmaxf(q >= 1 ? t0 : -3e38f, q >= 2 ? t1 : -3e38f), q >= 3 ? t2 : -3e38f));
}
__device__ __forceinline__ void mlstm_prompt_job(Frame& F, const Args& args, int jid) {
    using namespace ml;
    const int b = jid / (NHA * NSL), h = (jid / NSL) % NHA, sl = jid % NSL;
    const int tid = F.tid, lane = F.lane, w = F.wave, q = lane >> 4, c = lane & 15;
    LAS unsigned char* L = F.lds;
    const bf16_t* zin = (const bf16_t*)(F.ws + WS_ZIN); const float* gates = (const float*)(F.ws + WS_GATES);
    bf16_t* hm = (bf16_t*)(F.ws + WS_HM);
    const int rb = b * TP;
    for (int i = tid; i < (LO_GF - LO_VT) / 4; i += NTHREADS) ((LAS unsigned*)(L + LO_VT))[i] = 0u;
    f32x4 st[2][NVT];
#pragma unroll
    for (int a = 0; a < 2; ++a)
#pragma unroll
        for (int v = 0; v < NVT; ++v) st[a][v] = (f32x4){0.f, 0.f, 0.f, 0.f};
    float m_run = 0.f;
    float gq_i0 = -1e30f, gq_i1 = -1e30f, gq_f0 = 1e30f, gq_f1 = 1e30f, m_gate = 0.f;
#define ML_GATES_LOAD(chn_) do { const int r0n_ = ((chn_) == 0) ? 0 : 16 + 128 * ((chn_) - 1), Lcn_ = ((chn_) == 0) ? 16 : 128; const size_t gr_ = (size_t)(rb + r0n_); \
        gq_i0 = -1e30f; gq_i1 = -1e30f; gq_f0 = 1e30f; gq_f1 = 1e30f; \
        if (2 * lane < Lcn_) { gq_i0 = gates[(gr_ + 2 * lane) * 8 + h]; gq_f0 = gates[(gr_ + 2 * lane) * 8 + 4 + h]; } \
        if (2 * lane + 1 < Lcn_) { gq_i1 = gates[(gr_ + 2 * lane + 1) * 8 + h]; gq_f1 = gates[(gr_ + 2 * lane + 1) * 8 + 4 + h]; } } while (0)
#define ML_GATES_MATH(buf_) do { LAS float* gF_ = (LAS float*)(L + LO_GF + (buf_) * GATE_BLK); LAS float* gG_ = gF_ + 128; LAS float* gM_ = gF_ + 256; LAS float* sc_ = gF_ + 384; \
        const int j0 = 2 * lane, j1 = 2 * lane + 1; \
        const float lf0 = log_sigmoidf_(gq_f0), lf1 = log_sigmoidf_(gq_f1);         \
        const float ps = wave_scan_sum(lf0 + lf1, lane); \
        const float ex = ps - (lf0 + lf1); \
        const float F0 = ex + lf0, F1 = F0 + lf1; \
        const float g0 = gq_i0 - F0, g1 = gq_i1 - F1; \
        const float pm = wave_scan_max(fmaxf(g0, g1), lane); \
        const float pme = dpp_fill<0x138>(-3e38f, pm);                                \
        const float pm0 = fmaxf(pme, g0), pm1 = fmaxf(pm0, g1); \
        const float M0 = fmaxf(m_gate, pm0), M1 = fmaxf(m_gate, pm1); \
        gF_[j0] = F0; gF_[j1] = F1; gG_[j0] = g0; gG_[j1] = g1; gM_[j0] = M0; gM_[j1] = M1; \
        if (lane == 63) { sc_[0] = m_gate; sc_[1] = M1; sc_[2] = __expf(m_gate - M1); sc_[3] = F1 + M1; } \
        m_gate = __builtin_bit_cast(float, __builtin_amdgcn_readlane(__builtin_bit_cast(int, F1 + M1), 63)); } while (0)
    if (w == 0) { ML_GATES_LOAD(0); ML_GATES_MATH(0); }
    __syncthreads();
    for (int ch = 0; ch < 17; ++ch) {
        const int r0 = (ch == 0) ? 0 : 16 + 128 * (ch - 1), Lc = (ch == 0) ? 16 : 128;
        const int grow = rb + r0;
        LAS float* gF = (LAS float*)(L + LO_GF + (ch & 1) * GATE_BLK); LAS float* gG = gF + 128; LAS float* gM = gF + 256; LAS float* sc = gF + 384;
        if (w == 0 && ch + 1 < 17) ML_GATES_LOAD(ch + 1);
        const float m_old = sc[0], Mlast = sc[1], dec = sc[2], m_new = sc[3];
        {
            const int j = tid >> 2, v8 = (tid & 3) * 8;
            float vv[8];
#pragma unroll
            for (int e = 0; e < 8; ++e) vv[e] = 0.f;
            if (j < Lc) unpack8(*(const GAS u32x4*)(zin + (size_t)(grow + j) * NZ + 2048 + h * 256 + sl * SLW + v8), vv);
            const float we = __expf(gG[j] - Mlast);
#pragma unroll
            for (int e = 0; e < 8; ++e) { ((LAS bf16_t*)(L + LO_VT))[(v8 + e) * QS + j] = (bf16_t)f2bf(vv[e]); ((LAS bf16_t*)(L + LO_VW))[(v8 + e) * QS + j] = (bf16_t)f2bf(vv[e] * we); }
            if ((tid & 3) == 0) { ((LAS bf16_t*)(L + LO_VT))[SLW * QS + j] = (j < Lc) ? (bf16_t)0x3F80 : (bf16_t)0; ((LAS bf16_t*)(L + LO_VW))[SLW * QS + j] = (bf16_t)f2bf(we); }
        }
        f32x4 accS[8], accR[NVT];
#pragma unroll
        for (int i = 0; i < 8; ++i) accS[i] = (f32x4){0.f, 0.f, 0.f, 0.f};
#pragma unroll
        for (int i = 0; i < NVT; ++i) accR[i] = (f32x4){0.f, 0.f, 0.f, 0.f};
#pragma unroll
        for (int half = 0; half < 2; ++half) {
#pragma unroll
            for (int i = 0; i < 4; ++i) { const int p = tid + NTHREADS * i, row = p >> 4, c16 = p & 15;
                u32x4 qv = (u32x4){0u, 0u, 0u, 0u}, kv = (u32x4){0u, 0u, 0u, 0u};
                if (row < Lc) { const bf16_t* src = zin + (size_t)(grow + row) * NZ + h * 256 + half * 128 + c16 * 8; qv = *(const GAS u32x4*)src; kv = *(const GAS u32x4*)(src + 1024); }
                *(LAS u32x4*)(L + LO_QH + (row * QS + c16 * 8) * 2) = qv; *(LAS u32x4*)(L + LO_KH + (row * QS + c16 * 8) * 2) = kv; }
            __syncthreads();
#pragma unroll
            for (int ks = 0; ks < 4; ++ks) {
                const bf16x8 qf = ldfrag(L + LO_QH, 16 * w + c, QS, 32 * ks + 8 * q);
#pragma unroll
                for (int jt = 0; jt < 8; ++jt) if (jt <= (w | 1)) { const bf16x8 kf = ldfrag(L + LO_KH, 16 * jt + c, QS, 32 * ks + 8 * q); accS[jt] = __builtin_amdgcn_mfma_f32_16x16x32_bf16(kf, qf, accS[jt], 0, 0, 0); }
#pragma unroll
                for (int vt = 0; vt < NVT; ++vt) { const bf16x8 cf = ldfrag(L + LO_CT, 16 * vt + c, CS, half * 128 + 32 * ks + 8 * q); accR[vt] = __builtin_amdgcn_mfma_f32_16x16x32_bf16(cf, qf, accR[vt], 0, 0, 0); }
                asm volatile("" ::: "memory");
            }
#pragma unroll
            for (int vt = 0; vt < NVT; ++vt) st[half][vt] = st[half][vt] * dec;
#pragma unroll
            for (int ks = 0; ks < 4; ++ks) {
                const LAS unsigned char* kp = L + LO_KH + ((32 * ks + 8 * q + (c >> 2)) * QS + 16 * w + 4 * (c & 3)) * 2;
                const s16x4 t0 = ml::trread(kp), t1 = ml::trread(kp + 4 * QS * 2);
                const bf16x8 kb = (bf16x8){t0[0], t0[1], t0[2], t0[3], t1[0], t1[1], t1[2], t1[3]};
#pragma unroll
                for (int vt = 0; vt < NVT; ++vt) { const bf16x8 vf = ldfrag(L + LO_VW, 16 * vt + c, QS, 32 * ks + 8 * q); st[half][vt] = __builtin_amdgcn_mfma_f32_16x16x32_bf16(vf, kb, st[half][vt], 0, 0, 0); }
            }
            if (half == 0 && w == 0 && ch + 1 < 17) ML_GATES_MATH((ch + 1) & 1);
            __syncthreads();
        }
        {
            int q = lane >> 4, c = lane & 15; asm volatile("" : "+v"(q), "+v"(c));
            const int i = 16 * w + c; const float Mi = gM[i];
#pragma unroll
            for (int jt = 0; jt < 8; ++jt) if (jt <= (w | 1)) {
                float p[4];
#pragma unroll
                for (int r = 0; r < 4; ++r) { const int j = 16 * jt + 4 * q + r; p[r] = (j <= i) ? accS[jt][r] * __expf(gG[j] - Mi) : 0.f; }
                *(LAS u32x2*)(L + LO_PS + (i * QS + 16 * jt + 4 * q) * 2) = (u32x2){pk2(p[0], p[1]), pk2(p[2], p[3])};
            }
#pragma unroll
            for (int half = 0; half < 2; ++half)
#pragma unroll
                for (int vt = 0; vt < NVT; ++vt)
#pragma unroll
                    for (int r = 0; r < 4; ++r) ((LAS bf16_t*)(L + LO_CT))[(16 * vt + 4 * q + r) * CS + half * 128 + 16 * w + c] = (bf16_t)f2bf(st[half][vt][r]);
        }
        __syncthreads();
        {
            f32x4 accN[NVT];
#pragma unroll
            for (int i = 0; i < NVT; ++i) accN[i] = (f32x4){0.f, 0.f, 0.f, 0.f};
#pragma unroll
            for (int ks = 0; ks < 4; ++ks) if (ks <= (w >> 1)) {
                const bf16x8 pf = ldfrag(L + LO_PS, 16 * w + c, QS, 32 * ks + 8 * q);
#pragma unroll
                for (int vt = 0; vt < NVT; ++vt) { const bf16x8 vf = ldfrag(L + LO_VT, 16 * vt + c, QS, 32 * ks + 8 * q); accN[vt] = __builtin_amdgcn_mfma_f32_16x16x32_bf16(vf, pf, accN[vt], 0, 0, 0); }
            }
            const int i = 16 * w + c; const float Mi = gM[i], Fi = gF[i];
            const float inter = __expf(m_old - Mi);
            float den = accN[NVR][0] + inter * accR[NVR][0];
            den = __shfl(den, c);
            const float dd = fmaxf(fabsf(den), __expf(-(Fi + Mi)));
            const float inv = 1.0f / dd;
#pragma unroll
            for (int vt = 0; vt < NVR; ++vt) {
                float hv[4];
#pragma unroll
                for (int r = 0; r < 4; ++r) hv[r] = (accN[vt][r] + inter * accR[vt][r]) * inv;
                if (i < Lc) *(GAS u32x2*)(hm + (size_t)(grow + i) * MIXA + h * 256 + sl * SLW + 16 * vt + 4 * q) = (u32x2){pk2(hv[0], hv[1]), pk2(hv[2], hv[3])};
            }
        }
        m_run = m_new;
        __syncthreads();
    }
#undef ML_GATES_LOAD
#undef ML_GATES_MATH
    float* out = F.out;
#pragma unroll
    for (int half = 0; half < 2; ++half) {
        const int dk = half * 128 + 16 * w + c;
#pragma unroll
        for (int vt = 0; vt < NVR; ++vt) *(GAS f32x4*)(out + O_PC + (((size_t)(b * NHA + h) * HDA + dk) * HDA) + sl * SLW + 16 * vt + 4 * q) = st[half][vt];
        if (sl == 0 && q == 0) out[O_PN + (size_t)(b * NHA + h) * HDA + dk] = st[half][NVR][0];
    }
    if (sl == 0 && tid == 0) out[O_PM + b * NHA + h] = m_run;
    __syncthreads();
}

__device__ __forceinline__ void mlstm_sample_job(Frame& F, const Args& args, int jid) {
    const int b = jid >> 2, h = jid & 3;
    const int tid = F.tid, lane = F.lane, w = F.wave;
    LAS float* qs = (LAS float*)(F.lds);
    LAS float* ks = qs + 2048;
    LAS float* vs = ks + 2048;
    LAS float* kw = vs + 2048;
    LAS float* sm = kw + 2048;
    LAS float* gv = sm + 128;
    LAS float* red = gv + 64;
    const bf16_t* zin = (const bf16_t*)(F.ws + WS_ZIN); const float* gates = (const float*)(F.ws + WS_GATES);
    const int row0 = MPR + b * DS;
    const float* C0 = args.in[I_MC] + (size_t)(b * NHA + h) * HDA * HDA; const float* n0 = args.in[I_MN] + (size_t)(b * NHA + h) * HDA;
    const float m0 = args.in[I_MM][b * NHA + h];
    float gl[16];
#pragma unroll
    for (int j = 0; j < 16; ++j) gl[j] = 0.f;
    if (tid == NTHREADS - 64) {
#pragma unroll
        for (int j = 0; j < 8; ++j) { gl[j] = gates[(size_t)(row0 + j) * 8 + h]; gl[8 + j] = gates[(size_t)(row0 + j) * 8 + 4 + h]; }
    }
    for (int i = tid; i < 3 * 8 * 32; i += NTHREADS) { const int which = i / 256, r = (i % 256) / 32, c8 = (i % 32) * 8;
        const u32x4 wv = *(const GAS u32x4*)(zin + (size_t)(row0 + r) * NZ + which * 1024 + h * 256 + c8); float x[8]; unpack8(wv, x);
        LAS float* dst = qs + which * 2048 + r * 256 + c8;
#pragma unroll
        for (int e = 0; e < 8; ++e) dst[e] = x[e]; }
    {
        if (tid == NTHREADS - 64) {
            float Fv[8], gg[8], Mi[8]; float cum = 0.f, pmx = -3e38f;
#pragma unroll
            for (int j = 0; j < 8; ++j) { const float ig = gl[j]; cum += log_sigmoidf_(gl[8 + j]); Fv[j] = cum; gg[j] = ig - cum; pmx = fmaxf(pmx, gg[j]); Mi[j] = fmaxf(m0, pmx); }
            const float Ml = Mi[7];
#pragma unroll
            for (int j = 0; j < 8; ++j) { gv[j] = Fv[j]; gv[8 + j] = gg[j]; gv[16 + j] = Mi[j]; gv[24 + j] = __expf(m0 - Mi[j]); gv[32 + j] = __expf(-(Fv[j] + Mi[j])); gv[40 + j] = __expf(gg[j] - Ml); }
            gv[48] = __expf(m0 - Ml); gv[49] = Fv[7] + Ml;
        }
    }
    __syncthreads();
    f32x4 cvA[8], cvB[8];
#define MS_LOAD(cv_, kb_) do { _Pragma("unroll") for (int u = 0; u < 8; ++u) cv_[u] = *(const GAS f32x4*)(C0 + (size_t)(32 * w + (kb_) + u) * HDA + 4 * lane); } while (0)
    MS_LOAD(cvA, 0); MS_LOAD(cvB, 8);
    for (int i = tid; i < 2048; i += NTHREADS) kw[i] = ks[i] * gv[40 + (i >> 8)];
    {
        const int i = w, j = lane >> 3, part = lane & 7;
        float d = 0.f, dn = 0.f;
        for (int k = part * 32; k < part * 32 + 32; ++k) { const float qv = qs[i * 256 + k]; d += qv * ks[j * 256 + k]; if (j == 0) dn += qv * n0[k]; }
        d += __shfl_xor(d, 1); d += __shfl_xor(d, 2); d += __shfl_xor(d, 4);
        dn += __shfl_xor(dn, 1); dn += __shfl_xor(dn, 2); dn += __shfl_xor(dn, 4);
        if (part == 0) { sm[i * 16 + j] = (j <= i) ? d * __expf(gv[8 + j] - gv[16 + i]) : 0.f; if (j == 0) sm[i * 16 + 8] = dn; }
    }
    lds_barrier();
    const float dec = gv[48];
    f32x4 vr[8], hacc[8];
#pragma unroll
    for (int j = 0; j < 8; ++j) { vr[j] = *(const LAS f32x4*)(vs + j * 256 + 4 * lane); hacc[j] = (f32x4){0.f, 0.f, 0.f, 0.f}; }
    float* Cout = F.out + O_SC + (size_t)(b * NHA + h) * HDA * HDA;
#define MS_USE(cv_, kb_) do { _Pragma("unroll") for (int u = 0; u < 8; ++u) { const int k = 32 * w + (kb_) + u; \
            f32x4 cn = cv_[u] * dec; \
            _Pragma("unroll") for (int j = 0; j < 8; ++j) { hacc[j] += cv_[u] * qs[j * 256 + k]; cn += vr[j] * kw[j * 256 + k]; } \
            *(GAS f32x4*)(Cout + (size_t)k * HDA + 4 * lane) = cn; } } while (0)
    MS_USE(cvA, 0);  MS_LOAD(cvA, 16);
    MS_USE(cvB, 8);  MS_LOAD(cvB, 24);
    MS_USE(cvA, 16);
    MS_USE(cvB, 24);
#undef MS_LOAD
#undef MS_USE
#pragma unroll
    for (int j = 0; j < 8; ++j) *(LAS f32x4*)(red + (w * 8 + j) * 256 + 4 * lane) = hacc[j];
    __syncthreads();
    {
        const int i = tid >> 6; f32x4 qc = (f32x4){0.f, 0.f, 0.f, 0.f};
#pragma unroll
        for (int ww = 0; ww < 8; ++ww) qc += *(const LAS f32x4*)(red + (ww * 8 + i) * 256 + 4 * lane);
        f32x4 num = qc * gv[24 + i]; float den = gv[24 + i] * sm[i * 16 + 8];
#pragma unroll
        for (int j = 0; j < 8; ++j) { const float sij = sm[i * 16 + j]; num += vr[j] * sij; den += sij; }
        const float inv = 1.0f / fmaxf(fabsf(den), gv[32 + i]);
        num = num * inv;
        *(GAS u32x2*)((bf16_t*)(F.ws + WS_HM) + (size_t)(row0 + i) * MIXA + h * 256 + 4 * lane) = (u32x2){pk2(num[0], num[1]), pk2(num[2], num[3])};
    }
    if (tid < 256) { float nn = dec * n0[tid];
#pragma unroll
        for (int j = 0; j < 8; ++j) nn += kw[j * 256 + tid];
        F.out[O_SN + (size_t)(b * NHA + h) * HDA + tid] = nn; }
    if (tid == 0) F.out[O_SM + b * NHA + h] = gv[49];
    __syncthreads();
}


namespace rg {
constexpr int XS = 128, AS = 144, HS = 132;
constexpr int O_XP = 0, O_XC = O_XP + 176 * XS * 2, O_WA = O_XC + 128 * AS * 2, O_WX = O_WA + 32 * AS * 2, O_AL = O_WX + 32 * AS * 2, O_UL = O_AL + 32 * HS * 4, O_CR = O_UL + 32 * HS * 4, O_ENDL = O_CR + 128;
static_assert(O_ENDL <= RING_BYTES, "rglru lds");
}
__device__ __forceinline__ float gelu_tanh_(float x) { const float u = 0.7978845608028654f * (x + 0.044715f * x * x * x); return 0.5f * x * (1.0f + tanhf_(u)); }

__device__ __forceinline__ void rglru_job(Frame& F, const Args& args, int kind, int sq, int n, int qt) {
    using namespace rg;
    const int tid = F.tid, lane = F.lane, w = F.wave, q = lane >> 4, c = lane & 15;
    LAS unsigned char* L = F.lds;
    LAS bf16_t* xp = (LAS bf16_t*)(L + O_XP); LAS bf16_t* xc = (LAS bf16_t*)(L + O_XC);
    LAS float* aL = (LAS float*)(L + O_AL); LAS float* uL = (LAS float*)(L + O_UL); LAS float* carry = (LAS float*)(L + O_CR);
    const bf16_t* zin = (const bf16_t*)(F.ws + WS_ZIN); bf16_t* cat = (bf16_t*)(F.ws + WS_CAT);
    const int cb0 = n * 128;
    const int c0 = cb0 + qt * 32;
    for (int i = tid; i < 2 * 32 * 128; i += NTHREADS) { const int which = i >> 12, cc = (i >> 7) & 31, ii = i & 127;
        const float v = args.in[which ? I_WX : I_WA][((size_t)n * 128 + ii) * 128 + qt * 32 + cc];
        ((LAS bf16_t*)(L + (which ? O_WX : O_WA)))[cc * AS + ii] = (bf16_t)f2bf(v); }
    const int chn = tid & 127;
    const int rq = tid >> 4, cq = tid & 15;
    float cw[4][8], cbias[8];
#pragma unroll
    for (int j = 0; j < 4; ++j)
#pragma unroll
        for (int e = 0; e < 8; ++e) cw[j][e] = args.in[I_CVW][j * RGW + cb0 + 8 * cq + e];
#pragma unroll
    for (int e = 0; e < 8; ++e) cbias[e] = args.in[I_CVB][cb0 + 8 * cq + e];
    float bav[2], bxv[2], spv[2];
#pragma unroll
    for (int e = 0; e < 2; ++e) { const int cg = c0 + 16 * e + c; bav[e] = args.in[I_BA][cg]; bxv[e] = args.in[I_BX][cg]; spv[e] = softplusf_(-args.in[I_LAM][cg]); }
    if (tid < 32) carry[tid] = 0.f;
    const int ntiles = kind ? 1 : 17;
    const int T = kind ? DS : TP;
    u32x4 pre[5];
#define RG_PREFETCH(t0_) do { _Pragma("unroll") for (int i_ = 0; i_ < 5; ++i_) { const int p_ = tid + NTHREADS * i_; const int r_ = p_ >> 4, c16_ = p_ & 15; const int tok_ = (t0_) - 3 + r_; \
        pre[i_] = (u32x4){0u, 0u, 0u, 0u}; if (p_ < 131 * 16 && tok_ >= 0 && tok_ < TP) pre[i_] = *(const GAS u32x4*)(zin + (size_t)(sq * TP + tok_) * NZ + 4096 + cb0 + c16_ * 8); } } while (0)
    if (kind == 0) RG_PREFETCH(0);
    for (int ti = 0; ti < ntiles; ++ti) {
        const int t0 = ti * 128;
        const int nv = kind ? 128 : ((TP - t0) < 128 ? (TP - t0) : 128);
        __syncthreads();
        if (kind == 0) {
#pragma unroll
            for (int i = 0; i < 5; ++i) { const int p = tid + NTHREADS * i; if (p < 131 * 16) *(LAS u32x4*)(xp + (p >> 4) * XS + (p & 15) * 8) = pre[i]; }
        } else {
            for (int p = tid; p < 176 * 16; p += NTHREADS) { const int r = p >> 4, c16 = p & 15; const int sg = r / 11, lr = r % 11; const int bq = sq * 16 + sg;
                u32x4 v;
                if (lr < 3) { const float* src = args.in[I_RC] + ((size_t)bq * 3 + lr) * RGW + cb0 + c16 * 8; const f32x4 a = *(const GAS f32x4*)src, bb = *(const GAS f32x4*)(src + 4);
                    v.x = pk2(a[0], a[1]); v.y = pk2(a[2], a[3]); v.z = pk2(bb[0], bb[1]); v.w = pk2(bb[2], bb[3]); }
                else v = *(const GAS u32x4*)(zin + (size_t)(MPR + bq * DS + lr - 3) * NZ + 4096 + cb0 + c16 * 8);
                *(LAS u32x4*)(xp + r * XS + c16 * 8) = v; }
        }
        u32x4 gpre = (u32x4){0u, 0u, 0u, 0u};
        { const int rho = tid >> 2, c8 = (tid & 3) * 8;
          if (rho < nv) { const int grow = kind ? (MPR + (sq * 16 + (rho >> 3)) * DS + (rho & 7)) : (sq * TP + t0 + rho); gpre = *(const GAS u32x4*)(zin + (size_t)grow * NZ + 5120 + c0 + c8); } }
        __syncthreads();
        if (kind == 0 && ti + 1 < ntiles) RG_PREFETCH(t0 + 128);
        {
            const int rho0 = 4 * rq; const int idx0 = kind ? ((rho0 >> 3) * 11 + (rho0 & 7)) : rho0;
            float xr[7][8];
#pragma unroll
            for (int j = 0; j < 7; ++j) unpack8(*(const LAS u32x4*)(xp + (idx0 + j) * XS + 8 * cq), xr[j]);
#pragma unroll
            for (int r = 0; r < 4; ++r) { float o[8];
#pragma unroll
                for (int e = 0; e < 8; ++e) o[e] = cbias[e] + cw[0][e] * xr[r][e] + cw[1][e] * xr[r + 1][e] + cw[2][e] * xr[r + 2][e] + cw[3][e] * xr[r + 3][e];
                *(LAS u32x4*)(xc + (rho0 + r) * AS + 8 * cq) = pack8(o); }
        }
        __syncthreads();
        f32x4 acc[4];
#pragma unroll
        for (int i = 0; i < 4; ++i) acc[i] = (f32x4){0.f, 0.f, 0.f, 0.f};
#pragma unroll
        for (int ks = 0; ks < 4; ++ks) {
            const bf16x8 xf = *(const LAS bf16x8*)(xc + (16 * w + c) * AS + 32 * ks + 8 * q);
#pragma unroll
            for (int nt = 0; nt < 4; ++nt) { const bf16x8 wf = *(const LAS bf16x8*)((LAS bf16_t*)(L + ((nt >> 1) ? O_WX : O_WA)) + (16 * (nt & 1) + c) * AS + 32 * ks + 8 * q);
                acc[nt] = __builtin_amdgcn_mfma_f32_16x16x32_bf16(xf, wf, acc[nt], 0, 0, 0); }
        }
#pragma unroll
        for (int e = 0; e < 2; ++e) {
            f32x4 av, uv;
#pragma unroll
            for (int r = 0; r < 4; ++r) { const int t = 16 * w + 4 * q + r;
                const float rr = sigmoidf_(acc[e][r] + bav[e]), gi = sigmoidf_(acc[2 + e][r] + bxv[e]);
                const float la = -8.0f * rr * spv[e]; const float a = __expf(la); const float mult = sqrtf(fmaxf(1.0f - a * a, 0.f));
                const float xv = bf2f(xc[t * AS + qt * 32 + 16 * e + c]);
                const bool valid = t < nv;
                av[r] = valid ? a : 1.0f; uv[r] = valid ? mult * gi * xv : 0.f; }
            *(LAS f32x4*)(aL + (16 * e + c) * HS + 16 * w + 4 * q) = av; *(LAS f32x4*)(uL + (16 * e + c) * HS + 16 * w + 4 * q) = uv;
        }
        __syncthreads();
        {
            const int sg = tid & 15, ch = tid >> 4;
            float a8[8], u8[8];
            { const f32x4 a0 = *(const LAS f32x4*)(aL + ch * HS + 8 * sg), a1 = *(const LAS f32x4*)(aL + ch * HS + 8 * sg + 4), u0 = *(const LAS f32x4*)(uL + ch * HS + 8 * sg), u1 = *(const LAS f32x4*)(uL + ch * HS + 8 * sg + 4);
#pragma unroll
              for (int e = 0; e < 4; ++e) { a8[e] = a0[e]; a8[4 + e] = a1[e]; u8[e] = u0[e]; u8[4 + e] = u1[e]; } }
            float hin;
            if (kind == 0) {
                float A = 1.f, H = 0.f;
#pragma unroll
                for (int k = 0; k < 8; ++k) { H = a8[k] * H + u8[k]; A *= a8[k]; }
#pragma unroll
                for (int d = 1; d < 16; d <<= 1) { const float Ap = __shfl_up(A, d, 16), Hp = __shfl_up(H, d, 16); if (sg >= d) { H = A * Hp + H; A = A * Ap; } }
                float Ae = __shfl_up(A, 1, 16), He = __shfl_up(H, 1, 16); if (sg == 0) { Ae = 1.f; He = 0.f; }
                hin = Ae * carry[ch] + He;
            } else {
                hin = args.in[I_RH][(size_t)(sq * 16 + sg) * RGW + c0 + ch];
            }
            float hcur = hin; float h8[8];
#pragma unroll
            for (int k = 0; k < 8; ++k) { hcur = a8[k] * hcur + u8[k]; h8[k] = hcur; }
            __syncthreads();
            *(LAS f32x4*)(uL + ch * HS + 8 * sg) = (f32x4){h8[0], h8[1], h8[2], h8[3]}; *(LAS f32x4*)(uL + ch * HS + 8 * sg + 4) = (f32x4){h8[4], h8[5], h8[6], h8[7]};
            if (kind == 0) { if (sg == 15) carry[ch] = hcur; }
            else F.out[O_SH + (size_t)(sq * 16 + sg) * RGW + c0 + ch] = hcur;
            if (kind == 0 && ti == ntiles - 1 && sg == 15) F.out[O_PH + (size_t)sq * RGW + c0 + ch] = hcur;
        }
        __syncthreads();
        {
            const int rho = tid >> 2, c8 = (tid & 3) * 8;
            if (rho < nv) {
                const int grow = kind ? (MPR + (sq * 16 + (rho >> 3)) * DS + (rho & 7)) : (sq * TP + t0 + rho);
                float gr[8], o[8]; unpack8(gpre, gr);
#pragma unroll
                for (int e = 0; e < 8; ++e) o[e] = uL[(c8 + e) * HS + rho] * gelu_tanh_(gr[e]);
                *(GAS u32x4*)(cat + (size_t)grow * D + 1024 + c0 + c8) = pack8(o);
            }
        }
        if (qt == 0) {
            if (kind == 0) { if (ti == ntiles - 1 && tid < 384) { const int i3 = tid >> 7; F.out[O_PCV + ((size_t)sq * 3 + i3) * RGW + cb0 + chn] = bf2f(xp[(nv + i3) * XS + chn]); } }
            else { for (int p = tid; p < 16 * 3 * 128; p += NTHREADS) { const int sg = p / 384, i3 = (p % 384) >> 7, ch2 = p & 127; F.out[O_SCV + ((size_t)(sq * 16 + sg) * 3 + i3) * RGW + cb0 + ch2] = bf2f(xp[(sg * 11 + 8 + i3) * XS + ch2]); } }
        }
    }
#undef RG_PREFETCH
    __syncthreads();
    (void)T;
}


namespace rw {
constexpr int TB = 64;
constexpr int O_W = 0, O_A = O_W + TB * 64 * 4, O_B = O_A + TB * 64 * 4, O_K = O_B + TB * 64 * 4, O_R = O_K + TB * 64 * 4, O_V = O_R + TB * 64 * 4, O_Y = O_V + TB * 64 * 4, O_CB = O_Y + TB * 64 * 4, O_WC = O_CB + TB * 4, O_SP = O_WC + 256, O_ENDL = O_SP + 8 * 64 * 4;
static_assert(O_ENDL <= RING_BYTES, "rwkv lds");
}
__device__ __forceinline__ float row16_sum(float v) {
    v += __builtin_bit_cast(float, __builtin_amdgcn_update_dpp(0, __builtin_bit_cast(int, v), 0x128, 0xf, 0xf, false));
    v += __builtin_bit_cast(float, __builtin_amdgcn_update_dpp(0, __builtin_bit_cast(int, v), 0x124, 0xf, 0xf, false));
    v += __builtin_bit_cast(float, __builtin_amdgcn_update_dpp(0, __builtin_bit_cast(int, v), 0x122, 0xf, 0xf, false));
    v += __builtin_bit_cast(float, __builtin_amdgcn_update_dpp(0, __builtin_bit_cast(int, v), 0x121, 0xf, 0xf, false));
    return v;
}
template <int CTRL> __device__ __forceinline__ float dppf(float v) { return __builtin_bit_cast(float, __builtin_amdgcn_update_dpp(0, __builtin_bit_cast(int, v), CTRL, 0xf, 0xf, false)); }
#define RS_STAGE(n, bit, XCH) do { _Pragma("unroll") for (int j_ = 0; j_ < (n); ++j_) { \
        const float lo_ = ya[j_], hi_ = ya[j_ + (n)]; const float keep_ = (bit) ? hi_ : lo_, send_ = (bit) ? lo_ : hi_; ya[j_] = keep_ + XCH(send_); \
        const float lo2_ = yb[j_], hi2_ = yb[j_ + (n)]; const float keep2_ = (bit) ? hi2_ : lo2_, send2_ = (bit) ? lo2_ : hi2_; yb[j_] = keep2_ + XCH(send2_); } } while (0)
__device__ __forceinline__ float xch1(float v) { return dppf<0xB1>(v); }
__device__ __forceinline__ float xch2(float v) { return dppf<0x4E>(v); }
__device__ __forceinline__ float xch8(float v) { return dppf<0x128>(v); }
__device__ __forceinline__ float xch4(float v) { return dppf<0x1B>(dppf<0x141>(v)); }

__device__ __forceinline__ void rwkv_job(Frame& F, const Args& args, int rowbase, int T, int h, const float* S0, float* Sout) {
    using namespace rw;
    const int tid = F.tid, lane = F.lane, w = F.wave, rp = lane >> 4, kp = lane & 15;
    LAS unsigned char* L = F.lds;
    LAS float* Wl = (LAS float*)(L + O_W); LAS float* Al = (LAS float*)(L + O_A); LAS float* Bl = (LAS float*)(L + O_B); LAS float* Kl = (LAS float*)(L + O_K);
    LAS float* Rl = (LAS float*)(L + O_R); LAS float* Vl = (LAS float*)(L + O_V); LAS float* Yl = (LAS float*)(L + O_Y); LAS float* CBl = (LAS float*)(L + O_CB); LAS float* WCl = (LAS float*)(L + O_WC); LAS float* SPl = (LAS float*)(L + O_SP);
    const bf16_t* rb = (const bf16_t*)(F.ws + WS_RKV); const bf16_t* kb = rb + (size_t)MP * D; const bf16_t* vb = kb + (size_t)MP * D;
    const float* wd = (const float*)(F.ws + WS_WDEC); const bf16_t* ab = (const bf16_t*)(F.ws + WS_AG); const bf16_t* gb = (const bf16_t*)(F.ws + WS_GG);
    bf16_t* ycat = (bf16_t*)(F.ws + WS_YCAT);
    const int r0 = 8 * w + 2 * rp;
    f32x4 Sa, Sb;
    if (S0) { Sa = *(const GAS f32x4*)(S0 + (size_t)r0 * 64 + 4 * kp); Sb = *(const GAS f32x4*)(S0 + (size_t)(r0 + 1) * 64 + 4 * kp); }
    else { Sa = (f32x4){0.f, 0.f, 0.f, 0.f}; Sb = Sa; }
    const bool b0 = kp & 1, b1 = kp & 2, b2 = kp & 4, b3 = kp & 8;
    const int jmap = 8 * (kp & 1) + 4 * ((kp >> 1) & 1) + 2 * ((kp >> 3) & 1) + ((kp >> 2) & 1);
    const int tt = tid >> 3, part = tid & 7, hk = h * 64 + 8 * part;
    float ckk[8], cka[8], crk[8], clg[8], clb[8];
#pragma unroll
    for (int e = 0; e < 8; ++e) { ckk[e] = args.in[I_KK][hk + e]; cka[e] = args.in[I_KA][hk + e]; crk[e] = args.in[I_RK][hk + e]; clg[e] = args.in[I_LNXG][hk + e]; clb[e] = args.in[I_LNXB][hk + e]; }
    u32x4 q_r = (u32x4){0u, 0u, 0u, 0u}, q_k = q_r, q_v = q_r, q_a = q_r, q_g = q_r; f32x4 q_w0 = (f32x4){0.f, 0.f, 0.f, 0.f}, q_w1 = q_w0;
#define RW_PREFETCH(tb_) do { if ((tb_) + tt < T) { const size_t row_ = (size_t)(rowbase + (tb_) + tt); \
        q_r = *(const GAS u32x4*)(rb + row_ * D + hk); q_k = *(const GAS u32x4*)(kb + row_ * D + hk); q_v = *(const GAS u32x4*)(vb + row_ * D + hk); q_a = *(const GAS u32x4*)(ab + row_ * D + hk); \
        q_g = *(const GAS u32x4*)(gb + row_ * D + hk); q_w0 = *(const GAS f32x4*)(wd + row_ * D + hk); q_w1 = *(const GAS f32x4*)(wd + row_ * D + hk + 4); } } while (0)
    RW_PREFETCH(0);
    for (int tb = 0; tb < T; tb += TB) {
        const int nvt = (T - tb) < TB ? (T - tb) : TB;
        __syncthreads();
        float gcur[8];
        {
            const int o = tt * 64 + 8 * part;
            if (tt < nvt) {
                float r[8], k[8], v[8], a[8], wv[8];
                unpack8(q_r, r); unpack8(q_k, k); unpack8(q_v, v); unpack8(q_a, a); unpack8(q_g, gcur);
#pragma unroll
                for (int e = 0; e < 4; ++e) { wv[e] = q_w0[e]; wv[4 + e] = q_w1[e]; }
                float kkv[8], ss = 0.f, cb = 0.f, kp2[8];
#pragma unroll
                for (int e = 0; e < 8; ++e) { kkv[e] = k[e] * ckk[e]; ss += kkv[e] * kkv[e]; kp2[e] = k[e] * (1.0f + (a[e] - 1.0f) * cka[e]); cb += r[e] * kp2[e] * crk[e]; }
                ss += __shfl_xor(ss, 1); ss += __shfl_xor(ss, 2); ss += __shfl_xor(ss, 4);
                cb += __shfl_xor(cb, 1); cb += __shfl_xor(cb, 2); cb += __shfl_xor(cb, 4);
                const float inv = 1.0f / fmaxf(sqrtf(ss), 1e-12f);
#pragma unroll
                for (int e = 0; e < 8; ++e) { const float kk = kkv[e] * inv; Wl[o + e] = wv[e]; Al[o + e] = -kk; Bl[o + e] = kk * a[e]; Kl[o + e] = kp2[e]; Rl[o + e] = r[e]; Vl[o + e] = v[e]; }
                if (part == 0) CBl[tt] = cb;
            } else {
#pragma unroll
                for (int e = 0; e < 8; ++e) { Wl[o + e] = 1.f; Al[o + e] = 0.f; Bl[o + e] = 0.f; Kl[o + e] = 0.f; Rl[o + e] = 0.f; Vl[o + e] = 0.f; gcur[e] = 0.f; }
            }
        }
        RW_PREFETCH(tb + TB);
        __syncthreads();
        {
            const int kk_ = tid & 63, sg_ = tid >> 6;
            float wseg[8]; float pr = 1.f;
#pragma unroll
            for (int e = 0; e < 8; ++e) { wseg[e] = Wl[(8 * sg_ + e) * 64 + kk_]; pr *= wseg[e]; }
            SPl[sg_ * 64 + kk_] = pr;
            __syncthreads();
            float wc = 1.f;
#pragma unroll
            for (int q_ = 0; q_ < 8; ++q_) if (q_ < sg_) wc *= SPl[q_ * 64 + kk_];
#pragma unroll
            for (int e = 0; e < 8; ++e) { const int o_ = (8 * sg_ + e) * 64 + kk_;
                Al[o_] *= wc; wc *= wseg[e]; const float iw = 1.0f / wc; Bl[o_] *= iw; Kl[o_] *= iw; Rl[o_] *= wc; }
            if (sg_ == 7) WCl[kk_] = wc;
        }
        __syncthreads();
        const int ngrp = (nvt + 15) >> 4;
#define RW_LOAD(P, t_) do { P##a = *(const LAS f32x4*)(Al + (t_) * 64 + 4 * kp); P##b = *(const LAS f32x4*)(Bl + (t_) * 64 + 4 * kp); \
            P##k = *(const LAS f32x4*)(Kl + (t_) * 64 + 4 * kp); P##r = *(const LAS f32x4*)(Rl + (t_) * 64 + 4 * kp); P##v = *(const LAS f32x2*)(Vl + (t_) * 64 + r0); } while (0)
        f32x4 ca, cbv, ck, cr; f32x2 cv;
        f32x4 n0_a, n0_b, n0_k, n0_r; f32x2 n0_v;
        { RW_LOAD(n0_, 0); ca = n0_a; cbv = n0_b; ck = n0_k; cr = n0_r; cv = n0_v; }
#ifdef RW_DUPSTEPS
        const f32x4 Sa_sv = Sa, Sb_sv = Sb;
        for (int rep_ = 0; rep_ < 2; ++rep_) { if (rep_) { Sa = Sa_sv; Sb = Sb_sv; RW_LOAD(n0_, 0); ca = n0_a; cbv = n0_b; ck = n0_k; cr = n0_r; cv = n0_v; }
#endif
        for (int g = 0; g < ngrp; ++g) {
            float ya[16], yb[16];
#pragma unroll
            for (int j = 0; j < 16; ++j) {
                const int t = 16 * g + j;
                f32x4 na, nb, nk, nr; f32x2 nv;
                RW_LOAD(n, t + 1);
                __builtin_amdgcn_sched_barrier(0);
                const f32x2 a_lo = (f32x2){ca[0], ca[1]}, a_hi = (f32x2){ca[2], ca[3]};
                f32x2 qa = (f32x2){Sa[0], Sa[1]} * a_lo; qa = (f32x2){Sa[2], Sa[3]} * a_hi + qa;
                f32x2 qb = (f32x2){Sb[0], Sb[1]} * a_lo; qb = (f32x2){Sb[2], Sb[3]} * a_hi + qb;
                float pa = qa[0] + qa[1], pb = qb[0] + qb[1];
                const f32x4 ta = Sa + ck * cv[0], tbv = Sb + ck * cv[1];
                pa = row16_sum(pa); pb = row16_sum(pb);
                Sa = ta + cbv * pa; Sb = tbv + cbv * pb;
                const f32x2 r_lo = (f32x2){cr[0], cr[1]}, r_hi = (f32x2){cr[2], cr[3]};
                f32x2 za = (f32x2){Sa[0], Sa[1]} * r_lo; za = (f32x2){Sa[2], Sa[3]} * r_hi + za;
                f32x2 zb = (f32x2){Sb[0], Sb[1]} * r_lo; zb = (f32x2){Sb[2], Sb[3]} * r_hi + zb;
                ya[j] = za[0] + za[1]; yb[j] = zb[0] + zb[1];
                ca = na; cbv = nb; ck = nk; cr = nr; cv = nv;
                __builtin_amdgcn_sched_barrier(0);
            }
            RS_STAGE(8, b0, xch1); RS_STAGE(4, b1, xch2); RS_STAGE(2, b3, xch8); RS_STAGE(1, b2, xch4);
            *(LAS f32x2*)(Yl + (16 * g + jmap) * 64 + r0) = (f32x2){ya[0], yb[0]};
        }
#ifdef RW_DUPSTEPS
        }
#endif
#undef RW_LOAD
        { const f32x4 wl = *(const LAS f32x4*)(WCl + 4 * kp); Sa = Sa * wl; Sb = Sb * wl; }
        __syncthreads();
        if (tt < nvt) {
            const size_t row = (size_t)(rowbase + tb + tt);
            float y[8]; float s = 0.f;
#pragma unroll
            for (int e = 0; e < 8; ++e) { y[e] = Yl[tt * 64 + 8 * part + e]; s += y[e]; }
            s += __shfl_xor(s, 1); s += __shfl_xor(s, 2); s += __shfl_xor(s, 4);
            const float mu = s * (1.f / 64.f); float s2 = 0.f;
#pragma unroll
            for (int e = 0; e < 8; ++e) { y[e] -= mu; s2 += y[e] * y[e]; }
            s2 += __shfl_xor(s2, 1); s2 += __shfl_xor(s2, 2); s2 += __shfl_xor(s2, 4);
            const float rstd = 1.0f / sqrtf(s2 * (1.f / 64.f) + GN_EPS);
            float o[8];
            const float cb = CBl[tt];
#pragma unroll
            for (int e = 0; e < 8; ++e) o[e] = (y[e] * rstd * clg[e] + clb[e] + cb * Vl[tt * 64 + 8 * part + e]) * gcur[e];
            *(GAS u32x4*)(ycat + row * D + hk) = pack8(o);
        }
    }
#undef RW_PREFETCH
    *(GAS f32x4*)(Sout + (size_t)r0 * 64 + 4 * kp) = Sa; *(GAS f32x4*)(Sout + (size_t)(r0 + 1) * 64 + 4 * kp) = Sb;
    __syncthreads();
}


namespace rwc {
constexpr int TB = 64, LD = 66, LDG = 34, LDT = 18;
constexpr int LDB = 72;
constexpr int O_W = 0, O_B = O_W + TB * LD * 4, O_K = O_B + TB * LD * 4, O_V = O_K + TB * LD * 4, O_SB = O_V + TB * LD * 4,
              O_AB = O_SB + 64 * LDB * 2, O_RB = O_AB + TB * LDB * 2, O_BB = O_RB + TB * LDB * 2, O_KB = O_BB + TB * LDB * 2, O_U = O_KB + TB * LDB * 2, O_G = O_U + 16 * LD * 4, O_T = O_G + 4 * 32 * LDG * 4,
              O_WC = O_T + 4 * 16 * LDT * 4, O_CB = O_WC + 4 * 64 * 4, O_VT = O_CB + TB * 4, O_UT = O_VT + 64 * LDB * 2, O_LK = O_UT + 64 * 24 * 2, O_TB = O_LK + 4 * 16 * 20 * 2, O_ENDL = O_TB + 4 * 16 * 20 * 2;
constexpr int LDK = 20;
constexpr int LDU = 24;
constexpr int O_BT = O_B, O_KT = O_K;
constexpr int O_A = O_U;
static_assert(O_A + TB * LD * 4 <= O_WC, "rwkv temp alias");
static_assert(O_ENDL <= RING_BYTES, "rwkv chunk lds");
template <int K> __device__ __forceinline__ f32x4 mm(f32x4 acc, const LAS float* pa, int sak, const LAS float* pb, int sbk) {
    float a[K / 4], b[K / 4];
#pragma unroll
    for (int s4 = 0; s4 < K / 4; ++s4) { a[s4] = pa[4 * s4 * sak]; b[s4] = pb[4 * s4 * sbk]; }
    __builtin_amdgcn_sched_barrier(0);
#pragma unroll
    for (int s4 = 0; s4 < K / 4; ++s4) acc = __builtin_amdgcn_mfma_f32_16x16x4f32(a[s4], b[s4], acc, 0, 0, 0);
    return acc;
}
}
template <bool PUB, bool BAT = false>
__device__ __forceinline__ void rwkv_job_c(Frame& F, const Args& args, int rowbase, int T, int h, const float* S0, float* Sout, unsigned* prog = nullptr, size_t sstride = 0) {
    using namespace rwc;
    const int tid = F.tid, lane = F.lane, w = F.wave, q0 = lane >> 4, c0 = lane & 15;
    LAS unsigned char* L = F.lds;
    LAS float* Wl = (LAS float*)(L + O_W); LAS float* Al = (LAS float*)(L + O_A); LAS float* Bl = (LAS float*)(L + O_B); LAS float* Kl = (LAS float*)(L + O_K);
    LAS bf16_t* Bb = (LAS bf16_t*)(L + O_BB); LAS bf16_t* Kb = (LAS bf16_t*)(L + O_KB); LAS bf16_t* BTb = (LAS bf16_t*)(L + O_BT); LAS bf16_t* KTb = (LAS bf16_t*)(L + O_KT); LAS bf16_t* VTb = (LAS bf16_t*)(L + O_VT); LAS bf16_t* UTb = (LAS bf16_t*)(L + O_UT); LAS bf16_t* LKb = (LAS bf16_t*)(L + O_LK); LAS bf16_t* Tbb = (LAS bf16_t*)(L + O_TB); LAS float* Vl = (LAS float*)(L + O_V); LAS bf16_t* Sb = (LAS bf16_t*)(L + O_SB); LAS bf16_t* Ab = (LAS bf16_t*)(L + O_AB); LAS bf16_t* Rb = (LAS bf16_t*)(L + O_RB); LAS float* UL = (LAS float*)(L + O_U);
    LAS float* GL = (LAS float*)(L + O_G); LAS float* TL = (LAS float*)(L + O_T); LAS float* WCl = (LAS float*)(L + O_WC); LAS float* CBl = (LAS float*)(L + O_CB);
    LAS float* Yl = Wl;
    const bf16_t* rb = (const bf16_t*)(F.ws + WS_RKV); const bf16_t* kb = rb + (size_t)MP * D; const bf16_t* vb = kb + (size_t)MP * D;
    const float* wd = (const float*)(F.ws + WS_WDEC); const bf16_t* ab = (const bf16_t*)(F.ws + WS_AG); const bf16_t* gb = (const bf16_t*)(F.ws + WS_GG);
    bf16_t* ycat = (bf16_t*)(F.ws + WS_YCAT);
    const int rt = w >> 1, kh = w & 1;
    f32x4 st[2];
#pragma unroll
    for (int e = 0; e < 2; ++e)
#pragma unroll
        for (int r = 0; r < 4; ++r) st[e][r] = S0 ? S0[(size_t)(16 * rt + 4 * q0 + r) * 64 + 16 * (2 * kh + e) + c0] : 0.f;
    const int tt = tid >> 3, part = tid & 7, hk = h * 64 + 8 * part;
    float ckk[8], cka[8], crk[8], clg[8], clb[8];
#pragma unroll
    for (int e = 0; e < 8; ++e) { ckk[e] = args.in[I_KK][hk + e]; cka[e] = args.in[I_KA][hk + e]; crk[e] = args.in[I_RK][hk + e]; clg[e] = args.in[I_LNXG][hk + e]; clb[e] = args.in[I_LNXB][hk + e]; }
    u32x4 q_r = (u32x4){0u, 0u, 0u, 0u}, q_k = q_r, q_v = q_r, q_a = q_r, q_g = q_r; f32x4 q_w0 = (f32x4){0.f, 0.f, 0.f, 0.f}, q_w1 = q_w0;
#define RW_PREFETCH(tb_) do { if (BAT ? ((tb_) == 0 && (tt & 15) < DS) : ((tb_) + tt < T)) { const size_t row_ = BAT ? (size_t)(rowbase + (tt >> 4) * DS + (tt & 15)) : (size_t)(rowbase + (tb_) + tt); \
        q_r = *(const GAS u32x4*)(rb + row_ * D + hk); q_k = *(const GAS u32x4*)(kb + row_ * D + hk); q_v = *(const GAS u32x4*)(vb + row_ * D + hk); q_a = *(const GAS u32x4*)(ab + row_ * D + hk); \
        q_g = *(const GAS u32x4*)(gb + row_ * D + hk); q_w0 = *(const GAS f32x4*)(wd + row_ * D + hk); q_w1 = *(const GAS f32x4*)(wd + row_ * D + hk + 4); } } while (0)
    RW_PREFETCH(0);
    for (int tb = 0; tb < T; tb += TB) {
        int q = q0, c = c0; asm volatile("" : "+v"(q), "+v"(c));
        const int nvt = (T - tb) < TB ? (T - tb) : TB;
        const int nch = (nvt + 15) >> 4;
        __syncthreads();
        float gcur[8];
        {
            const int o = tt * LD + 8 * part;
            if (BAT ? ((tt & 15) < DS) : (tt < nvt)) {
                float r[8], k[8], v[8], a[8], wv[8];
                unpack8(q_r, r); unpack8(q_k, k); unpack8(q_v, v); unpack8(q_a, a); unpack8(q_g, gcur);
#pragma unroll
                for (int e = 0; e < 4; ++e) { wv[e] = q_w0[e]; wv[4 + e] = q_w1[e]; }
                float kkv[8], ss = 0.f, cb = 0.f, kp2[8];
#pragma unroll
                for (int e = 0; e < 8; ++e) { kkv[e] = k[e] * ckk[e]; ss += kkv[e] * kkv[e]; kp2[e] = k[e] * (1.0f + (a[e] - 1.0f) * cka[e]); cb += r[e] * kp2[e] * crk[e]; }
                ss += __shfl_xor(ss, 1); ss += __shfl_xor(ss, 2); ss += __shfl_xor(ss, 4);
                cb += __shfl_xor(cb, 1); cb += __shfl_xor(cb, 2); cb += __shfl_xor(cb, 4);
                const float inv = 1.0f / fmaxf(sqrtf(ss), 1e-12f);
#pragma unroll
                for (int e = 0; e < 8; ++e) { const float kk = kkv[e] * inv; Wl[o + e] = wv[e]; Al[o + e] = -kk; Bl[o + e] = kk * a[e]; Kl[o + e] = kp2[e]; Vl[o + e] = v[e]; }
                *(LAS u32x4*)(Rb + tt * LDB + 8 * part) = q_r;
                if (part == 0) CBl[tt] = cb;
            } else {
#pragma unroll
                for (int e = 0; e < 8; ++e) { Wl[o + e] = 1.f; Al[o + e] = 0.f; Bl[o + e] = 0.f; Kl[o + e] = 0.f; Vl[o + e] = 0.f; gcur[e] = 0.f; }
                *(LAS u32x4*)(Rb + tt * LDB + 8 * part) = (u32x4){0u, 0u, 0u, 0u};
            }
        }
        RW_PREFETCH(tb + TB);
        __syncthreads();
        {
            const int kk_ = tid & 63, sg_ = tid >> 6;
            float bin[8], kin[8];
            {
                unsigned vt[4];
#pragma unroll
                for (int e = 0; e < 8; ++e) { const int o_ = (8 * sg_ + e) * LD + kk_; bin[e] = Bl[o_]; kin[e] = Kl[o_]; const unsigned vb_ = f2bf(Vl[o_]); if (e & 1) vt[e >> 1] |= vb_ << 16; else vt[e >> 1] = vb_; }
                *(LAS u32x4*)(VTb + kk_ * LDB + 8 * sg_) = (u32x4){vt[0], vt[1], vt[2], vt[3]};
            }
            __syncthreads();
            float wseg[8]; float wc = 1.f;
#pragma unroll
            for (int e = 0; e < 8; ++e) wseg[e] = Wl[(8 * sg_ + e) * LD + kk_];
            if (sg_ & 1) {
#pragma unroll
                for (int e = 0; e < 8; ++e) wc *= Wl[(8 * (sg_ - 1) + e) * LD + kk_];
            }
            unsigned bt[4], kt4[4];
#pragma unroll
            for (int e = 0; e < 8; ++e) { const int o_ = (8 * sg_ + e) * LD + kk_; const int ob_ = (8 * sg_ + e) * LDB + kk_;
                const float av = Al[o_] * wc; wc *= wseg[e]; const float iw = __builtin_amdgcn_rcpf(wc); const float bv = bin[e] * iw, kv = kin[e] * iw, rv = bf2f(Rb[ob_]) * wc;
                const unsigned bb_ = f2bf(bv), kb_ = f2bf(kv);
                Ab[ob_] = (bf16_t)f2bf(av); Rb[ob_] = (bf16_t)f2bf(rv); Bb[ob_] = (bf16_t)bb_; Kb[ob_] = (bf16_t)kb_;
                if (e & 1) { bt[e >> 1] |= bb_ << 16; kt4[e >> 1] |= kb_ << 16; } else { bt[e >> 1] = bb_; kt4[e >> 1] = kb_; } }
            *(LAS u32x4*)(BTb + kk_ * LDB + 8 * sg_) = (u32x4){bt[0], bt[1], bt[2], bt[3]};
            *(LAS u32x4*)(KTb + kk_ * LDB + 8 * sg_) = (u32x4){kt4[0], kt4[1], kt4[2], kt4[3]};
            if (sg_ & 1) WCl[(sg_ >> 1) * 64 + kk_] = wc;
        }
        __syncthreads();
        {
            const int gc = w >> 1, mt = w & 1; const int t0 = 16 * gc;
            const LAS bf16_t* pa = (mt ? Rb : Ab) + (t0 + c) * LDB + 8 * q;
            const bf16x8 a0 = *(const LAS bf16x8*)pa, a1 = *(const LAS bf16x8*)(pa + 32);
#pragma unroll
            for (int nt = 0; nt < 2; ++nt) {
                const LAS bf16_t* pb = (nt ? Kb : Bb) + (t0 + c) * LDB + 8 * q;
                const bf16x8 b0 = *(const LAS bf16x8*)pb, b1 = *(const LAS bf16x8*)(pb + 32);
                f32x4 g = __builtin_amdgcn_mfma_f32_16x16x32_bf16(a0, b0, (f32x4){0.f, 0.f, 0.f, 0.f}, 0, 0, 0);
                g = __builtin_amdgcn_mfma_f32_16x16x32_bf16(a1, b1, g, 0, 0, 0);
#pragma unroll
                for (int r = 0; r < 4; ++r) { const int t = 4 * q + r; const bool keep = mt ? (c <= t) : (c < t); const float gv = keep ? g[r] : 0.f; GL[gc * 32 * LDG + (16 * mt + t) * LDG + 16 * nt + c] = gv;
                    if (mt == 0 && nt == 1) LKb[(gc * 16 + t) * LDK + c] = (bf16_t)f2bf(gv); }
            }
        }
        __syncthreads();
        if (w == 0) {
            float tr[16];
            const LAS float* Lg = GL + q * 32 * LDG;
#pragma unroll
            for (int t = 0; t < 16; ++t) { float acc = (t == c) ? 1.f : 0.f;
#pragma unroll
                for (int i = 0; i < t; ++i) acc += Lg[t * LDG + i] * tr[i];
                tr[t] = acc; TL[q * 16 * LDT + t * LDT + c] = acc; Tbb[(q * 16 + t) * LDK + c] = (bf16_t)f2bf(acc); }
        }
#pragma unroll
        for (int e = 0; e < 2; ++e)
#pragma unroll
            for (int r = 0; r < 4; ++r) Sb[(16 * rt + 4 * q + r) * LDB + 16 * (2 * kh + e) + c] = (bf16_t)f2bf(st[e][r]);
        if (PUB) asm volatile("s_waitcnt vmcnt(0)" ::: "memory");
        __syncthreads();
        if (PUB && tid == 0 && tb > 0) __hip_atomic_store(prog, (unsigned)tb, __ATOMIC_RELAXED, __HIP_MEMORY_SCOPE_AGENT);
        for (int ch = 0; ch < nch; ++ch) {
            const int t0 = 16 * ch;
            const int xm = w >> 2, nt = w & 3;
            f32x4 x;
            {
                const LAS bf16_t* xa = (xm ? Rb : Ab) + (t0 + c) * LDB + 8 * q; const LAS bf16_t* xs = Sb + (16 * nt + c) * LDB + 8 * q;
                const bf16x8 a0 = *(const LAS bf16x8*)xa, a1 = *(const LAS bf16x8*)(xa + 32), s0 = *(const LAS bf16x8*)xs, s1 = *(const LAS bf16x8*)(xs + 32);
                x = __builtin_amdgcn_mfma_f32_16x16x32_bf16(a0, s0, (f32x4){0.f, 0.f, 0.f, 0.f}, 0, 0, 0);
                x = __builtin_amdgcn_mfma_f32_16x16x32_bf16(a1, s1, x, 0, 0, 0);
            }
            const LAS float* Gc = GL + ch * 32 * LDG;
            if (xm == 0) {
                typedef short s16x4_t __attribute__((ext_vector_type(4)));
                const s16x4_t lkf = *(const LAS s16x4_t*)(LKb + (ch * 16 + c) * LDK + 4 * q), vtf = *(const LAS s16x4_t*)(VTb + (16 * nt + c) * LDB + t0 + 4 * q);
                const s16x4_t tbf = *(const LAS s16x4_t*)(Tbb + (ch * 16 + c) * LDK + 4 * q);
                x = __builtin_amdgcn_mfma_f32_16x16x16bf16_1k(lkf, vtf, x, 0, 0, 0);
                const unsigned rh0 = pk2(x[0], x[1]), rh1 = pk2(x[2], x[3]);
                const s16x4_t rhf = __builtin_bit_cast(s16x4_t, (u32x2){rh0, rh1});
                f32x4 u = __builtin_amdgcn_mfma_f32_16x16x16bf16_1k(tbf, rhf, (f32x4){0.f, 0.f, 0.f, 0.f}, 0, 0, 0);
#pragma unroll
                for (int r = 0; r < 4; ++r) UL[(4 * q + r) * LD + 16 * nt + c] = u[r];
                *(LAS u32x2*)(UTb + (16 * nt + c) * LDU + 4 * q) = (u32x2){pk2(u[0], u[1]), pk2(u[2], u[3])};
            }
            __syncthreads();
            if (xm == 1) {
                x = mm<16>(x, Gc + (16 + c) * LDG + q, 1, UL + q * LD + 16 * nt + c, LD);
                x = mm<16>(x, Gc + (16 + c) * LDG + 16 + q, 1, Vl + (t0 + q) * LD + 16 * nt + c, LD);
#pragma unroll
                for (int r = 0; r < 4; ++r) Yl[(t0 + 4 * q + r) * LD + 16 * nt + c] = x[r];
            }
            {
                const LAS bf16_t* pf = (q < 2) ? UTb + (16 * rt + c) * LDU + 8 * q : VTb + (16 * rt + c) * LDB + t0 + 8 * (q - 2);
                const bf16x8 uvf = *(const LAS bf16x8*)pf;
#pragma unroll
                for (int e = 0; e < 2; ++e) {
                    const int kt = 2 * kh + e;
                    const LAS bf16_t* ps = (q < 2) ? BTb + (16 * kt + c) * LDB + t0 + 8 * q : KTb + (16 * kt + c) * LDB + t0 + 8 * (q - 2);
                    const bf16x8 bkf = *(const LAS bf16x8*)ps;
                    st[e] = __builtin_amdgcn_mfma_f32_16x16x32_bf16(uvf, bkf, st[e], 0, 0, 0);
                    const float wcv = WCl[ch * 64 + 16 * kt + c];
                    st[e] = st[e] * wcv;
                }
            }
            if (BAT) {
#pragma unroll
                for (int e = 0; e < 2; ++e)
#pragma unroll
                    for (int r = 0; r < 4; ++r) Sout[(size_t)ch * sstride + (size_t)(16 * rt + 4 * q + r) * 64 + 16 * (2 * kh + e) + c] = st[e][r];
                if (ch + 1 < nch) {
#pragma unroll
                    for (int e = 0; e < 2; ++e)
#pragma unroll
                        for (int r = 0; r < 4; ++r) st[e][r] = S0[(size_t)(ch + 1) * sstride + (size_t)(16 * rt + 4 * q + r) * 64 + 16 * (2 * kh + e) + c];
                }
            }
            if (ch + 1 < nch) {
#pragma unroll
                for (int e = 0; e < 2; ++e)
#pragma unroll
                    for (int r = 0; r < 4; ++r) Sb[(16 * rt + 4 * q + r) * LDB + 16 * (2 * kh + e) + c] = (bf16_t)f2bf(st[e][r]);
            }
            __syncthreads();
        }
        if (BAT ? ((tt & 15) < DS) : (tt < nvt)) {
            const size_t row = BAT ? (size_t)(rowbase + (tt >> 4) * DS + (tt & 15)) : (size_t)(rowbase + tb + tt);
            float y[8]; float s = 0.f;
#pragma unroll
            for (int e = 0; e < 8; ++e) { y[e] = Yl[tt * LD + 8 * part + e]; s += y[e]; }
            s += __shfl_xor(s, 1); s += __shfl_xor(s, 2); s += __shfl_xor(s, 4);
            const float mu = s * (1.f / 64.f); float s2 = 0.f;
#pragma unroll
            for (int e = 0; e < 8; ++e) { y[e] -= mu; s2 += y[e] * y[e]; }
            s2 += __shfl_xor(s2, 1); s2 += __shfl_xor(s2, 2); s2 += __shfl_xor(s2, 4);
            const float rstd = 1.0f / sqrtf(s2 * (1.f / 64.f) + GN_EPS);
            float o[8];
            const float cb = CBl[tt];
#pragma unroll
            for (int e = 0; e < 8; ++e) o[e] = (y[e] * rstd * clg[e] + clb[e] + cb * Vl[tt * LD + 8 * part + e]) * gcur[e];
            if (PUB) { const u32x4 yv = pack8(o); const bf16_t* yp = ycat + row * D + hk; asm volatile("global_store_dwordx4 %0, %1, off sc1" :: "v"(yp), "v"(yv) : "memory"); }
            else *(GAS u32x4*)(ycat + row * D + hk) = pack8(o);
        }
    }
#undef RW_PREFETCH
    if (!BAT)
#pragma unroll
    for (int e = 0; e < 2; ++e)
#pragma unroll
        for (int r = 0; r < 4; ++r) Sout[(size_t)(16 * rt + 4 * q0 + r) * 64 + 16 * (2 * kh + e) + c0] = st[e][r];
    if (PUB) asm volatile("s_waitcnt vmcnt(0)" ::: "memory");
    __syncthreads();
    if (PUB && tid == 0) __hip_atomic_store(prog, (unsigned)T, __ATOMIC_RELAXED, __HIP_MEMORY_SCOPE_AGENT);
}
__global__ void __launch_bounds__(NTHREADS, 2) mega_fwd(Args args) {
    extern __shared__ __attribute__((aligned(16))) unsigned char lds_raw[];
    Frame F;
    F.lds = (LAS unsigned char*)lds_raw;
    F.out = args.out; F.ws = args.ws;
    F.tid = threadIdx.x; F.lane = F.tid & 63; F.wave = __builtin_amdgcn_readfirstlane(F.tid >> 6);
    F.G = gridDim.x; { const int bx = blockIdx.x; const int vcu = (F.G % 8 == 0) ? (bx % 8) * (F.G / 8) + bx / 8 : bx; F.gw = vcu * NWAVES + F.wave; }
    F.NGW = F.G * NWAVES;
    volatile LAS unsigned* MISC = (volatile LAS unsigned*)(F.lds + MISC_OFF);
    for (int u = F.tid; u < (LDS_BYTES - LDSCTL_OFF) / 4; u += NTHREADS) ((LAS unsigned*)(F.lds + LDSCTL_OFF))[u] = 0u;
    __syncthreads();
    unsigned* ctl = (unsigned*)(F.ws + WS_CTL);
    XcdBarrier bar = xcd_barrier_post(ctl + CW_BAR, MISC + 8);
    const int lo = args.ph_lo, hi = args.ph_hi;
#ifndef PHASE_MASK
#define PHASE_MASK 0x1ffffu
#endif
#define IN(k) (((PHASE_MASK >> (k)) & 1u) && lo <= (k) && (k) < hi)
#define SEAM(k) do { if (IN(k) && IN((k) + 1)) xcd_barrier(bar); } while (0)
#ifndef DUP_MASK
#define DUP_MASK 0u
#endif
#define RUNPH(k, ...) if (IN(k)) { __VA_ARGS__; if ((DUP_MASK >> (k)) & 1u) { xcd_barrier(bar); __VA_ARGS__; } }

    const int vcu = F.gw >> 3;
    unsigned char* ws = F.ws;
    RUNPH(0, { p0_prologue(F, args); __syncthreads(); p0_rows(F, args); })
    SEAM(0);
    RUNPH(1, pg8::gemm_phase<1u << pg8::EM_BF16>(F.lds, c_ph[0], ws, args.in[I_W0], args.in[I_A0], F.G, (int)blockIdx.x, ctl + CW_SPLIT + 1 * 256, MISC + 16);)
    SEAM(1);
    RUNPH(2, {    \
        if (vcu < 128) { mlstm_prompt_job(F, args, vcu); } \
        else { for (int j = vcu - 128; j < 384; j += 128) { if (j < 128) rglru_job(F, args, 0, j >> 5, (j >> 2) & 7, j & 3); else { const int k = j - 128; rglru_job(F, args, 1, k >> 5, (k >> 2) & 7, k & 3); } } \
               for (int j = vcu - 128; j < DB * NHA; j += 128) mlstm_sample_job(F, args, j); } \
    })
    SEAM(2);
    RUNPH(3, headnorm_pass(F, args);)
    SEAM(3);
    RUNPH(4, { pg8::gemm_phase<1u << pg8::EM_RESID>(F.lds, c_ph[1], ws, args.in[I_W0], args.in[I_A0], F.G, (int)blockIdx.x, ctl + CW_SPLIT + 4 * 256, MISC + 16); \
        constexpr int BUSY4 = ((MP / 256) * (D / 256) - 256) * 4;       \
        if ((int)blockIdx.x >= BUSY4) { Frame F2 = F; F2.gw = ((int)blockIdx.x - BUSY4) * NWAVES + F.wave; F2.NGW = (F.G - BUSY4) * NWAVES; int cursor = 0; convert_wup(F2, args, 0, cursor, (LAS float*)(F.lds + F.wave * 16896)); } })
    SEAM(4);
    RUNPH(5, ln_pass(F, (const bf16_t*)(ws + WS_ZRES), args.in[I_LN1G], args.in[I_LN1B], (bf16_t*)(ws + WS_HA));)
    SEAM(5);
    RUNPH(6, { pg8::gemm_phase<1u << pg8::EM_RELU2>(F.lds, c_ph[2], ws, args.in[I_W0], args.in[I_A0], F.G, (int)blockIdx.x, ctl + CW_SPLIT + 6 * 256, MISC + 16); \
        constexpr int BUSY6 = (MP / 256) * (DFF / 256) - 4 * 256;       \
        if ((int)blockIdx.x >= BUSY6) { Frame F2 = F; F2.gw = ((int)blockIdx.x - BUSY6) * NWAVES + F.wave; F2.NGW = (F.G - BUSY6) * NWAVES; int cursor = 0; convert_wdn(F2, args, 0, cursor, (LAS float*)(F.lds + F.wave * 16896)); } })
    SEAM(6);
    RUNPH(7, { pg8::gemm_phase<1u << pg8::EM_RESID>(F.lds, c_ph[3], ws, args.in[I_W0], args.in[I_A0], F.G, (int)blockIdx.x, ctl + CW_SPLIT + 7 * 256, MISC + 16); \
        constexpr int BUSY = ((MP / 256) * (D / 256) - 256) * 4;        \
        if ((int)blockIdx.x >= BUSY) { Frame F2 = F; F2.gw = ((int)blockIdx.x - BUSY) * NWAVES + F.wave; F2.NGW = (F.G - BUSY) * NWAVES; convert_rwkv_weights(F2, args, (LAS float*)(F.lds + F.wave * 16896)); } })
    SEAM(7);
    RUNPH(8, ln_mix_pass(F, args, (const bf16_t*)(ws + WS_ZRES), args.in[I_LN2G], args.in[I_LN2B]);)
    SEAM(8);
    RUNPH(9, pg8::gemm_phase<(1u << pg8::EM_BF16) | (1u << pg8::EM_TANH) | (1u << pg8::EM_SIGM)>(F.lds, c_ph[4], ws, args.in[I_W0], args.in[I_A0], F.G, (int)blockIdx.x, ctl + CW_SPLIT + 9 * 256, MISC + 16);)
    SEAM(9);
    RUNPH(10, pg8::gemm_phase<(1u << pg8::EM_BF16) | (1u << pg8::EM_WDEC) | (1u << pg8::EM_ASIG)>(F.lds, c_ph[5], ws, args.in[I_W0], args.in[I_A0], F.G, (int)blockIdx.x, ctl + CW_SPLIT + 10 * 256, MISC + 16);)
    SEAM(10);
    RUNPH(11, {   \
        const int rep_a = ((DUP_MASK >> 17) & 1u) ? 2 : 1; const int rep_b = ((DUP_MASK >> 18) & 1u) ? 2 : 1; \
        if (vcu < NB * NHC) { const int bb = vcu >> 5; const int h = vcu & 31; for (int rep = 0; rep < rep_a; ++rep) rwkv_job_c<true>(F, args, bb * TP, TP, h, nullptr, F.out + O_PS + (size_t)(bb * NHC + h) * HDC * HDC, ctl + CW_PROG + vcu); } \
        else { for (int rep = 0; rep < rep_b; ++rep) for (int j = vcu - NB * NHC; j < (DB / 4) * NHC; j += F.G - NB * NHC) { const int bb = 4 * (j >> 5); const int h = j & 31; \
            rwkv_job_c<false, true>(F, args, MPR + bb * DS, 64, h, args.in[I_RS] + (size_t)(bb * NHC + h) * HDC * HDC, F.out + O_SS + (size_t)(bb * NHC + h) * HDC * HDC, nullptr, (size_t)NHC * HDC * HDC); } \
              \
            asm volatile("s_waitcnt vmcnt(0)" ::: "memory"); __syncthreads(); \
            if (F.tid == 0) { __builtin_amdgcn_fence(__ATOMIC_RELEASE, "agent"); asm volatile("s_waitcnt vmcnt(0)" ::: "memory"); __hip_atomic_fetch_add(ctl + CW_PROG + 256, 1u, __ATOMIC_RELAXED, __HIP_MEMORY_SCOPE_AGENT); } \
            Frame F2 = F; F2.gw = (vcu - NB * NHC) * NWAVES + F.wave; F2.NGW = (F.G - NB * NHC) * NWAVES; int cursor = 0; \
            convert_wup(F2, args, 1, cursor, (LAS float*)(F.lds + F.wave * 16896)); \
            __syncthreads(); \
            pg8::gemm_phase<1u << pg8::EM_RESID, 1>(F.lds, c_ph[7], ws, args.in[I_W0], args.in[I_A0], F.G - NB * NHC, vcu - NB * NHC, ctl + CW_SPLIT + 11 * 256, MISC + 16, ctl + CW_PROG); } \
    })
    SEAM(11);
    RUNPH(12, { pg8::gemm_phase<1u << pg8::EM_RESID>(F.lds, c_ph[6], ws, args.in[I_W0], args.in[I_A0], F.G, (int)blockIdx.x, ctl + CW_SPLIT + 12 * 256, MISC + 16); \
        constexpr int BUSY12 = pg8::N_LATE * (D / 256);                \
        if ((int)blockIdx.x >= BUSY12) { Frame F2 = F; F2.gw = ((int)blockIdx.x - BUSY12) * NWAVES + F.wave; F2.NGW = (F.G - BUSY12) * NWAVES; int cursor = 0; \
            convert_wdn(F2, args, 1, cursor, (LAS float*)(F.lds + F.wave * 16896)); } })
    SEAM(12);
    RUNPH(13, ln_pass(F, (const bf16_t*)(ws + WS_ZRES), args.in[I_LN1G] + D, args.in[I_LN1B] + D, (bf16_t*)(ws + WS_HA));)
    SEAM(13);
    RUNPH(14, pg8::gemm_phase<1u << pg8::EM_RELU2>(F.lds, c_ph[2], ws, args.in[I_W0], args.in[I_A0], F.G, (int)blockIdx.x, ctl + CW_SPLIT + 14 * 256, MISC + 16);)
    SEAM(14);
    RUNPH(15, pg8::gemm_phase<1u << pg8::EM_RESID>(F.lds, c_ph[3], ws, args.in[I_W0], args.in[I_A0], F.G, (int)blockIdx.x, ctl + CW_SPLIT + 15 * 256, MISC + 16);)
    SEAM(15);
    RUNPH(16, ln_final(F, (const bf16_t*)(ws + WS_ZRES), args.in[I_LN2G] + D, args.in[I_LN2B] + D);)
#undef IN
#undef SEAM
}

constexpr int N_PHASES = 17;
extern "C" void kernel_launch(void* const* d_in, const int* in_sizes, int n_in, void* d_out, int out_size, void* d_ws, size_t ws_size, hipStream_t stream) {
    static int grid = 0;
    if (grid == 0) {
        if (n_in != N_IN || (size_t)out_size != O_END || ws_size < WS_END) { fprintf(stderr, "kernel_launch: unexpected sizes n_in %d out %d ws %zu (need %zu)\n", n_in, out_size, ws_size, (size_t)WS_END); grid = -1; return; }
        int dev = 0, cus = 0;
        if (hipGetDevice(&dev) != hipSuccess || hipDeviceGetAttribute(&cus, hipDeviceAttributeMultiprocessorCount, dev) != hipSuccess) { grid = -1; return; }
        if (hipFuncSetAttribute((const void*)mega_fwd, hipFuncAttributeMaxDynamicSharedMemorySize, LDS_BYTES) != hipSuccess) { fprintf(stderr, "kernel_launch: hipFuncSetAttribute failed\n"); grid = -1; return; }
        grid = cus;
    }
    if (grid < 0) return;
    (void)hipMemsetAsync((char*)d_ws + WS_CTL, 0, CTL_ZERO_BYTES, stream);
    Args a{};
    for (int i = 0; i < N_IN; ++i) a.in[i] = (const float*)d_in[i];
    a.out = (float*)d_out; a.ws = (unsigned char*)d_ws;
    a.ph_lo = 0; a.ph_hi = N_PHASES;
    hipLaunchKernelGGL(mega_fwd, dim3(grid), dim3(NTHREADS), LDS_BYTES, stream, a);
}
```

```cpp
#include <hip/hip_runtime.h>
#include <cstdio>
#include <cstdint>

#define GAS __attribute__((address_space(1)))
#define LAS __attribute__((address_space(3)))
typedef unsigned short bf16_t;
typedef short bf16x8 __attribute__((ext_vector_type(8)));
typedef short s16x4 __attribute__((ext_vector_type(4)));
typedef float f32x4 __attribute__((ext_vector_type(4)));
typedef float f32x2 __attribute__((ext_vector_type(2)));
typedef unsigned u32x4 __attribute__((ext_vector_type(4)));
typedef unsigned u32x2 __attribute__((ext_vector_type(2)));

constexpr int D = 2048, NB = 4, SEQ = 2048, NMETA = 16, TP = SEQ + NMETA  , DB = 128, DS = 8;
constexpr int MPR = NB * TP  , MSA = DB * DS  , M = MPR + MSA  , MP = 9472  ;
constexpr int NHA = 4, HDA = 256, MIXA = 1024, RGW = 1024, PROJ = 6152, NZ = 6144, DFF = 8192;
constexpr int NHC = 32, HDC = 64;
constexpr float ALPHA = 1.4142135623730951f;
constexpr float LN_EPS = 1e-5f, GN_EPS = 64e-5f;
constexpr int NWAVES = 8, NTHREADS = 512;

constexpr size_t O_YP = 0, O_YS = O_YP + (size_t)NB * SEQ * D, O_PC = O_YS + (size_t)DB * DS * D, O_PN = O_PC + (size_t)NB * NHA * HDA * HDA,
                 O_PM = O_PN + (size_t)NB * NHA * HDA, O_PH = O_PM + NB * NHA, O_PCV = O_PH + (size_t)NB * RGW, O_PS = O_PCV + (size_t)NB * 3 * RGW,
                 O_PX = O_PS + (size_t)NB * NHC * HDC * HDC, O_SC = O_PX + (size_t)NB * D, O_SN = O_SC + (size_t)DB * NHA * HDA * HDA,
                 O_SM = O_SN + (size_t)DB * NHA * HDA, O_SH = O_SM + DB * NHA, O_SCV = O_SH + (size_t)DB * RGW, O_SS = O_SCV + (size_t)DB * 3 * RGW,
                 O_SX = O_SS + (size_t)DB * NHC * HDC * HDC, O_END = O_SX + (size_t)DB * D;
static_assert(O_END == 71725584, "output size");

enum { I_XP = 0, I_XS, I_MC, I_MN, I_MM, I_RH, I_RC, I_RS, I_RX, I_META, I_WIN, I_BIF, I_MNG, I_CVW, I_CVB, I_WA, I_BA, I_WX, I_BX, I_LAM, I_WOUT,
       I_MU, I_WR, I_WK, I_WV, I_WO, I_W0, I_W1, I_W2, I_A0, I_A1, I_A2, I_G1, I_G2, I_KK, I_KA, I_RK, I_LNXG, I_LNXB, I_LN1G, I_LN1B, I_LN2G, I_LN2B, I_WUP, I_WDN, N_IN };
static_assert(N_IN == 45, "inputs");

constexpr size_t MiB = 1u << 20;
constexpr size_t U37 = (size_t)MP * D * 2;
constexpr size_t WS_CTL = 0, CTL_ZERO_BYTES = 1 * MiB;
constexpr size_t WS_WIN = 1 * MiB;
constexpr size_t WS_WOUT = WS_WIN + 24 * MiB;
constexpr size_t WS_WR = WS_WOUT + 8 * MiB, WS_WK = WS_WR + 8 * MiB, WS_WV = WS_WK + 8 * MiB, WS_WO = WS_WV + 8 * MiB;
constexpr size_t WS_L1 = WS_WO + 8 * MiB;
constexpr size_t WS_L2 = WS_L1 + 3 * MiB;
constexpr size_t WS_WUP = WS_L2 + 3 * MiB;
constexpr size_t WS_WDN = WS_WUP + 32 * MiB;
constexpr size_t WS_ZRES = WS_WDN + 32 * MiB;
constexpr size_t WS_HA = WS_ZRES + U37, WS_HB = WS_HA + U37;
constexpr size_t WS_GATES = WS_HB + U37;
constexpr size_t WS_BIG = WS_GATES + 1 * MiB;
constexpr size_t WS_X0 = WS_BIG, WS_ZIN = WS_X0 + U37, WS_HM = WS_ZIN + (size_t)MP * NZ * 2, WS_CAT = WS_HM + (size_t)MP * MIXA * 2;
constexpr size_t WS_U = WS_BIG;
constexpr size_t WS_XS = WS_BIG;
constexpr size_t WS_RKV = WS_XS + 6 * U37;
constexpr size_t WS_LO1 = WS_RKV + 3 * U37;
constexpr size_t WS_WDEC = WS_XS;
constexpr size_t WS_AG = WS_WDEC + 2 * U37;
constexpr size_t WS_GG = WS_AG + U37;
constexpr size_t WS_YCAT = WS_GG + U37;
constexpr size_t WS_END = WS_LO1 + 3 * (size_t)MP * 256 * 2;
constexpr size_t WS_SLAB = WS_RKV;
static_assert(240 * (size_t)262144 <= 3 * U37, "slab overlay");
static_assert(WS_YCAT + U37 <= WS_RKV, "overlay");
static_assert(WS_CAT + U37 <= WS_END && WS_U + (size_t)MP * DFF * 2 <= WS_END, "big region");

constexpr int CW_BAR = 4096;
constexpr int CW_SPLIT = 16384;
constexpr int CW_PROG = 24576;

__device__ __forceinline__ unsigned f2bf(float f) { unsigned u = __builtin_bit_cast(unsigned, f); return (u + 0x7fffu + ((u >> 16) & 1u)) >> 16; }
__device__ __forceinline__ unsigned pk2(float lo, float hi) { return f2bf(lo) | (f2bf(hi) << 16); }
__device__ __forceinline__ float bf2f(unsigned short b) { return __builtin_bit_cast(float, (unsigned)b << 16); }
__device__ __forceinline__ float bflo(unsigned w) { return __builtin_bit_cast(float, w << 16); }
__device__ __forceinline__ float bfhi(unsigned w) { return __builtin_bit_cast(float, w & 0xffff0000u); }
typedef __bf16 bf16x2_hw __attribute__((ext_vector_type(2)));
__device__ __forceinline__ unsigned cvt_pk_bf16(float lo, float hi) { const f32x2 v = {lo, hi}; const bf16x2_hw b = __builtin_convertvector(v, bf16x2_hw); return __builtin_bit_cast(unsigned, b); }
__device__ __forceinline__ void lds_barrier() { asm volatile("s_waitcnt lgkmcnt(0)" ::: "memory"); __builtin_amdgcn_s_barrier(); asm volatile("" ::: "memory"); }
__device__ __forceinline__ float wave_sum(float v) {
#pragma unroll
    for (int o = 1; o < 64; o <<= 1) v += __shfl_xor(v, o);
    return v;
}
__device__ __forceinline__ float sigmoidf_(float x) { return __builtin_amdgcn_rcpf(1.0f + __expf(-x)); }
__device__ __forceinline__ float softplusf_(float x) { return fmaxf(x, 0.f) + __logf(1.0f + __expf(-fabsf(x))); }
__device__ __forceinline__ float sigm3_(float x) { return __builtin_amdgcn_rcpf(1.0f + __expf(-x)); }
__device__ __forceinline__ float wdecayf_(float x) { return __expf(-0.6065306597126334f * sigm3_(x)); }
__device__ __forceinline__ float tanhf_(float x) { const float e = __expf(2.0f * x); return 1.0f - 2.0f * __builtin_amdgcn_rcpf(e + 1.0f); }
#define LDS_WAIT() asm volatile("s_waitcnt lgkmcnt(0)" ::: "memory")
#define VM_WAIT() asm volatile("s_waitcnt vmcnt(0)" ::: "memory")

#define XB_TMO      128
#define XB_XCNT(j)  (256  + 64 * (j))
#define XB_XSUB(j)  (1280 + 64 * (j))
#define XB_XGEN(j)  (2304 + 64 * (j))
#define XB_TOP      3328
#define XB_TOPGEN   3392
#define XCD_BAR_WORDS 3456
#define XB_SPIN_CAP (1u << 18)
__device__ __forceinline__ unsigned xb_ld(unsigned* p)              { return __hip_atomic_load(p, __ATOMIC_RELAXED, __HIP_MEMORY_SCOPE_AGENT); }
__device__ __forceinline__ unsigned xb_add(unsigned* p, unsigned v) { return __hip_atomic_fetch_add(p, v, __ATOMIC_RELAXED, __HIP_MEMORY_SCOPE_AGENT); }
__device__ __forceinline__ unsigned xb_xcc_id() { return (unsigned)__builtin_amdgcn_s_getreg((3 << 11) | 20) & 0xFu; }
#define XB_SPIN(cond, bar) do { unsigned _sp = 0; while (cond) { __builtin_amdgcn_s_sleep(1); \
    if ((++_sp & 255u) == 0u) { if (xb_ld(&(bar)[XB_TMO])) break; if (_sp > XB_SPIN_CAP) { atomicAdd(&(bar)[XB_TMO], 1u); break; } } } } while (0)
struct XcdBarrier { unsigned* bar; unsigned x; volatile LAS unsigned* st; };
__device__ __forceinline__ XcdBarrier xcd_barrier_post(unsigned* bar, volatile LAS unsigned* st) {
    XcdBarrier b; b.bar = bar; b.x = xb_xcc_id(); b.st = st;
    if (threadIdx.x == 0) (void)xb_add(&bar[XB_XCNT(b.x)], 1u);
    return b;
}
__device__ __forceinline__ void xcd_barrier_complete(unsigned* bar, unsigned x, unsigned& nloc, unsigned& nx) {
    const unsigned G = gridDim.x * gridDim.y * gridDim.z;
    unsigned sum, cnt, mine, sp = 0u;
    for (;;) {
        sum = 0u; cnt = 0u; mine = 0u;
#pragma unroll
        for (unsigned j = 0; j < 16; ++j) { const unsigned c = xb_ld(&bar[XB_XCNT(j)]); sum += c; cnt += (c > 0u) ? 1u : 0u; mine = (j == x) ? c : mine; }
        if (sum == G) break;
        __builtin_amdgcn_s_sleep(1);
        if ((++sp & 255u) == 0u) { if (xb_ld(&bar[XB_TMO])) break; if (sp > XB_SPIN_CAP) { atomicAdd(&bar[XB_TMO], 1u); break; } }
    }
    nloc = mine > 0u ? mine : 1u; nx = cnt > 0u ? cnt : 1u;
}
__device__ __forceinline__ void xcd_barrier(const XcdBarrier& b) {
    asm volatile("s_waitcnt vmcnt(0)" ::: "memory");
    __syncthreads();
    if (threadIdx.x == 0) {
        unsigned* bar = b.bar;
        __builtin_amdgcn_s_waitcnt(0);
        unsigned nloc = b.st[0], nx = b.st[1];
        if (nloc == 0u) { xcd_barrier_complete(bar, b.x, nloc, nx); b.st[0] = nloc; b.st[1] = nx; }
        const unsigned old = xb_add(&bar[XB_XSUB(b.x)], 1u);
        const unsigned gen = old / nloc;
        if (old + 1u == (gen + 1u) * nloc) {
            __builtin_amdgcn_fence(__ATOMIC_RELEASE, "agent");
            asm volatile("s_waitcnt vmcnt(0)" ::: "memory");
            const unsigned og = xb_add(&bar[XB_TOP], 1u);
            const unsigned tg = og / nx;
            if (og + 1u == (tg + 1u) * nx) xb_add(&bar[XB_TOPGEN], 1u);
            else XB_SPIN(xb_ld(&bar[XB_TOPGEN]) == tg, bar);
            __builtin_amdgcn_fence(__ATOMIC_ACQUIRE, "agent");
            xb_add(&bar[XB_XGEN(b.x)], 1u);
            asm volatile("s_waitcnt vmcnt(0)" ::: "memory");
        } else {
            XB_SPIN(xb_ld(&bar[XB_XGEN(b.x)]) == gen, bar);
            __builtin_amdgcn_fence(__ATOMIC_ACQUIRE, "agent");
            asm volatile("s_waitcnt vmcnt(0)" ::: "memory");
        }
    }
    __syncthreads();
}

namespace pg8 {
constexpr int BM = 256, BK = 64, HALF = 128, HTB = HALF * BK * 2, STAGE_BYTES = 8 * HTB, NXCD = 8, WGM = 8;
__host__ __device__ __forceinline__ int lds_byte(int r, int c) { const int st = (r >> 4) * 2 + (c >> 5), rr = r & 15, cc = c & 31, ob = rr * 64 + cc * 2; return st * 1024 + (ob ^ (((ob >> 9) & 1) << 5)); }
__host__ __device__ __forceinline__ void stage_rc(int b, int& R, int& C) { const int st = b / 1024, sb = b % 1024, swz = sb ^ (((sb >> 9) & 1) << 5); R = (st >> 1) * 16 + swz / 64; C = (st & 1) * 32 + (swz % 64) / 2; }
__host__ __device__ __forceinline__ int perm32(int rho) { const int n = rho >> 4, i = rho & 15; return 8 * (i >> 2) + 4 * n + (i & 3); }

struct Unit { int pm, pn, job, split, kpart, tail; };
enum { EM_BF16 = 0, EM_RELU2 = 1, EM_TANH = 2, EM_SIGM = 3, EM_RESID = 4, EM_WDEC = 5, EM_ASIG = 6 };
struct JobC { unsigned A, B, out, aux; int nN, ldc, mode, pad; };
struct PhaseC { int njobs, K, lda, totN, split, pad0, pad1, pad2; JobC job[6]; };
__constant__ int c_plist[2][32] = {
    {33, 34, 35, 36, 0, 25, 17, 9, 1, 26, 18, 10, 2, 27, 19, 11, 0, 0, 0, 0, 0, 0, 0, 0, 0, 0, 0, 0, 0, 0, 0, 0},
    {3, 28, 20, 12, 4, 29, 21, 13, 5, 30, 22, 14, 6, 7, 8, 15, 16, 23, 24, 31, 32, 0, 0, 0, 0, 0, 0, 0, 0, 0, 0, 0}};
constexpr int N_EARLY = 16, N_LATE = 21;
static_assert(N_EARLY + N_LATE == MP / 256, "panel lists");
struct Order {
    int nwg, G, c;
    __device__ __forceinline__ void init(int nM, int totN, int G_, int c_) { nwg = nM * totN; G = G_; c = c_; }
    __device__ __forceinline__ bool next(const PhaseC& P, int i, Unit& u) const {
        long L = (long)i * G + c;
        const int nfull = (nwg / G) * G, sp = P.split;
        if (L >= nwg && !(sp > 1 && L >= nfull)) return false;
        u.split = 1; u.kpart = 0; u.tail = 0;
        if (sp > 1 && L >= nfull) { const int j = (int)(L - nfull); if (j >= (nwg - nfull) * sp) return false; u.split = sp; u.kpart = j % sp; u.tail = j / sp; L = nfull + j / sp; }
        if (P.pad0) { u.pm = c_plist[P.pad0 - 1][(int)L / P.totN]; u.pn = (int)L % P.totN; u.job = 0; return true; }
        int wgid = (int)L; { const int q = nwg / NXCD, r = nwg % NXCD, xcd = wgid % NXCD, off = wgid / NXCD; wgid = (xcd < r ? xcd * (q + 1) : r * (q + 1) + (xcd - r) * q) + off; }
        const int nM = MP / BM, nN = P.totN;
        const int nig = WGM * nN, gid = wgid / nig, fm = gid * WGM, gsz = (nM - fm) < WGM ? (nM - fm) : WGM;
        u.pm = fm + ((wgid % nig) % gsz); int pnv = (wgid % nig) / gsz; int job = 0;
        while (pnv >= P.job[job].nN) { pnv -= P.job[job].nN; ++job; }
        u.pn = pnv; u.job = job; return true;
    }
};

template <int MODE>
__device__ __forceinline__ void epilogue_mode(const f32x4 (&acc)[2][2][4][2], char* outp, const void* aux, int ldc, int row0, int col0) {
#pragma unroll
    for (int ai = 0; ai < 2; ++ai)
#pragma unroll
        for (int m = 0; m < 4; ++m) {
            const int row = row0 + ai * HALF + m * 16;
#pragma unroll
            for (int bj = 0; bj < 2; ++bj) {
                const int col = col0 + bj * HALF;
                f32x4 v0 = acc[ai][bj][m][0], v1 = acc[ai][bj][m][1];
                if (MODE == EM_WDEC) {
                    const float* w0 = (const float*)aux; const f32x4 b0 = *(const f32x4*)(w0 + col), b1 = *(const f32x4*)(w0 + col + 4);
#pragma unroll
                    for (int j = 0; j < 4; ++j) { v0[j] = wdecayf_(v0[j] + b0[j]); v1[j] = wdecayf_(v1[j] + b1[j]); }
                    float* o = (float*)outp + (size_t)row * ldc + col; *(f32x4*)o = v0; *(f32x4*)(o + 4) = v1;
                } else {
                    if (MODE == EM_RELU2) {
#pragma unroll
                        for (int j = 0; j < 4; ++j) {
                            const float a0 = v0[j], a1 = v1[j]; int i0 = __builtin_bit_cast(int, a0), i1 = __builtin_bit_cast(int, a1); i0 = i0 > 0 ? i0 : 0; i1 = i1 > 0 ? i1 : 0;
                            const float x0 = __builtin_bit_cast(float, i0), x1 = __builtin_bit_cast(float, i1); v0[j] = x0 * x0; v1[j] = x1 * x1; }
                    } else if (MODE == EM_TANH) {
#pragma unroll
                        for (int j = 0; j < 4; ++j) { v0[j] = tanhf_(v0[j]); v1[j] = tanhf_(v1[j]); }
                    } else if (MODE == EM_SIGM) {
#pragma unroll
                        for (int j = 0; j < 4; ++j) { v0[j] = sigmoidf_(v0[j]); v1[j] = sigmoidf_(v1[j]); }
                    } else if (MODE == EM_ASIG) {
                        const float* a0 = (const float*)aux; const f32x4 b0 = *(const f32x4*)(a0 + col), b1 = *(const f32x4*)(a0 + col + 4);
#pragma unroll
                        for (int j = 0; j < 4; ++j) { v0[j] = sigm3_(v0[j] + b0[j]); v1[j] = sigm3_(v1[j] + b1[j]); }
                    } else if (MODE == EM_RESID) {
                        const u32x4 r = *(const u32x4*)((const bf16_t*)aux + (size_t)row * D + col);
                        v0[0] += ALPHA * bflo(r.x); v0[1] += ALPHA * bfhi(r.x); v0[2] += ALPHA * bflo(r.y); v0[3] += ALPHA * bfhi(r.y);
                        v1[0] += ALPHA * bflo(r.z); v1[1] += ALPHA * bfhi(r.z); v1[2] += ALPHA * bflo(r.w); v1[3] += ALPHA * bfhi(r.w);
                    }
                    u32x4 w; w.x = cvt_pk_bf16(v0[0], v0[1]); w.y = cvt_pk_bf16(v0[2], v0[3]); w.z = cvt_pk_bf16(v1[0], v1[1]); w.w = cvt_pk_bf16(v1[2], v1[3]);
                    *(u32x4*)((bf16_t*)outp + (size_t)row * ldc + col) = w;
                }
            }
        }
}
template <int MODE>
__device__ __forceinline__ void epi_frag(f32x4 v0, f32x4 v1, char* outp, const void* aux, int ldc, int row, int col) {
    if (MODE == EM_RESID) {
        const u32x4 r = *(const u32x4*)((const bf16_t*)aux + (size_t)row * D + col);
        v0[0] += ALPHA * bflo(r.x); v0[1] += ALPHA * bfhi(r.x); v0[2] += ALPHA * bflo(r.y); v0[3] += ALPHA * bfhi(r.y);
        v1[0] += ALPHA * bflo(r.z); v1[1] += ALPHA * bfhi(r.z); v1[2] += ALPHA * bflo(r.w); v1[3] += ALPHA * bfhi(r.w);
    }
    u32x4 w; w.x = cvt_pk_bf16(v0[0], v0[1]); w.y = cvt_pk_bf16(v0[2], v0[3]); w.z = cvt_pk_bf16(v1[0], v1[1]); w.w = cvt_pk_bf16(v1[2], v1[3]);
    *(u32x4*)((bf16_t*)outp + (size_t)row * ldc + col) = w;
}
template <unsigned MM>
__device__ __forceinline__ void epilogue(const f32x4 (&acc)[2][2][4][2], const Unit& u, const PhaseC& P, unsigned char* ws, const float* w0p, const float* a0p, int wr, int wc, int fr, int fq) {
    const int mode = P.job[u.job].mode, ldc = P.job[u.job].ldc;
    char* outp = (char*)ws + P.job[u.job].out; const void* aux = (mode == EM_WDEC) ? (const void*)w0p : (mode == EM_ASIG) ? (const void*)a0p : (const void*)(ws + P.job[u.job].aux);
    const int row0 = u.pm * BM + wr * 64 + fr, col0 = u.pn * BM + wc * 32 + 8 * fq;
    if ((MM & (1u << EM_WDEC)) && mode == EM_WDEC) epilogue_mode<EM_WDEC>(acc, outp, aux, ldc, row0, col0);
    else if ((MM & (1u << EM_RELU2)) && mode == EM_RELU2) epilogue_mode<EM_RELU2>(acc, outp, aux, ldc, row0, col0);
    else if ((MM & (1u << EM_TANH)) && mode == EM_TANH) epilogue_mode<EM_TANH>(acc, outp, aux, ldc, row0, col0);
    else if ((MM & (1u << EM_SIGM)) && mode == EM_SIGM) epilogue_mode<EM_SIGM>(acc, outp, aux, ldc, row0, col0);
    else if ((MM & (1u << EM_ASIG)) && mode == EM_ASIG) epilogue_mode<EM_ASIG>(acc, outp, aux, ldc, row0, col0);
    else if ((MM & (1u << EM_RESID)) && mode == EM_RESID) epilogue_mode<EM_RESID>(acc, outp, aux, ldc, row0, col0);
    else epilogue_mode<EM_BF16>(acc, outp, aux, ldc, row0, col0);
}

__device__ __forceinline__ void wait_panel(int pm, const unsigned* prog, int wid, int lane) {
    if (wid == 0) {
        unsigned spins = 0;
        if (pm >= 33) { while (__hip_atomic_load(prog + 256, __ATOMIC_RELAXED, __HIP_MEMORY_SCOPE_AGENT) < 128u && ++spins < (1u << 22)) __builtin_amdgcn_s_sleep(8); }
        else { const int b = (256 * pm) / TP; const unsigned need = (unsigned)(256 * pm + 256 - TP * b);
            for (;;) { const unsigned v = __hip_atomic_load(prog + b * 32 + (lane & 31), __ATOMIC_RELAXED, __HIP_MEMORY_SCOPE_AGENT);
                if (__all(v >= need) || ++spins >= (1u << 22)) break; __builtin_amdgcn_s_sleep(8); } }
        __builtin_amdgcn_fence(__ATOMIC_ACQUIRE, "agent"); asm volatile("s_waitcnt vmcnt(0)" ::: "memory");
    }
    asm volatile("s_waitcnt lgkmcnt(0)" ::: "memory"); __builtin_amdgcn_s_barrier(); asm volatile("" ::: "memory");
}
template <unsigned MM, int WAITA = 0>
__device__ __forceinline__ void gemm_phase(LAS unsigned char* lds, const PhaseC& P, unsigned char* ws, const float* w0p, const float* a0p, int G, int c, unsigned* cntw, volatile LAS unsigned* flagw, const unsigned* prog = nullptr) {
    const int tid = threadIdx.x, wid = __builtin_amdgcn_readfirstlane(tid >> 6), lane = tid & 63, wr = wid >> 2, wc = wid & 3, fr = lane & 15, fq = lane >> 4;
    const int K = P.K, nt = K / BK, lda = P.lda; const size_t kpartB = (size_t)(K / P.split) * 2;
    Order S; S.init(P.pad0 ? P.pad1 : MP / BM, P.totN, G, c);
    unsigned voffA[2], voffB[2];
#pragma unroll
    for (int i = 0; i < 2; ++i) { int R, C; stage_rc(tid * 16 + i * 8192, R, C); const int Rb = (R & ~31) + perm32(R & 31);
        voffA[i] = (unsigned)(R * lda + C) * 2u; voffB[i] = (unsigned)(Rb * K + C) * 2u; }
    const size_t kstep = (size_t)(BK * 2);
    const size_t hstepA = (size_t)HALF * lda * 2, hstepB = (size_t)HALF * K * 2;
    const size_t tstepA = 2 * hstepA, tstepB = 2 * hstepB;
    const unsigned ldsw = (unsigned)wid * 1024u;
    const int aoff = lds_byte(wr * 64 + fr, fq * 8), boff = lds_byte(wc * 32 + fr, fq * 8);
#define PG8_SA(b, h) (((b) * 2 + (h)) * HTB)
#define PG8_SB(b, h) ((4 + (b) * 2 + (h)) * HTB)
#define PG8_STAGE(bufoff, gbase, voff) do { _Pragma("unroll") for (int _i = 0; _i < 2; ++_i) \
        __builtin_amdgcn_global_load_lds((const unsigned*)((const char*)(gbase) + (voff)[_i]), (LAS unsigned*)(lds + (bufoff) + ldsw + _i * 8192), 16, 0, 0); } while (0)
#define PG8_LDA(dst, b, h) do { _Pragma("unroll") for (int m = 0; m < 4; ++m) _Pragma("unroll") for (int k = 0; k < 2; ++k) dst[m][k] = *(const LAS bf16x8*)(lds + PG8_SA(b, h) + aoff + m * 2048 + k * 1024); } while (0)
#define PG8_LDB(dst, b, h) do { _Pragma("unroll") for (int n = 0; n < 2; ++n) _Pragma("unroll") for (int k = 0; k < 2; ++k) dst[n][k] = *(const LAS bf16x8*)(lds + PG8_SB(b, h) + boff + n * 2048 + k * 1024); } while (0)
#define PG8_MMA(ai, bj, At, Bt) do { __builtin_amdgcn_s_setprio(1); _Pragma("unroll") for (int m = 0; m < 4; ++m) _Pragma("unroll") for (int n = 0; n < 2; ++n) _Pragma("unroll") for (int k = 0; k < 2; ++k) \
        acc[ai][bj][m][n] = __builtin_amdgcn_mfma_f32_16x16x32_bf16(Bt[n][k], At[m][k], acc[ai][bj][m][n], 0, 0, 0); __builtin_amdgcn_s_setprio(0); } while (0)
#define PG8_WAIT_V(n) asm volatile("s_waitcnt vmcnt(" #n ")" ::: "memory")
#define PG8_WAIT_L(n) asm volatile("s_waitcnt lgkmcnt(" #n ")" ::: "memory")
#define PG8_BAR __builtin_amdgcn_s_barrier()
#define PG8_SCHED __builtin_amdgcn_sched_barrier(0)
    Unit cur, nxt; int ui = 0;
    if (!S.next(P, 0, cur)) return;
    if (WAITA) wait_panel(cur.pm, prog, wid, lane);
    f32x4 acc[2][2][4][2];
#pragma unroll
    for (int a = 0; a < 2; ++a)
#pragma unroll
        for (int b = 0; b < 2; ++b)
#pragma unroll
            for (int m = 0; m < 4; ++m)
#pragma unroll
                for (int n = 0; n < 2; ++n) acc[a][b][m][n] = (f32x4){0.f, 0.f, 0.f, 0.f};
    bf16x8 At[4][2], B0[2][2], B1[2][2];
    const char* cA = (const char*)ws + P.job[cur.job].A + (size_t)cur.pm * tstepA + cur.kpart * kpartB; const char* cB = (const char*)ws + P.job[cur.job].B + (size_t)cur.pn * tstepB + cur.kpart * kpartB;
    PG8_STAGE(PG8_SB(0, 0), cB, voffB); PG8_STAGE(PG8_SB(0, 1), cB + hstepB, voffB); PG8_STAGE(PG8_SA(0, 0), cA, voffA); PG8_STAGE(PG8_SA(0, 1), cA + hstepA, voffA);
    if (wr == 1) PG8_BAR;
    PG8_WAIT_V(2); PG8_BAR;
    PG8_STAGE(PG8_SB(1, 0), cB + kstep, voffB); PG8_STAGE(PG8_SA(1, 0), cA + kstep, voffA); PG8_STAGE(PG8_SB(1, 1), cB + hstepB + kstep, voffB);
    PG8_WAIT_V(6); PG8_BAR;
    for (;;) {
        const bool has_next = S.next(P, ui + 1, nxt);
        if (WAITA && has_next) wait_panel(nxt.pm, prog, wid, lane);
        const char* nA = has_next ? (const char*)ws + P.job[nxt.job].A + (size_t)nxt.pm * tstepA + nxt.kpart * kpartB : cA; const char* nB = has_next ? (const char*)ws + P.job[nxt.job].B + (size_t)nxt.pn * tstepB + nxt.kpart * kpartB : cB;
        const int ntc = nt / cur.split;
        for (int t = 0; t < ntc; t += 2) {
            const bool last = (t == ntc - 2);
            const char* a1 = cA + (size_t)(t + 1) * kstep;
            const char* a2 = last ? nA : cA + (size_t)(t + 2) * kstep; const char* b2 = last ? nB : cB + (size_t)(t + 2) * kstep;
            const char* a3 = a2 + kstep; const char* b3 = b2 + kstep;
            PG8_LDB(B0, 0, 0); PG8_LDB(B1, 0, 1); PG8_SCHED; PG8_LDA(At, 0, 0); PG8_STAGE(PG8_SA(1, 1), a1 + hstepA, voffA);
            PG8_WAIT_V(8); PG8_WAIT_L(0); PG8_BAR; PG8_MMA(0, 0, At, B0); PG8_MMA(0, 1, At, B1); PG8_BAR; PG8_SCHED;
            PG8_LDA(At, 0, 1); PG8_STAGE(PG8_SB(0, 0), b2, voffB); PG8_STAGE(PG8_SB(0, 1), b2 + hstepB, voffB); PG8_STAGE(PG8_SA(0, 0), a2, voffA);
            PG8_WAIT_V(8); PG8_WAIT_L(0); PG8_BAR; PG8_MMA(1, 0, At, B0); PG8_MMA(1, 1, At, B1); PG8_BAR; PG8_SCHED;
            PG8_LDB(B0, 1, 0); PG8_LDB(B1, 1, 1); PG8_SCHED; PG8_LDA(At, 1, 0); PG8_STAGE(PG8_SA(0, 1), a2 + hstepA, voffA);
            PG8_WAIT_V(8); PG8_WAIT_L(0); PG8_BAR; PG8_MMA(0, 0, At, B0); PG8_MMA(0, 1, At, B1); PG8_BAR; PG8_SCHED;
            PG8_LDA(At, 1, 1); PG8_STAGE(PG8_SB(1, 0), b3, voffB); PG8_STAGE(PG8_SB(1, 1), b3 + hstepB, voffB); PG8_STAGE(PG8_SA(1, 0), a3, voffA);
            PG8_WAIT_V(8); PG8_WAIT_L(0); PG8_BAR; PG8_MMA(1, 0, At, B0); PG8_MMA(1, 1, At, B1); PG8_BAR; PG8_SCHED;
        }
        if (wr == 0) PG8_BAR;
        if (cur.split > 1) {
            {
                asm volatile("s_nop 15\n\ts_nop 7" ::: "memory");
                f32x4* sp_ = (f32x4*)(ws + WS_SLAB) + (size_t)(cur.tail * cur.split + cur.kpart) * (32 * NTHREADS) + tid;
#pragma unroll
                for (int a = 0; a < 2; ++a)
#pragma unroll
                    for (int b = 0; b < 2; ++b)
#pragma unroll
                        for (int m = 0; m < 4; ++m)
#pragma unroll
                            for (int n = 0; n < 2; ++n) { asm volatile("global_store_dwordx4 %0, %1, off sc1\n\ts_nop 1" :: "v"(sp_), "v"(acc[a][b][m][n]) : "memory"); sp_ += NTHREADS; asm volatile("" : "+v"(sp_)); }
            }
            asm volatile("s_waitcnt vmcnt(0)" ::: "memory");
            PG8_BAR;
            if (tid == 0) {
                __hip_atomic_fetch_add(cntw + cur.tail, 1u, __ATOMIC_RELAXED, __HIP_MEMORY_SCOPE_AGENT);
                unsigned spins = 0;
                while (__hip_atomic_load(cntw + cur.tail, __ATOMIC_RELAXED, __HIP_MEMORY_SCOPE_AGENT) < (unsigned)cur.split && ++spins < (1u << 22)) __builtin_amdgcn_s_sleep(1);
                __builtin_amdgcn_fence(__ATOMIC_ACQUIRE, "agent"); asm volatile("s_waitcnt vmcnt(0)" ::: "memory");
            }
            asm volatile("" ::: "memory"); PG8_BAR; asm volatile("" ::: "memory");
            {
                const int nreg = 32 / cur.split, i0 = cur.kpart * nreg;
                f32x4 red[16];
#pragma unroll
                for (int r = 0; r < 16; ++r) red[r] = (f32x4){0.f, 0.f, 0.f, 0.f};
                for (int p = 0; p < cur.split; ++p) {
                    const f32x4* sl = (const f32x4*)(ws + WS_SLAB) + (size_t)(cur.tail * cur.split + p) * (32 * NTHREADS) + (size_t)i0 * NTHREADS + tid;
#pragma unroll
                    for (int r = 0; r < 16; ++r) { if (r < nreg) red[r] += *sl; sl += NTHREADS; }
                    asm volatile("" : "+v"(sl));
                }
                const int mode = P.job[cur.job].mode, ldc = P.job[cur.job].ldc;
                char* outp = (char*)ws + P.job[cur.job].out; const void* aux = (const void*)(ws + P.job[cur.job].aux);
                const int row0 = cur.pm * BM + wr * 64 + fr, col0 = cur.pn * BM + wc * 32 + 8 * fq;
#pragma unroll
                for (int pr = 0; pr < 8; ++pr) if (2 * pr < nreg) {
                    const int g = (i0 >> 1) + pr, ai = g >> 3, bj = (g >> 2) & 1, m = g & 3;
                    const int row = row0 + ai * HALF + m * 16, col = col0 + bj * HALF;
                    if ((MM & (1u << EM_RESID)) && mode == EM_RESID) epi_frag<EM_RESID>(red[2 * pr], red[2 * pr + 1], outp, aux, ldc, row, col);
                    else epi_frag<EM_BF16>(red[2 * pr], red[2 * pr + 1], outp, aux, ldc, row, col);
                }
            }
            PG8_BAR;
        } else
        epilogue<MM>(acc, cur, P, ws, w0p, a0p, wr, wc, fr, fq);
        if (!has_next) break;
#pragma unroll
        for (int a = 0; a < 2; ++a)
#pragma unroll
            for (int b = 0; b < 2; ++b)
#pragma unroll
                for (int m = 0; m < 4; ++m)
#pragma unroll
                    for (int n = 0; n < 2; ++n) acc[a][b][m][n] = (f32x4){0.f, 0.f, 0.f, 0.f};
        cur = nxt; cA = nA; cB = nB; ++ui;
        if (wr == 1) PG8_BAR;
    }
    PG8_WAIT_V(0);
    PG8_BAR;
#undef PG8_SA
#undef PG8_SB
#undef PG8_STAGE
#undef PG8_LDA
#undef PG8_LDB
#undef PG8_MMA
#undef PG8_WAIT_V
#undef PG8_WAIT_L
#undef PG8_BAR
#undef PG8_SCHED
}
}


#define JOB(A, B, O, AUX, NN, LDC, MODE) {(unsigned)(A), (unsigned)(B), (unsigned)(O), (unsigned)(AUX), (NN), (LDC), (MODE), 0}
#define NOJOB {0u, 0u, 0u, 0u, 1 << 30, 0, 0, 0}
constexpr size_t LO1S = (size_t)MP * 256 * 2;
__constant__ pg8::PhaseC c_ph[8] = {
      {1, D, D, NZ / 256, 2, 0, 0, 0, {JOB(WS_X0, WS_WIN, WS_ZIN, 0, NZ / 256, NZ, pg8::EM_BF16), NOJOB, NOJOB, NOJOB, NOJOB, NOJOB}},
      {1, D, D, D / 256, 4, 0, 0, 0, {JOB(WS_CAT, WS_WOUT, WS_ZRES, WS_X0, D / 256, D, pg8::EM_RESID), NOJOB, NOJOB, NOJOB, NOJOB, NOJOB}},
      {1, D, D, DFF / 256, 1, 0, 0, 0, {JOB(WS_HA, WS_WUP, WS_U, 0, DFF / 256, DFF, pg8::EM_RELU2), NOJOB, NOJOB, NOJOB, NOJOB, NOJOB}},
      {1, DFF, DFF, D / 256, 4, 0, 0, 0, {JOB(WS_U, WS_WDN, WS_ZRES, WS_HA, D / 256, D, pg8::EM_RESID), NOJOB, NOJOB, NOJOB, NOJOB, NOJOB}},
      {6, D, D, 27, 1, 0, 0, 0, {JOB(WS_XS + 0 * U37, WS_WR, WS_RKV + 0 * U37, 0, 8, D, pg8::EM_BF16), JOB(WS_XS + 2 * U37, WS_WK, WS_RKV + 1 * U37, 0, 8, D, pg8::EM_BF16),
                                    JOB(WS_XS + 3 * U37, WS_WV, WS_RKV + 2 * U37, 0, 8, D, pg8::EM_BF16), JOB(WS_XS + 1 * U37, WS_L1, WS_LO1, 0, 1, 256, pg8::EM_TANH),
                                    JOB(WS_XS + 4 * U37, WS_L1 + 1 * MiB, WS_LO1 + LO1S, 0, 1, 256, pg8::EM_BF16), JOB(WS_XS + 5 * U37, WS_L1 + 2 * MiB, WS_LO1 + 2 * LO1S, 0, 1, 256, pg8::EM_SIGM)}},
      {3, 256, 256, 24, 1, 0, 0, 0, {JOB(WS_LO1, WS_L2, WS_WDEC, 0, 8, D, pg8::EM_WDEC), JOB(WS_LO1 + LO1S, WS_L2 + 1 * MiB, WS_AG, 0, 8, D, pg8::EM_ASIG),
                                      JOB(WS_LO1 + 2 * LO1S, WS_L2 + 2 * MiB, WS_GG, 0, 8, D, pg8::EM_BF16), NOJOB, NOJOB, NOJOB}},
      {1, D, D, D / 256, 1, 2, pg8::N_LATE, 0, {JOB(WS_YCAT, WS_WO, WS_ZRES, WS_HB, D / 256, D, pg8::EM_RESID), NOJOB, NOJOB, NOJOB, NOJOB, NOJOB}},
      {1, D, D, D / 256, 1, 1, pg8::N_EARLY, 0, {JOB(WS_YCAT, WS_WO, WS_ZRES, WS_HB, D / 256, D, pg8::EM_RESID), NOJOB, NOJOB, NOJOB, NOJOB, NOJOB}},
};
static_assert(WS_END < (1ull << 32), "ws offsets fit 32 bits");

constexpr int RING_BYTES = 158720;
constexpr int LDSCTL_OFF = RING_BYTES, MISC_OFF = LDSCTL_OFF + 64;
constexpr int LDS_BYTES = RING_BYTES + 512;

struct Args { const float* in[N_IN]; float* out; unsigned char* ws; int ph_lo, ph_hi; };
struct Frame {
    LAS unsigned char* lds;
    float* out; unsigned char* ws;
    int tid, lane, wave, G, gw, NGW;
};

__device__ __forceinline__ void transpose_item(const float* W, int ldw, int klim, int nsrc0, bf16_t* WT, int ldwt, int ndst0, float scale, LAS float* scr, int kb, int nb, int lane) {
    const int k0 = 64 * kb, n0 = 32 * nb;
#pragma unroll 8
    for (int i = 0; i < 32; ++i) { const int kk = 2 * i + (lane >> 5); const int k = k0 + kk;
        scr[kk * 33 + (lane & 31)] = (k < klim) ? W[(size_t)k * ldw + nsrc0 + n0 + (lane & 31)] * scale : 0.f; }
    LDS_WAIT(); asm volatile("" ::: "memory");
    const int c = lane & 7;
#pragma unroll
    for (int j = 0; j < 4; ++j) { const int n = (lane >> 3) + 8 * j; const LAS float* s = scr + (8 * c) * 33 + n;
        u32x4 o; o.x = pk2(s[0 * 33], s[1 * 33]); o.y = pk2(s[2 * 33], s[3 * 33]); o.z = pk2(s[4 * 33], s[5 * 33]); o.w = pk2(s[6 * 33], s[7 * 33]);
        *(GAS u32x4*)(WT + (size_t)(ndst0 + n0 + n) * ldwt + k0 + 8 * c) = o; }
    LDS_WAIT(); asm volatile("" ::: "memory");
}
__device__ __forceinline__ void transpose_item64(const float* W, int ldw, int nsrc0, bf16_t* WT, int ldwt, int ndst0, float scale, LAS float* scr, int kb, int nb, int lane) {
    const int k0 = 64 * kb, n0 = 64 * nb;
    f32x4 v[16];
#pragma unroll
    for (int i = 0; i < 16; ++i) { const int kk = 4 * i + (lane >> 4); v[i] = *(const GAS f32x4*)(W + (size_t)(k0 + kk) * ldw + nsrc0 + n0 + 4 * (lane & 15)); }
#pragma unroll
    for (int i = 0; i < 16; ++i) { const int kk = 4 * i + (lane >> 4); LAS float* d = scr + kk * 65 + 4 * (lane & 15); d[0] = v[i][0] * scale; d[1] = v[i][1] * scale; d[2] = v[i][2] * scale; d[3] = v[i][3] * scale; }
    LDS_WAIT(); asm volatile("" ::: "memory");
    const int c = lane & 7;
#pragma unroll
    for (int j = 0; j < 8; ++j) { const int n = (lane >> 3) + 8 * j; const LAS float* sp = scr + (8 * c) * 65 + n;
        u32x4 o; o.x = pk2(sp[0 * 65], sp[1 * 65]); o.y = pk2(sp[2 * 65], sp[3 * 65]); o.z = pk2(sp[4 * 65], sp[5 * 65]); o.w = pk2(sp[6 * 65], sp[7 * 65]);
        *(GAS u32x4*)(WT + (size_t)(ndst0 + n0 + n) * ldwt + k0 + 8 * c) = o; }
    LDS_WAIT(); asm volatile("" ::: "memory");
}
__device__ __forceinline__ void convert_matrix64(Frame& F, int& cursor, const float* W, int ldw, int K, int nsrc0, int N, bf16_t* WT, int ldwt, int ndst0, float scale, LAS float* scr) {
    const int nblk = N / 64, kblk = K / 64, items = nblk * kblk;
    int first = (F.gw - cursor % F.NGW + F.NGW) % F.NGW;
    for (int it = first; it < items; it += F.NGW) transpose_item64(W, ldw, nsrc0, WT, ldwt, ndst0, scale, scr, it / nblk, it % nblk, F.lane);
    cursor += items;
}
__device__ __forceinline__ void convert_matrix(Frame& F, int& cursor, const float* W, int ldw, int Ksrc, int Kdst, int nsrc0, int N, bf16_t* WT, int ldwt, int ndst0, float scale, LAS float* scr) {
    const int nblk = N / 32, kblk = Kdst / 64, items = nblk * kblk;
    int first = (F.gw - cursor % F.NGW + F.NGW) % F.NGW;
    for (int it = first; it < items; it += F.NGW) transpose_item(W, ldw, Ksrc, nsrc0, WT, ldwt, ndst0, scale, scr, it / nblk, it % nblk, F.lane);
    cursor += items;
}
__device__ __forceinline__ void convert_wup(Frame& F, const Args& args, int layer, int& cursor, LAS float* scr) {
    convert_matrix64(F, cursor, args.in[I_WUP] + (size_t)layer * D * DFF, DFF, D, 0, DFF, (bf16_t*)(F.ws + WS_WUP), D, 0, 1.f, scr);
}
__device__ __forceinline__ void convert_wdn(Frame& F, const Args& args, int layer, int& cursor, LAS float* scr) {
    convert_matrix64(F, cursor, args.in[I_WDN] + (size_t)layer * DFF * D, D, DFF, 0, D, (bf16_t*)(F.ws + WS_WDN), DFF, 0, 1.f, scr);
}
__device__ __forceinline__ void convert_mlp_weights(Frame& F, const Args& args, int layer, int& cursor, LAS float* scr) {
    convert_wup(F, args, layer, cursor, scr); convert_wdn(F, args, layer, cursor, scr);
}
__device__ __forceinline__ void p0_prologue(Frame& F, const Args& args) {
    LAS float* scr = (LAS float*)(F.lds + F.wave * 16896);
    int cursor = 0;
    const float* win = args.in[I_WIN];
    convert_matrix64(F, cursor, win, PROJ, D, 0, 1024, (bf16_t*)(F.ws + WS_WIN), D, 0, 1.f, scr);
    convert_matrix64(F, cursor, win, PROJ, D, 1024, 1024, (bf16_t*)(F.ws + WS_WIN), D, 1024, 0.0625f, scr);
    convert_matrix64(F, cursor, win, PROJ, D, 2048, 2048, (bf16_t*)(F.ws + WS_WIN), D, 2048, 1.f, scr);
    convert_matrix64(F, cursor, win, PROJ, D, 4104, 2048, (bf16_t*)(F.ws + WS_WIN), D, 4096, 1.f, scr);
    convert_matrix64(F, cursor, args.in[I_WOUT], D, D, 0, D, (bf16_t*)(F.ws + WS_WOUT), D, 0, 1.f, scr);
}
__device__ __forceinline__ void convert_rwkv_weights(Frame& F, const Args& args, LAS float* scr) {
    int cursor = 0;
    convert_matrix64(F, cursor, args.in[I_WR], D, D, 0, D, (bf16_t*)(F.ws + WS_WR), D, 0, 1.f, scr);
    convert_matrix64(F, cursor, args.in[I_WK], D, D, 0, D, (bf16_t*)(F.ws + WS_WK), D, 0, 1.f, scr);
    convert_matrix64(F, cursor, args.in[I_WV], D, D, 0, D, (bf16_t*)(F.ws + WS_WV), D, 0, 1.f, scr);
    convert_matrix64(F, cursor, args.in[I_WO], D, D, 0, D, (bf16_t*)(F.ws + WS_WO), D, 0, 1.f, scr);
    convert_matrix(F, cursor, args.in[I_W1], 96, D, D, 0, 96, (bf16_t*)(F.ws + WS_L1), D, 0, 1.f, scr);
    convert_matrix(F, cursor, args.in[I_A1], 96, D, D, 0, 96, (bf16_t*)(F.ws + WS_L1 + 1 * MiB), D, 0, 1.f, scr);
    convert_matrix(F, cursor, args.in[I_G1], 256, D, D, 0, 256, (bf16_t*)(F.ws + WS_L1 + 2 * MiB), D, 0, 1.f, scr);
    convert_matrix(F, cursor, args.in[I_W2], D, 96, 256, 0, D, (bf16_t*)(F.ws + WS_L2), 256, 0, 1.f, scr);
    convert_matrix(F, cursor, args.in[I_A2], D, 96, 256, 0, D, (bf16_t*)(F.ws + WS_L2 + 1 * MiB), 256, 0, 1.f, scr);
    convert_matrix(F, cursor, args.in[I_G2], D, 256, 256, 0, D, (bf16_t*)(F.ws + WS_L2 + 2 * MiB), 256, 0, 1.f, scr);
    for (int p = F.gw * 64 + F.lane; p < 2 * 40960; p += F.NGW * 64) { const int mtx = p / 40960, q = p % 40960;
        *(GAS u32x4*)(F.ws + WS_L1 + (size_t)mtx * MiB + (size_t)96 * D * 2 + (size_t)q * 16) = (u32x4){0u, 0u, 0u, 0u}; }
}
__device__ __forceinline__ int balanced_row(const Frame& F, int it) {
    const int full = (M / F.NGW) * F.NGW;
    if ((it + 1) * F.NGW <= full) return it * F.NGW + F.gw;
    if (it * F.NGW != full) return M;
    const int r2 = F.wave * F.G + F.gw / NWAVES;
    return (full + r2 < M) ? full + r2 : M;
}
__device__ __forceinline__ void p0_rows(Frame& F, const Args& args) {
    LAS f32x4* Glo = (LAS f32x4*)(F.lds); LAS f32x4* Ghi = (LAS f32x4*)(F.lds + 32768);
    const float* win = args.in[I_WIN];
    for (int k = F.tid; k < D; k += NTHREADS) { const f32x4 a = *(const f32x4*)(win + (size_t)k * PROJ + 4096), b = *(const f32x4*)(win + (size_t)k * PROJ + 4100);
        const int l = (k & 255) >> 2, c = k & 3, j = k >> 8, p = (4 * j + c) * 64 + l; Glo[p] = a; Ghi[p] = b; }
    __syncthreads();
    const float* bif = args.in[I_BIF];
    for (int it_ = 0, row = F.gw; row < M; ++it_, row = balanced_row(F, it_)) {
        const float* src;
        if (row < MPR) { const int b = row / TP, t = row % TP; src = (t < NMETA) ? args.in[I_META] + (size_t)t * D : args.in[I_XP] + ((size_t)b * SEQ + (t - NMETA)) * D; }
        else src = args.in[I_XS] + (size_t)(row - MPR) * D;
        f32x4 v[8]; float g[8];
#pragma unroll
        for (int j = 0; j < 8; ++j) v[j] = *(const GAS f32x4*)(src + 4 * F.lane + 256 * j);
#pragma unroll
        for (int q = 0; q < 8; ++q) g[q] = 0.f;
        GAS u32x2* o8 = (GAS u32x2*)(F.ws + WS_X0 + (size_t)row * D * 2) + F.lane;
#pragma unroll
        for (int j = 0; j < 8; ++j) {
            o8[64 * j] = (u32x2){pk2(v[j][0], v[j][1]), pk2(v[j][2], v[j][3])};
#pragma unroll
            for (int c = 0; c < 4; ++c) { const int p = (4 * j + c) * 64 + F.lane; const f32x4 a = Glo[p], b = Ghi[p]; const float x = v[j][c];
                g[0] += x * a[0]; g[1] += x * a[1]; g[2] += x * a[2]; g[3] += x * a[3]; g[4] += x * b[0]; g[5] += x * b[1]; g[6] += x * b[2]; g[7] += x * b[3]; }
            asm volatile("" ::: "memory");
        }
#pragma unroll
        for (int q = 0; q < 8; ++q) g[q] = wave_sum(g[q]);
        if (F.lane == 0) { float* go = (float*)(F.ws + WS_GATES) + (size_t)row * 8;
#pragma unroll
            for (int q = 0; q < 8; ++q) go[q] = g[q] + bif[q]; }
    }
}


__device__ __forceinline__ void unpack8(const u32x4 w, float (&x)[8]) { x[0] = bflo(w.x); x[1] = bfhi(w.x); x[2] = bflo(w.y); x[3] = bfhi(w.y); x[4] = bflo(w.z); x[5] = bfhi(w.z); x[6] = bflo(w.w); x[7] = bfhi(w.w); }
__device__ __forceinline__ u32x4 pack8(const float (&x)[8]) { u32x4 w; w.x = pk2(x[0], x[1]); w.y = pk2(x[2], x[3]); w.z = pk2(x[4], x[5]); w.w = pk2(x[6], x[7]); return w; }
__device__ __forceinline__ void ln_row_load_norm(const bf16_t* zrow, int lane, float (&x)[4][8]) {
    float s = 0.f;
#pragma unroll
    for (int j = 0; j < 4; ++j) { const u32x4 w = *(const GAS u32x4*)(zrow + 8 * lane + 512 * j); unpack8(w, x[j]);
#pragma unroll
        for (int e = 0; e < 8; ++e) s += x[j][e]; }
    const float mean = wave_sum(s) * (1.f / D); float s2 = 0.f;
#pragma unroll
    for (int j = 0; j < 4; ++j)
#pragma unroll
        for (int e = 0; e < 8; ++e) { x[j][e] -= mean; s2 += x[j][e] * x[j][e]; }
    const float rstd = 1.0f / sqrtf(wave_sum(s2) * (1.f / D) + LN_EPS);
#pragma unroll
    for (int j = 0; j < 4; ++j)
#pragma unroll
        for (int e = 0; e < 8; ++e) x[j][e] *= rstd;
}
__device__ __forceinline__ void stage_lds(LAS float* dst, const float* src, int n, int tid) {
    for (int i = tid * 4; i < n; i += NTHREADS * 4) *(LAS f32x4*)(dst + i) = *(const GAS f32x4*)(src + i);
}
__device__ __forceinline__ void ln_affine(const LAS float* gl, int lane, float (&x)[4][8]) {
#pragma unroll
    for (int j = 0; j < 4; ++j) { const int c = 8 * lane + 512 * j; const f32x4 g0 = *(const LAS f32x4*)(gl + c), g1 = *(const LAS f32x4*)(gl + c + 4), b0 = *(const LAS f32x4*)(gl + D + c), b1 = *(const LAS f32x4*)(gl + D + c + 4);
#pragma unroll
        for (int e = 0; e < 4; ++e) { x[j][e] = x[j][e] * g0[e] + b0[e]; x[j][4 + e] = x[j][4 + e] * g1[e] + b1[e]; } }
}
__device__ __forceinline__ void ln_pass(Frame& F, const bf16_t* z, const float* g, const float* b, bf16_t* out) {
    LAS float* gl = (LAS float*)F.lds; stage_lds(gl, g, D, F.tid); stage_lds(gl + D, b, D, F.tid); __syncthreads();
    for (int it_ = 0, row = F.gw; row < M; ++it_, row = balanced_row(F, it_)) {
        float x[4][8]; ln_row_load_norm(z + (size_t)row * D, F.lane, x); ln_affine(gl, F.lane, x);
#pragma unroll
        for (int j = 0; j < 4; ++j) *(GAS u32x4*)(out + (size_t)row * D + 8 * F.lane + 512 * j) = pack8(x[j]);
    }
}
__device__ __forceinline__ void ln_final(Frame& F, const bf16_t* z, const float* g, const float* b) {
    LAS float* gl = (LAS float*)F.lds; stage_lds(gl, g, D, F.tid); stage_lds(gl + D, b, D, F.tid); __syncthreads();
    for (int it_ = 0, row = F.gw; row < M; ++it_, row = balanced_row(F, it_)) {
        float* dst;
        if (row < MPR) { const int bb = row / TP, t = row % TP; if (t < NMETA) continue; dst = F.out + O_YP + ((size_t)bb * SEQ + (t - NMETA)) * D; }
        else dst = F.out + O_YS + (size_t)(row - MPR) * D;
        const bf16_t* zrow = z + (size_t)row * D;
        float x[8][4]; float s = 0.f;
#pragma unroll
        for (int j = 0; j < 8; ++j) { const u32x2 w = *(const GAS u32x2*)(zrow + 4 * F.lane + 256 * j); x[j][0] = bflo(w.x); x[j][1] = bfhi(w.x); x[j][2] = bflo(w.y); x[j][3] = bfhi(w.y);
            s += (x[j][0] + x[j][1]) + (x[j][2] + x[j][3]); }
        const float mean = wave_sum(s) * (1.f / D); float s2 = 0.f;
#pragma unroll
        for (int j = 0; j < 8; ++j)
#pragma unroll
            for (int e = 0; e < 4; ++e) { x[j][e] -= mean; s2 += x[j][e] * x[j][e]; }
        const float rstd = 1.0f / sqrtf(wave_sum(s2) * (1.f / D) + LN_EPS);
#pragma unroll
        for (int j = 0; j < 8; ++j) { const int c = 4 * F.lane + 256 * j; const f32x4 g0 = *(const LAS f32x4*)(gl + c), b0 = *(const LAS f32x4*)(gl + D + c);
            f32x4 o;
#pragma unroll
            for (int e = 0; e < 4; ++e) o[e] = x[j][e] * rstd * g0[e] + b0[e];
            *(GAS f32x4*)(dst + c) = o; }
    }
}
__device__ __forceinline__ void ln_mix_pass(Frame& F, const Args& args, const bf16_t* z, const float* g, const float* b) {
    LAS float* gl = (LAS float*)F.lds; LAS float* mul = gl + 2 * D;
    stage_lds(gl, g, D, F.tid); stage_lds(gl + D, b, D, F.tid); stage_lds(mul, args.in[I_MU], 6 * D, F.tid); __syncthreads();
    const int body = (4 * F.NGW < M) ? 4 * F.NGW : M, vcu_ = F.gw / NWAVES;
#pragma unroll 1
    for (int k = 0; k < 2; ++k) {
        int row0, nr;
        if (k == 0) { row0 = 4 * F.gw; nr = 4; if (row0 >= body) continue; }
        else { const int r2 = F.wave * F.G + vcu_; if (body + r2 >= M) break; row0 = body + r2; nr = 1; }
        int t0, T; const float* xlast = nullptr; float* shift_out;
        if (row0 < MPR) { const int bb = row0 / TP; t0 = row0 % TP; T = TP; shift_out = F.out + O_PX + (size_t)bb * D; }
        else { const int r = row0 - MPR; const int bb = r / DS; t0 = r % DS; T = DS; xlast = args.in[I_RX] + (size_t)bb * D; shift_out = F.out + O_SX + (size_t)bb * D; }
        float prev[4][8], cur[4][8];
        if (t0 == 0) {
#pragma unroll
            for (int j = 0; j < 4; ++j)
#pragma unroll
                for (int e = 0; e < 8; ++e) prev[j][e] = 0.f;
            if (xlast) {
#pragma unroll
                for (int j = 0; j < 4; ++j) { const f32x4 a = *(const GAS f32x4*)(xlast + 8 * F.lane + 512 * j), c = *(const GAS f32x4*)(xlast + 8 * F.lane + 512 * j + 4);
#pragma unroll
                    for (int e = 0; e < 4; ++e) { prev[j][e] = a[e]; prev[j][4 + e] = c[e]; } }
            }
        } else { ln_row_load_norm(z + (size_t)(row0 - 1) * D, F.lane, prev); ln_affine(gl, F.lane, prev); }
#pragma unroll 1
        for (int r = 0; r < nr; ++r) {
            const int row = row0 + r;
            ln_row_load_norm(z + (size_t)row * D, F.lane, cur); ln_affine(gl, F.lane, cur);
#pragma unroll
            for (int j = 0; j < 4; ++j) *(GAS u32x4*)((bf16_t*)(F.ws + WS_HB) + (size_t)row * D + 8 * F.lane + 512 * j) = pack8(cur[j]);
            if (t0 + r == T - 1) {
#pragma unroll
                for (int j = 0; j < 4; ++j) { GAS f32x4* o = (GAS f32x4*)(shift_out + 8 * F.lane + 512 * j); o[0] = (f32x4){cur[j][0], cur[j][1], cur[j][2], cur[j][3]}; o[1] = (f32x4){cur[j][4], cur[j][5], cur[j][6], cur[j][7]}; }
            }
#pragma unroll 1
            for (int mx = 0; mx < 6; ++mx) {
                bf16_t* dst = (bf16_t*)(F.ws + WS_XS + (size_t)mx * U37) + (size_t)row * D;
#pragma unroll
                for (int j = 0; j < 4; ++j) { const int c = 8 * F.lane + 512 * j; const f32x4 m0 = *(const LAS f32x4*)(mul + mx * D + c), m1 = *(const LAS f32x4*)(mul + mx * D + c + 4);
                    float o[8];
#pragma unroll
                    for (int e = 0; e < 4; ++e) { o[e] = cur[j][e] + (prev[j][e] - cur[j][e]) * m0[e]; o[4 + e] = cur[j][4 + e] + (prev[j][4 + e] - cur[j][4 + e]) * m1[e]; }
                    *(GAS u32x4*)(dst + c) = pack8(o); asm volatile("" ::: "memory"); }
            }
#pragma unroll
            for (int j = 0; j < 4; ++j)
#pragma unroll
                for (int e = 0; e < 8; ++e) prev[j][e] = cur[j][e];
        }
    }
}
__device__ __forceinline__ void headnorm_pass(Frame& F, const Args& args) {
    const float* ng = args.in[I_MNG];
    const bf16_t* hm = (const bf16_t*)(F.ws + WS_HM); const bf16_t* zin = (const bf16_t*)(F.ws + WS_ZIN); bf16_t* cat = (bf16_t*)(F.ws + WS_CAT);
    for (int it_ = 0, row = F.gw; row < M; ++it_, row = balanced_row(F, it_)) {
        const int c = 16 * F.lane;
        float x[16], o[16];
        { const u32x4 w0 = *(const GAS u32x4*)(hm + (size_t)row * MIXA + c), w1 = *(const GAS u32x4*)(hm + (size_t)row * MIXA + c + 8);
          float a[8], bq[8]; unpack8(w0, a); unpack8(w1, bq);
#pragma unroll
          for (int e = 0; e < 8; ++e) { x[e] = a[e]; x[8 + e] = bq[e]; } }
        { const u32x4 w0 = *(const GAS u32x4*)(zin + (size_t)row * NZ + 3072 + c), w1 = *(const GAS u32x4*)(zin + (size_t)row * NZ + 3072 + c + 8);
          float a[8], bq[8]; unpack8(w0, a); unpack8(w1, bq);
#pragma unroll
          for (int e = 0; e < 8; ++e) { o[e] = a[e]; o[8 + e] = bq[e]; } }
        float s = 0.f;
#pragma unroll
        for (int e = 0; e < 16; ++e) s += x[e];
        s += __shfl_xor(s, 1); s += __shfl_xor(s, 2); s += __shfl_xor(s, 4); s += __shfl_xor(s, 8);
        const float mean = s * (1.f / 256.f); float s2 = 0.f;
#pragma unroll
        for (int e = 0; e < 16; ++e) { x[e] -= mean; s2 += x[e] * x[e]; }
        s2 += __shfl_xor(s2, 1); s2 += __shfl_xor(s2, 2); s2 += __shfl_xor(s2, 4); s2 += __shfl_xor(s2, 8);
        const float rstd = 1.0f / sqrtf(s2 * (1.f / 256.f) + LN_EPS);
        float y0[8], y1[8];
#pragma unroll
        for (int e = 0; e < 8; ++e) { y0[e] = x[e] * rstd * ng[c + e] * sigmoidf_(o[e]); y1[e] = x[8 + e] * rstd * ng[c + 8 + e] * sigmoidf_(o[8 + e]); }
        *(GAS u32x4*)(cat + (size_t)row * D + c) = pack8(y0); *(GAS u32x4*)(cat + (size_t)row * D + c + 8) = pack8(y1);
    }
}


namespace ml {
constexpr int NVR = 2, NVT = NVR + 1, SLW = 16 * NVR, NSL = HDA / SLW;
constexpr int QS = 144;
constexpr int CS = 272;
constexpr int LO_QH = 0, LO_KH = LO_QH + 128 * QS * 2, LO_VT = LO_KH + 128 * QS * 2, LO_VW = LO_VT + 16 * NVT * QS * 2, LO_CT = LO_VW + 16 * NVT * QS * 2,
              LO_GF = LO_CT + 16 * NVT * CS * 2, LO_GG = LO_GF + 512, LO_GM = LO_GG + 512, LO_SC = LO_GM + 512, GATE_BLK = 1600, LO_END = LO_GF + 2 * GATE_BLK;
constexpr int LO_PS = LO_QH;
static_assert(LO_END <= RING_BYTES, "mlstm lds");
__device__ __forceinline__ bf16x8 ldfrag(const LAS unsigned char* base, int row, int stride_el, int col) { return *(const LAS bf16x8*)(base + ((size_t)row * stride_el + col) * 2); }
__device__ __forceinline__ s16x4 trread(const LAS unsigned char* p) { typedef short v4i16_t __attribute__((ext_vector_type(4))); return __builtin_bit_cast(s16x4, __builtin_amdgcn_ds_read_tr16_b64_v4i16((LAS v4i16_t*)p)); }
}
__device__ __forceinline__ float log_sigmoidf_(float x) { return fminf(x, 0.f) - __logf(1.0f + __expf(-fabsf(x))); }
template <int CTRL> __device__ __forceinline__ float dpp_fill(float fill, float v) { return __builtin_bit_cast(float, __builtin_amdgcn_update_dpp(__builtin_bit_cast(int, fill), __builtin_bit_cast(int, v), CTRL, 0xf, 0xf, false)); }
__device__ __forceinline__ float wave_scan_sum(float v, int lane) {
    v += dpp_fill<0x111>(0.f, v); v += dpp_fill<0x112>(0.f, v); v += dpp_fill<0x114>(0.f, v); v += dpp_fill<0x118>(0.f, v);
    const int b = __builtin_bit_cast(int, v);
    const float t0 = __builtin_bit_cast(float, __builtin_amdgcn_readlane(b, 15)), t1 = __builtin_bit_cast(float, __builtin_amdgcn_readlane(b, 31)), t2 = __builtin_bit_cast(float, __builtin_amdgcn_readlane(b, 47));
    const int q = lane >> 4;
    return v + ((q >= 1 ? t0 : 0.f) + (q >= 2 ? t1 : 0.f) + (q >= 3 ? t2 : 0.f));
}
__device__ __forceinline__ float wave_scan_max(float v, int lane) {
    v = fmaxf(v, dpp_fill<0x111>(-3e38f, v)); v = fmaxf(v, dpp_fill<0x112>(-3e38f, v)); v = fmaxf(v, dpp_fill<0x114>(-3e38f, v)); v = fmaxf(v, dpp_fill<0x118>(-3e38f, v));
    const int b = __builtin_bit_cast(int, v);
    const float t0 = __builtin_bit_cast(float, __builtin_amdgcn_readlane(b, 15)), t1 = __builtin_bit_cast(float, __builtin_amdgcn_readlane(b, 31)), t2 = __builtin_bit_cast(float, __builtin_amdgcn_readlane(b, 47));
    const int q = lane >> 4;
    return fmaxf(v, fmaxf(fmaxf(q >= 1 ? t0 : -3e38f, q >= 2 ? t1 : -3e38f), q >= 3 ? t2 : -3e38f));
}
__device__ __forceinline__ void mlstm_prompt_job(Frame& F, const Args& args, int jid) {
    using namespace ml;
    const int b = jid / (NHA * NSL), h = (jid / NSL) % NHA, sl = jid % NSL;
    const int tid = F.tid, lane = F.lane, w = F.wave, q = lane >> 4, c = lane & 15;
    LAS unsigned char* L = F.lds;
    const bf16_t* zin = (const bf16_t*)(F.ws + WS_ZIN); const float* gates = (const float*)(F.ws + WS_GATES);
    bf16_t* hm = (bf16_t*)(F.ws + WS_HM);
    const int rb = b * TP;
    for (int i = tid; i < (LO_GF - LO_VT) / 4; i += NTHREADS) ((LAS unsigned*)(L + LO_VT))[i] = 0u;
    f32x4 st[2][NVT];
#pragma unroll
    for (int a = 0; a < 2; ++a)
#pragma unroll
        for (int v = 0; v < NVT; ++v) st[a][v] = (f32x4){0.f, 0.f, 0.f, 0.f};
    float m_run = 0.f;
    float gq_i0 = -1e30f, gq_i1 = -1e30f, gq_f0 = 1e30f, gq_f1 = 1e30f, m_gate = 0.f;
#define ML_GATES_LOAD(chn_) do { const int r0n_ = ((chn_) == 0) ? 0 : 16 + 128 * ((chn_) - 1), Lcn_ = ((chn_) == 0) ? 16 : 128; const size_t gr_ = (size_t)(rb + r0n_); \
        gq_i0 = -1e30f; gq_i1 = -1e30f; gq_f0 = 1e30f; gq_f1 = 1e30f; \
        if (2 * lane < Lcn_) { gq_i0 = gates[(gr_ + 2 * lane) * 8 + h]; gq_f0 = gates[(gr_ + 2 * lane) * 8 + 4 + h]; } \
        if (2 * lane + 1 < Lcn_) { gq_i1 = gates[(gr_ + 2 * lane + 1) * 8 + h]; gq_f1 = gates[(gr_ + 2 * lane + 1) * 8 + 4 + h]; } } while (0)
#define ML_GATES_MATH(buf_) do { LAS float* gF_ = (LAS float*)(L + LO_GF + (buf_) * GATE_BLK); LAS float* gG_ = gF_ + 128; LAS float* gM_ = gF_ + 256; LAS float* sc_ = gF_ + 384; \
        const int j0 = 2 * lane, j1 = 2 * lane + 1; \
        const float lf0 = log_sigmoidf_(gq_f0), lf1 = log_sigmoidf_(gq_f1);         \
        const float ps = wave_scan_sum(lf0 + lf1, lane); \
        const float ex = ps - (lf0 + lf1); \
        const float F0 = ex + lf0, F1 = F0 + lf1; \
        const float g0 = gq_i0 - F0, g1 = gq_i1 - F1; \
        const float pm = wave_scan_max(fmaxf(g0, g1), lane); \
        const float pme = dpp_fill<0x138>(-3e38f, pm);                                \
        const float pm0 = fmaxf(pme, g0), pm1 = fmaxf(pm0, g1); \
        const float M0 = fmaxf(m_gate, pm0), M1 = fmaxf(m_gate, pm1); \
        gF_[j0] = F0; gF_[j1] = F1; gG_[j0] = g0; gG_[j1] = g1; gM_[j0] = M0; gM_[j1] = M1; \
        if (lane == 63) { sc_[0] = m_gate; sc_[1] = M1; sc_[2] = __expf(m_gate - M1); sc_[3] = F1 + M1; } \
        m_gate = __builtin_bit_cast(float, __builtin_amdgcn_readlane(__builtin_bit_cast(int, F1 + M1), 63)); } while (0)
    if (w == 0) { ML_GATES_LOAD(0); ML_GATES_MATH(0); }
    __syncthreads();
    for (int ch = 0; ch < 17; ++ch) {
        const int r0 = (ch == 0) ? 0 : 16 + 128 * (ch - 1), Lc = (ch == 0) ? 16 : 128;
        const int grow = rb + r0;
        LAS float* gF = (LAS float*)(L + LO_GF + (ch & 1) * GATE_BLK); LAS float* gG = gF + 128; LAS float* gM = gF + 256; LAS float* sc = gF + 384;
        if (w == 0 && ch + 1 < 17) ML_GATES_LOAD(ch + 1);
        const float m_old = sc[0], Mlast = sc[1], dec = sc[2], m_new = sc[3];
        {
            const int j = tid >> 2, v8 = (tid & 3) * 8;
            float vv[8];
#pragma unroll
            for (int e = 0; e < 8; ++e) vv[e] = 0.f;
            if (j < Lc) unpack8(*(const GAS u32x4*)(zin + (size_t)(grow + j) * NZ + 2048 + h * 256 + sl * SLW + v8), vv);
            const float we = __expf(gG[j] - Mlast);
#pragma unroll
            for (int e = 0; e < 8; ++e) { ((LAS bf16_t*)(L + LO_VT))[(v8 + e) * QS + j] = (bf16_t)f2bf(vv[e]); ((LAS bf16_t*)(L + LO_VW))[(v8 + e) * QS + j] = (bf16_t)f2bf(vv[e] * we); }
            if ((tid & 3) == 0) { ((LAS bf16_t*)(L + LO_VT))[SLW * QS + j] = (j < Lc) ? (bf16_t)0x3F80 : (bf16_t)0; ((LAS bf16_t*)(L + LO_VW))[SLW * QS + j] = (bf16_t)f2bf(we); }
        }
        f32x4 accS[8], accR[NVT];
#pragma unroll
        for (int i = 0; i < 8; ++i) accS[i] = (f32x4){0.f, 0.f, 0.f, 0.f};
#pragma unroll
        for (int i = 0; i < NVT; ++i) accR[i] = (f32x4){0.f, 0.f, 0.f, 0.f};
#pragma unroll
        for (int half = 0; half < 2; ++half) {
#pragma unroll
            for (int i = 0; i < 4; ++i) { const int p = tid + NTHREADS * i, row = p >> 4, c16 = p & 15;
                u32x4 qv = (u32x4){0u, 0u, 0u, 0u}, kv = (u32x4){0u, 0u, 0u, 0u};
                if (row < Lc) { const bf16_t* src = zin + (size_t)(grow + row) * NZ + h * 256 + half * 128 + c16 * 8; qv = *(const GAS u32x4*)src; kv = *(const GAS u32x4*)(src + 1024); }
                *(LAS u32x4*)(L + LO_QH + (row * QS + c16 * 8) * 2) = qv; *(LAS u32x4*)(L + LO_KH + (row * QS + c16 * 8) * 2) = kv; }
            __syncthreads();
#pragma unroll
            for (int ks = 0; ks < 4; ++ks) {
                const bf16x8 qf = ldfrag(L + LO_QH, 16 * w + c, QS, 32 * ks + 8 * q);
#pragma unroll
                for (int jt = 0; jt < 8; ++jt) if (jt <= (w | 1)) { const bf16x8 kf = ldfrag(L + LO_KH, 16 * jt + c, QS, 32 * ks + 8 * q); accS[jt] = __builtin_amdgcn_mfma_f32_16x16x32_bf16(kf, qf, accS[jt], 0, 0, 0); }
#pragma unroll
                for (int vt = 0; vt < NVT; ++vt) { const bf16x8 cf = ldfrag(L + LO_CT, 16 * vt + c, CS, half * 128 + 32 * ks + 8 * q); accR[vt] = __builtin_amdgcn_mfma_f32_16x16x32_bf16(cf, qf, accR[vt], 0, 0, 0); }
                asm volatile("" ::: "memory");
            }
#pragma unroll
            for (int vt = 0; vt < NVT; ++vt) st[half][vt] = st[half][vt] * dec;
#pragma unroll
            for (int ks = 0; ks < 4; ++ks) {
                const LAS unsigned char* kp = L + LO_KH + ((32 * ks + 8 * q + (c >> 2)) * QS + 16 * w + 4 * (c & 3)) * 2;
                const s16x4 t0 = ml::trread(kp), t1 = ml::trread(kp + 4 * QS * 2);
                const bf16x8 kb = (bf16x8){t0[0], t0[1], t0[2], t0[3], t1[0], t1[1], t1[2], t1[3]};
#pragma unroll
                for (int vt = 0; vt < NVT; ++vt) { const bf16x8 vf = ldfrag(L + LO_VW, 16 * vt + c, QS, 32 * ks + 8 * q); st[half][vt] = __builtin_amdgcn_mfma_f32_16x16x32_bf16(vf, kb, st[half][vt], 0, 0, 0); }
            }
            if (half == 0 && w == 0 && ch + 1 < 17) ML_GATES_MATH((ch + 1) & 1);
            __syncthreads();
        }
        {
            int q = lane >> 4, c = lane & 15; asm volatile("" : "+v"(q), "+v"(c));
            const int i = 16 * w + c; const float Mi = gM[i];
#pragma unroll
            for (int jt = 0; jt < 8; ++jt) if (jt <= (w | 1)) {
                float p[4];
#pragma unroll
                for (int r = 0; r < 4; ++r) { const int j = 16 * jt + 4 * q + r; p[r] = (j <= i) ? accS[jt][r] * __expf(gG[j] - Mi) : 0.f; }
                *(LAS u32x2*)(L + LO_PS + (i * QS + 16 * jt + 4 * q) * 2) = (u32x2){pk2(p[0], p[1]), pk2(p[2], p[3])};
            }
#pragma unroll
            for (int half = 0; half < 2; ++half)
#pragma unroll
                for (int vt = 0; vt < NVT; ++vt)
#pragma unroll
                    for (int r = 0; r < 4; ++r) ((LAS bf16_t*)(L + LO_CT))[(16 * vt + 4 * q + r) * CS + half * 128 + 16 * w + c] = (bf16_t)f2bf(st[half][vt][r]);
        }
        __syncthreads();
        {
            f32x4 accN[NVT];
#pragma unroll
            for (int i = 0; i < NVT; ++i) accN[i] = (f32x4){0.f, 0.f, 0.f, 0.f};
#pragma unroll
            for (int ks = 0; ks < 4; ++ks) if (ks <= (w >> 1)) {
                const bf16x8 pf = ldfrag(L + LO_PS, 16 * w + c, QS, 32 * ks + 8 * q);
#pragma unroll
                for (int vt = 0; vt < NVT; ++vt) { const bf16x8 vf = ldfrag(L + LO_VT, 16 * vt + c, QS, 32 * ks + 8 * q); accN[vt] = __builtin_amdgcn_mfma_f32_16x16x32_bf16(vf, pf, accN[vt], 0, 0, 0); }
            }
            const int i = 16 * w + c; const float Mi = gM[i], Fi = gF[i];
            const float inter = __expf(m_old - Mi);
            float den = accN[NVR][0] + inter * accR[NVR][0];
            den = __shfl(den, c);
            const float dd = fmaxf(fabsf(den), __expf(-(Fi + Mi)));
            const float inv = 1.0f / dd;
#pragma unroll
            for (int vt = 0; vt < NVR; ++vt) {
                float hv[4];
#pragma unroll
                for (int r = 0; r < 4; ++r) hv[r] = (accN[vt][r] + inter * accR[vt][r]) * inv;
                if (i < Lc) *(GAS u32x2*)(hm + (size_t)(grow + i) * MIXA + h * 256 + sl * SLW + 16 * vt + 4 * q) = (u32x2){pk2(hv[0], hv[1]), pk2(hv[2], hv[3])};
            }
        }
        m_run = m_new;
        __syncthreads();
    }
#undef ML_GATES_LOAD
#undef ML_GATES_MATH
    float* out = F.out;
#pragma unroll
    for (int half = 0; half < 2; ++half) {
        const int dk = half * 128 + 16 * w + c;
#pragma unroll
        for (int vt = 0; vt < NVR; ++vt) *(GAS f32x4*)(out + O_PC + (((size_t)(b * NHA + h) * HDA + dk) * HDA) + sl * SLW + 16 * vt + 4 * q) = st[half][vt];
        if (sl == 0 && q == 0) out[O_PN + (size_t)(b * NHA + h) * HDA + dk] = st[half][NVR][0];
    }
    if (sl == 0 && tid == 0) out[O_PM + b * NHA + h] = m_run;
    __syncthreads();
}

__device__ __forceinline__ void mlstm_sample_job(Frame& F, const Args& args, int jid) {
    const int b = jid >> 2, h = jid & 3;
    const int tid = F.tid, lane = F.lane, w = F.wave;
    LAS float* qs = (LAS float*)(F.lds);
    LAS float* ks = qs + 2048;
    LAS float* vs = ks + 2048;
    LAS float* kw = vs + 2048;
    LAS float* sm = kw + 2048;
    LAS float* gv = sm + 128;
    LAS float* red = gv + 64;
    const bf16_t* zin = (const bf16_t*)(F.ws + WS_ZIN); const float* gates = (const float*)(F.ws + WS_GATES);
    const int row0 = MPR + b * DS;
    const float* C0 = args.in[I_MC] + (size_t)(b * NHA + h) * HDA * HDA; const float* n0 = args.in[I_MN] + (size_t)(b * NHA + h) * HDA;
    const float m0 = args.in[I_MM][b * NHA + h];
    float gl[16];
#pragma unroll
    for (int j = 0; j < 16; ++j) gl[j] = 0.f;
    if (tid == NTHREADS - 64) {
#pragma unroll
        for (int j = 0; j < 8; ++j) { gl[j] = gates[(size_t)(row0 + j) * 8 + h]; gl[8 + j] = gates[(size_t)(row0 + j) * 8 + 4 + h]; }
    }
    for (int i = tid; i < 3 * 8 * 32; i += NTHREADS) { const int which = i / 256, r = (i % 256) / 32, c8 = (i % 32) * 8;
        const u32x4 wv = *(const GAS u32x4*)(zin + (size_t)(row0 + r) * NZ + which * 1024 + h * 256 + c8); float x[8]; unpack8(wv, x);
        LAS float* dst = qs + which * 2048 + r * 256 + c8;
#pragma unroll
        for (int e = 0; e < 8; ++e) dst[e] = x[e]; }
    {
        if (tid == NTHREADS - 64) {
            float Fv[8], gg[8], Mi[8]; float cum = 0.f, pmx = -3e38f;
#pragma unroll
            for (int j = 0; j < 8; ++j) { const float ig = gl[j]; cum += log_sigmoidf_(gl[8 + j]); Fv[j] = cum; gg[j] = ig - cum; pmx = fmaxf(pmx, gg[j]); Mi[j] = fmaxf(m0, pmx); }
            const float Ml = Mi[7];
#pragma unroll
            for (int j = 0; j < 8; ++j) { gv[j] = Fv[j]; gv[8 + j] = gg[j]; gv[16 + j] = Mi[j]; gv[24 + j] = __expf(m0 - Mi[j]); gv[32 + j] = __expf(-(Fv[j] + Mi[j])); gv[40 + j] = __expf(gg[j] - Ml); }
            gv[48] = __expf(m0 - Ml); gv[49] = Fv[7] + Ml;
        }
    }
    __syncthreads();
    f32x4 cvA[8], cvB[8];
#define MS_LOAD(cv_, kb_) do { _Pragma("unroll") for (int u = 0; u < 8; ++u) cv_[u] = *(const GAS f32x4*)(C0 + (size_t)(32 * w + (kb_) + u) * HDA + 4 * lane); } while (0)
    MS_LOAD(cvA, 0); MS_LOAD(cvB, 8);
    for (int i = tid; i < 2048; i += NTHREADS) kw[i] = ks[i] * gv[40 + (i >> 8)];
    {
        const int i = w, j = lane >> 3, part = lane & 7;
        float d = 0.f, dn = 0.f;
        for (int k = part * 32; k < part * 32 + 32; ++k) { const float qv = qs[i * 256 + k]; d += qv * ks[j * 256 + k]; if (j == 0) dn += qv * n0[k]; }
        d += __shfl_xor(d, 1); d += __shfl_xor(d, 2); d += __shfl_xor(d, 4);
        dn += __shfl_xor(dn, 1); dn += __shfl_xor(dn, 2); dn += __shfl_xor(dn, 4);
        if (part == 0) { sm[i * 16 + j] = (j <= i) ? d * __expf(gv[8 + j] - gv[16 + i]) : 0.f; if (j == 0) sm[i * 16 + 8] = dn; }
    }
    lds_barrier();
    const float dec = gv[48];
    f32x4 vr[8], hacc[8];
#pragma unroll
    for (int j = 0; j < 8; ++j) { vr[j] = *(const LAS f32x4*)(vs + j * 256 + 4 * lane); hacc[j] = (f32x4){0.f, 0.f, 0.f, 0.f}; }
    float* Cout = F.out + O_SC + (size_t)(b * NHA + h) * HDA * HDA;
#define MS_USE(cv_, kb_) do { _Pragma("unroll") for (int u = 0; u < 8; ++u) { const int k = 32 * w + (kb_) + u; \
            f32x4 cn = cv_[u] * dec; \
            _Pragma("unroll") for (int j = 0; j < 8; ++j) { hacc[j] += cv_[u] * qs[j * 256 + k]; cn += vr[j] * kw[j * 256 + k]; } \
            *(GAS f32x4*)(Cout + (size_t)k * HDA + 4 * lane) = cn; } } while (0)
    MS_USE(cvA, 0);  MS_LOAD(cvA, 16);
    MS_USE(cvB, 8);  MS_LOAD(cvB, 24);
    MS_USE(cvA, 16);
    MS_USE(cvB, 24);
#undef MS_LOAD
#undef MS_USE
#pragma unroll
    for (int j = 0; j < 8; ++j) *(LAS f32x4*)(red + (w * 8 + j) * 256 + 4 * lane) = hacc[j];
    __syncthreads();
    {
        const int i = tid >> 6; f32x4 qc = (f32x4){0.f, 0.f, 0.f, 0.f};
#pragma unroll
        for (int ww = 0; ww < 8; ++ww) qc += *(const LAS f32x4*)(red + (ww * 8 + i) * 256 + 4 * lane);
        f32x4 num = qc * gv[24 + i]; float den = gv[24 + i] * sm[i * 16 + 8];
#pragma unroll
        for (int j = 0; j < 8; ++j) { const float sij = sm[i * 16 + j]; num += vr[j] * sij; den += sij; }
        const float inv = 1.0f / fmaxf(fabsf(den), gv[32 + i]);
        num = num * inv;
        *(GAS u32x2*)((bf16_t*)(F.ws + WS_HM) + (size_t)(row0 + i) * MIXA + h * 256 + 4 * lane) = (u32x2){pk2(num[0], num[1]), pk2(num[2], num[3])};
    }
    if (tid < 256) { float nn = dec * n0[tid];
#pragma unroll
        for (int j = 0; j < 8; ++j) nn += kw[j * 256 + tid];
        F.out[O_SN + (size_t)(b * NHA + h) * HDA + tid] = nn; }
    if (tid == 0) F.out[O_SM + b * NHA + h] = gv[49];
    __syncthreads();
}


namespace rg {
constexpr int XS = 128, AS = 144, HS = 132;
constexpr int O_XP = 0, O_XC = O_XP + 176 * XS * 2, O_WA = O_XC + 128 * AS * 2, O_WX = O_WA + 32 * AS * 2, O_AL = O_WX + 32 * AS * 2, O_UL = O_AL + 32 * HS * 4, O_CR = O_UL + 32 * HS * 4, O_ENDL = O_CR + 128;
static_assert(O_ENDL <= RING_BYTES, "rglru lds");
}
__device__ __forceinline__ float gelu_tanh_(float x) { const float u = 0.7978845608028654f * (x + 0.044715f * x * x * x); return 0.5f * x * (1.0f + tanhf_(u)); }

__device__ __forceinline__ void rglru_job(Frame& F, const Args& args, int kind, int sq, int n, int qt) {
    using namespace rg;
    const int tid = F.tid, lane = F.lane, w = F.wave, q = lane >> 4, c = lane & 15;
    LAS unsigned char* L = F.lds;
    LAS bf16_t* xp = (LAS bf16_t*)(L + O_XP); LAS bf16_t* xc = (LAS bf16_t*)(L + O_XC);
    LAS float* aL = (LAS float*)(L + O_AL); LAS float* uL = (LAS float*)(L + O_UL); LAS float* carry = (LAS float*)(L + O_CR);
    const bf16_t* zin = (const bf16_t*)(F.ws + WS_ZIN); bf16_t* cat = (bf16_t*)(F.ws + WS_CAT);
    const int cb0 = n * 128;
    const int c0 = cb0 + qt * 32;
    for (int i = tid; i < 2 * 32 * 128; i += NTHREADS) { const int which = i >> 12, cc = (i >> 7) & 31, ii = i & 127;
        const float v = args.in[which ? I_WX : I_WA][((size_t)n * 128 + ii) * 128 + qt * 32 + cc];
        ((LAS bf16_t*)(L + (which ? O_WX : O_WA)))[cc * AS + ii] = (bf16_t)f2bf(v); }
    const int chn = tid & 127;
    const int rq = tid >> 4, cq = tid & 15;
    float cw[4][8], cbias[8];
#pragma unroll
    for (int j = 0; j < 4; ++j)
#pragma unroll
        for (int e = 0; e < 8; ++e) cw[j][e] = args.in[I_CVW][j * RGW + cb0 + 8 * cq + e];
#pragma unroll
    for (int e = 0; e < 8; ++e) cbias[e] = args.in[I_CVB][cb0 + 8 * cq + e];
    float bav[2], bxv[2], spv[2];
#pragma unroll
    for (int e = 0; e < 2; ++e) { const int cg = c0 + 16 * e + c; bav[e] = args.in[I_BA][cg]; bxv[e] = args.in[I_BX][cg]; spv[e] = softplusf_(-args.in[I_LAM][cg]); }
    if (tid < 32) carry[tid] = 0.f;
    const int ntiles = kind ? 1 : 17;
    const int T = kind ? DS : TP;
    u32x4 pre[5];
#define RG_PREFETCH(t0_) do { _Pragma("unroll") for (int i_ = 0; i_ < 5; ++i_) { const int p_ = tid + NTHREADS * i_; const int r_ = p_ >> 4, c16_ = p_ & 15; const int tok_ = (t0_) - 3 + r_; \
        pre[i_] = (u32x4){0u, 0u, 0u, 0u}; if (p_ < 131 * 16 && tok_ >= 0 && tok_ < TP) pre[i_] = *(const GAS u32x4*)(zin + (size_t)(sq * TP + tok_) * NZ + 4096 + cb0 + c16_ * 8); } } while (0)
    if (kind == 0) RG_PREFETCH(0);
    for (int ti = 0; ti < ntiles; ++ti) {
        const int t0 = ti * 128;
        const int nv = kind ? 128 : ((TP - t0) < 128 ? (TP - t0) : 128);
        __syncthreads();
        if (kind == 0) {
#pragma unroll
            for (int i = 0; i < 5; ++i) { const int p = tid + NTHREADS * i; if (p < 131 * 16) *(LAS u32x4*)(xp + (p >> 4) * XS + (p & 15) * 8) = pre[i]; }
        } else {
            for (int p = tid; p < 176 * 16; p += NTHREADS) { const int r = p >> 4, c16 = p & 15; const int sg = r / 11, lr = r % 11; const int bq = sq * 16 + sg;
                u32x4 v;
                if (lr < 3) { const float* src = args.in[I_RC] + ((size_t)bq * 3 + lr) * RGW + cb0 + c16 * 8; const f32x4 a = *(const GAS f32x4*)src, bb = *(const GAS f32x4*)(src + 4);
                    v.x = pk2(a[0], a[1]); v.y = pk2(a[2], a[3]); v.z = pk2(bb[0], bb[1]); v.w = pk2(bb[2], bb[3]); }
                else v = *(const GAS u32x4*)(zin + (size_t)(MPR + bq * DS + lr - 3) * NZ + 4096 + cb0 + c16 * 8);
                *(LAS u32x4*)(xp + r * XS + c16 * 8) = v; }
        }
        u32x4 gpre = (u32x4){0u, 0u, 0u, 0u};
        { const int rho = tid >> 2, c8 = (tid & 3) * 8;
          if (rho < nv) { const int grow = kind ? (MPR + (sq * 16 + (rho >> 3)) * DS + (rho & 7)) : (sq * TP + t0 + rho); gpre = *(const GAS u32x4*)(zin + (size_t)grow * NZ + 5120 + c0 + c8); } }
        __syncthreads();
        if (kind == 0 && ti + 1 < ntiles) RG_PREFETCH(t0 + 128);
        {
            const int rho0 = 4 * rq; const int idx0 = kind ? ((rho0 >> 3) * 11 + (rho0 & 7)) : rho0;
            float xr[7][8];
#pragma unroll
            for (int j = 0; j < 7; ++j) unpack8(*(const LAS u32x4*)(xp + (idx0 + j) * XS + 8 * cq), xr[j]);
#pragma unroll
            for (int r = 0; r < 4; ++r) { float o[8];
#pragma unroll
                for (int e = 0; e < 8; ++e) o[e] = cbias[e] + cw[0][e] * xr[r][e] + cw[1][e] * xr[r + 1][e] + cw[2][e] * xr[r + 2][e] + cw[3][e] * xr[r + 3][e];
                *(LAS u32x4*)(xc + (rho0 + r) * AS + 8 * cq) = pack8(o); }
        }
        __syncthreads();
        f32x4 acc[4];
#pragma unroll
        for (int i = 0; i < 4; ++i) acc[i] = (f32x4){0.f, 0.f, 0.f, 0.f};
#pragma unroll
        for (int ks = 0; ks < 4; ++ks) {
            const bf16x8 xf = *(const LAS bf16x8*)(xc + (16 * w + c) * AS + 32 * ks + 8 * q);
#pragma unroll
            for (int nt = 0; nt < 4; ++nt) { const bf16x8 wf = *(const LAS bf16x8*)((LAS bf16_t*)(L + ((nt >> 1) ? O_WX : O_WA)) + (16 * (nt & 1) + c) * AS + 32 * ks + 8 * q);
                acc[nt] = __builtin_amdgcn_mfma_f32_16x16x32_bf16(xf, wf, acc[nt], 0, 0, 0); }
        }
#pragma unroll
        for (int e = 0; e < 2; ++e) {
            f32x4 av, uv;
#pragma unroll
            for (int r = 0; r < 4; ++r) { const int t = 16 * w + 4 * q + r;
                const float rr = sigmoidf_(acc[e][r] + bav[e]), gi = sigmoidf_(acc[2 + e][r] + bxv[e]);
                const float la = -8.0f * rr * spv[e]; const float a = __expf(la); const float mult = sqrtf(fmaxf(1.0f - a * a, 0.f));
                const float xv = bf2f(xc[t * AS + qt * 32 + 16 * e + c]);
                const bool valid = t < nv;
                av[r] = valid ? a : 1.0f; uv[r] = valid ? mult * gi * xv : 0.f; }
            *(LAS f32x4*)(aL + (16 * e + c) * HS + 16 * w + 4 * q) = av; *(LAS f32x4*)(uL + (16 * e + c) * HS + 16 * w + 4 * q) = uv;
        }
        __syncthreads();
        {
            const int sg = tid & 15, ch = tid >> 4;
            float a8[8], u8[8];
            { const f32x4 a0 = *(const LAS f32x4*)(aL + ch * HS + 8 * sg), a1 = *(const LAS f32x4*)(aL + ch * HS + 8 * sg + 4), u0 = *(const LAS f32x4*)(uL + ch * HS + 8 * sg), u1 = *(const LAS f32x4*)(uL + ch * HS + 8 * sg + 4);
#pragma unroll
              for (int e = 0; e < 4; ++e) { a8[e] = a0[e]; a8[4 + e] = a1[e]; u8[e] = u0[e]; u8[4 + e] = u1[e]; } }
            float hin;
            if (kind == 0) {
                float A = 1.f, H = 0.f;
#pragma unroll
                for (int k = 0; k < 8; ++k) { H = a8[k] * H + u8[k]; A *= a8[k]; }
#pragma unroll
                for (int d = 1; d < 16; d <<= 1) { const float Ap = __shfl_up(A, d, 16), Hp = __shfl_up(H, d, 16); if (sg >= d) { H = A * Hp + H; A = A * Ap; } }
                float Ae = __shfl_up(A, 1, 16), He = __shfl_up(H, 1, 16); if (sg == 0) { Ae = 1.f; He = 0.f; }
                hin = Ae * carry[ch] + He;
            } else {
                hin = args.in[I_RH][(size_t)(sq * 16 + sg) * RGW + c0 + ch];
            }
            float hcur = hin; float h8[8];
#pragma unroll
            for (int k = 0; k < 8; ++k) { hcur = a8[k] * hcur + u8[k]; h8[k] = hcur; }
            __syncthreads();
            *(LAS f32x4*)(uL + ch * HS + 8 * sg) = (f32x4){h8[0], h8[1], h8[2], h8[3]}; *(LAS f32x4*)(uL + ch * HS + 8 * sg + 4) = (f32x4){h8[4], h8[5], h8[6], h8[7]};
            if (kind == 0) { if (sg == 15) carry[ch] = hcur; }
            else F.out[O_SH + (size_t)(sq * 16 + sg) * RGW + c0 + ch] = hcur;
            if (kind == 0 && ti == ntiles - 1 && sg == 15) F.out[O_PH + (size_t)sq * RGW + c0 + ch] = hcur;
        }
        __syncthreads();
        {
            const int rho = tid >> 2, c8 = (tid & 3) * 8;
            if (rho < nv) {
                const int grow = kind ? (MPR + (sq * 16 + (rho >> 3)) * DS + (rho & 7)) : (sq * TP + t0 + rho);
                float gr[8], o[8]; unpack8(gpre, gr);
#pragma unroll
                for (int e = 0; e < 8; ++e) o[e] = uL[(c8 + e) * HS + rho] * gelu_tanh_(gr[e]);
                *(GAS u32x4*)(cat + (size_t)grow * D + 1024 + c0 + c8) = pack8(o);
            }
        }
        if (qt == 0) {
            if (kind == 0) { if (ti == ntiles - 1 && tid < 384) { const int i3 = tid >> 7; F.out[O_PCV + ((size_t)sq * 3 + i3) * RGW + cb0 + chn] = bf2f(xp[(nv + i3) * XS + chn]); } }
            else { for (int p = tid; p < 16 * 3 * 128; p += NTHREADS) { const int sg = p / 384, i3 = (p % 384) >> 7, ch2 = p & 127; F.out[O_SCV + ((size_t)(sq * 16 + sg) * 3 + i3) * RGW + cb0 + ch2] = bf2f(xp[(sg * 11 + 8 + i3) * XS + ch2]); } }
        }
    }
#undef RG_PREFETCH
    __syncthreads();
    (void)T;
}


namespace rw {
constexpr int TB = 64;
constexpr int O_W = 0, O_A = O_W + TB * 64 * 4, O_B = O_A + TB * 64 * 4, O_K = O_B + TB * 64 * 4, O_R = O_K + TB * 64 * 4, O_V = O_R + TB * 64 * 4, O_Y = O_V + TB * 64 * 4, O_CB = O_Y + TB * 64 * 4, O_WC = O_CB + TB * 4, O_SP = O_WC + 256, O_ENDL = O_SP + 8 * 64 * 4;
static_assert(O_ENDL <= RING_BYTES, "rwkv lds");
}
__device__ __forceinline__ float row16_sum(float v) {
    v += __builtin_bit_cast(float, __builtin_amdgcn_update_dpp(0, __builtin_bit_cast(int, v), 0x128, 0xf, 0xf, false));
    v += __builtin_bit_cast(float, __builtin_amdgcn_update_dpp(0, __builtin_bit_cast(int, v), 0x124, 0xf, 0xf, false));
    v += __builtin_bit_cast(float, __builtin_amdgcn_update_dpp(0, __builtin_bit_cast(int, v), 0x122, 0xf, 0xf, false));
    v += __builtin_bit_cast(float, __builtin_amdgcn_update_dpp(0, __builtin_bit_cast(int, v), 0x121, 0xf, 0xf, false));
    return v;
}
template <int CTRL> __device__ __forceinline__ float dppf(float v) { return __builtin_bit_cast(float, __builtin_amdgcn_update_dpp(0, __builtin_bit_cast(int, v), CTRL, 0xf, 0xf, false)); }
#define RS_STAGE(n, bit, XCH) do { _Pragma("unroll") for (int j_ = 0; j_ < (n); ++j_) { \
        const float lo_ = ya[j_], hi_ = ya[j_ + (n)]; const float keep_ = (bit) ? hi_ : lo_, send_ = (bit) ? lo_ : hi_; ya[j_] = keep_ + XCH(send_); \
        const float lo2_ = yb[j_], hi2_ = yb[j_ + (n)]; const float keep2_ = (bit) ? hi2_ : lo2_, send2_ = (bit) ? lo2_ : hi2_; yb[j_] = keep2_ + XCH(send2_); } } while (0)
__device__ __forceinline__ float xch1(float v) { return dppf<0xB1>(v); }
__device__ __forceinline__ float xch2(float v) { return dppf<0x4E>(v); }
__device__ __forceinline__ float xch8(float v) { return dppf<0x128>(v); }
__device__ __forceinline__ float xch4(float v) { return dppf<0x1B>(dppf<0x141>(v)); }

__device__ __forceinline__ void rwkv_job(Frame& F, const Args& args, int rowbase, int T, int h, const float* S0, float* Sout) {
    using namespace rw;
    const int tid = F.tid, lane = F.lane, w = F.wave, rp = lane >> 4, kp = lane & 15;
    LAS unsigned char* L = F.lds;
    LAS float* Wl = (LAS float*)(L + O_W); LAS float* Al = (LAS float*)(L + O_A); LAS float* Bl = (LAS float*)(L + O_B); LAS float* Kl = (LAS float*)(L + O_K);
    LAS float* Rl = (LAS float*)(L + O_R); LAS float* Vl = (LAS float*)(L + O_V); LAS float* Yl = (LAS float*)(L + O_Y); LAS float* CBl = (LAS float*)(L + O_CB); LAS float* WCl = (LAS float*)(L + O_WC); LAS float* SPl = (LAS float*)(L + O_SP);
    const bf16_t* rb = (const bf16_t*)(F.ws + WS_RKV); const bf16_t* kb = rb + (size_t)MP * D; const bf16_t* vb = kb + (size_t)MP * D;
    const float* wd = (const float*)(F.ws + WS_WDEC); const bf16_t* ab = (const bf16_t*)(F.ws + WS_AG); const bf16_t* gb = (const bf16_t*)(F.ws + WS_GG);
    bf16_t* ycat = (bf16_t*)(F.ws + WS_YCAT);
    const int r0 = 8 * w + 2 * rp;
    f32x4 Sa, Sb;
    if (S0) { Sa = *(const GAS f32x4*)(S0 + (size_t)r0 * 64 + 4 * kp); Sb = *(const GAS f32x4*)(S0 + (size_t)(r0 + 1) * 64 + 4 * kp); }
    else { Sa = (f32x4){0.f, 0.f, 0.f, 0.f}; Sb = Sa; }
    const bool b0 = kp & 1, b1 = kp & 2, b2 = kp & 4, b3 = kp & 8;
    const int jmap = 8 * (kp & 1) + 4 * ((kp >> 1) & 1) + 2 * ((kp >> 3) & 1) + ((kp >> 2) & 1);
    const int tt = tid >> 3, part = tid & 7, hk = h * 64 + 8 * part;
    float ckk[8], cka[8], crk[8], clg[8], clb[8];
#pragma unroll
    for (int e = 0; e < 8; ++e) { ckk[e] = args.in[I_KK][hk + e]; cka[e] = args.in[I_KA][hk + e]; crk[e] = args.in[I_RK][hk + e]; clg[e] = args.in[I_LNXG][hk + e]; clb[e] = args.in[I_LNXB][hk + e]; }
    u32x4 q_r = (u32x4){0u, 0u, 0u, 0u}, q_k = q_r, q_v = q_r, q_a = q_r, q_g = q_r; f32x4 q_w0 = (f32x4){0.f, 0.f, 0.f, 0.f}, q_w1 = q_w0;
#define RW_PREFETCH(tb_) do { if ((tb_) + tt < T) { const size_t row_ = (size_t)(rowbase + (tb_) + tt); \
        q_r = *(const GAS u32x4*)(rb + row_ * D + hk); q_k = *(const GAS u32x4*)(kb + row_ * D + hk); q_v = *(const GAS u32x4*)(vb + row_ * D + hk); q_a = *(const GAS u32x4*)(ab + row_ * D + hk); \
        q_g = *(const GAS u32x4*)(gb + row_ * D + hk); q_w0 = *(const GAS f32x4*)(wd + row_ * D + hk); q_w1 = *(const GAS f32x4*)(wd + row_ * D + hk + 4); } } while (0)
    RW_PREFETCH(0);
    for (int tb = 0; tb < T; tb += TB) {
        const int nvt = (T - tb) < TB ? (T - tb) : TB;
        __syncthreads();
        float gcur[8];
        {
            const int o = tt * 64 + 8 * part;
            if (tt < nvt) {
                float r[8], k[8], v[8], a[8], wv[8];
                unpack8(q_r, r); unpack8(q_k, k); unpack8(q_v, v); unpack8(q_a, a); unpack8(q_g, gcur);
#pragma unroll
                for (int e = 0; e < 4; ++e) { wv[e] = q_w0[e]; wv[4 + e] = q_w1[e]; }
                float kkv[8], ss = 0.f, cb = 0.f, kp2[8];
#pragma unroll
                for (int e = 0; e < 8; ++e) { kkv[e] = k[e] * ckk[e]; ss += kkv[e] * kkv[e]; kp2[e] = k[e] * (1.0f + (a[e] - 1.0f) * cka[e]); cb += r[e] * kp2[e] * crk[e]; }
                ss += __shfl_xor(ss, 1); ss += __shfl_xor(ss, 2); ss += __shfl_xor(ss, 4);
                cb += __shfl_xor(cb, 1); cb += __shfl_xor(cb, 2); cb += __shfl_xor(cb, 4);
                const float inv = 1.0f / fmaxf(sqrtf(ss), 1e-12f);
#pragma unroll
                for (int e = 0; e < 8; ++e) { const float kk = kkv[e] * inv; Wl[o + e] = wv[e]; Al[o + e] = -kk; Bl[o + e] = kk * a[e]; Kl[o + e] = kp2[e]; Rl[o + e] = r[e]; Vl[o + e] = v[e]; }
                if (part == 0) CBl[tt] = cb;
            } else {
#pragma unroll
                for (int e = 0; e < 8; ++e) { Wl[o + e] = 1.f; Al[o + e] = 0.f; Bl[o + e] = 0.f; Kl[o + e] = 0.f; Rl[o + e] = 0.f; Vl[o + e] = 0.f; gcur[e] = 0.f; }
            }
        }
        RW_PREFETCH(tb + TB);
        __syncthreads();
        {
            const int kk_ = tid & 63, sg_ = tid >> 6;
            float wseg[8]; float pr = 1.f;
#pragma unroll
            for (int e = 0; e < 8; ++e) { wseg[e] = Wl[(8 * sg_ + e) * 64 + kk_]; pr *= wseg[e]; }
            SPl[sg_ * 64 + kk_] = pr;
            __syncthreads();
            float wc = 1.f;
#pragma unroll
            for (int q_ = 0; q_ < 8; ++q_) if (q_ < sg_) wc *= SPl[q_ * 64 + kk_];
#pragma unroll
            for (int e = 0; e < 8; ++e) { const int o_ = (8 * sg_ + e) * 64 + kk_;
                Al[o_] *= wc; wc *= wseg[e]; const float iw = 1.0f / wc; Bl[o_] *= iw; Kl[o_] *= iw; Rl[o_] *= wc; }
            if (sg_ == 7) WCl[kk_] = wc;
        }
        __syncthreads();
        const int ngrp = (nvt + 15) >> 4;
#define RW_LOAD(P, t_) do { P##a = *(const LAS f32x4*)(Al + (t_) * 64 + 4 * kp); P##b = *(const LAS f32x4*)(Bl + (t_) * 64 + 4 * kp); \
            P##k = *(const LAS f32x4*)(Kl + (t_) * 64 + 4 * kp); P##r = *(const LAS f32x4*)(Rl + (t_) * 64 + 4 * kp); P##v = *(const LAS f32x2*)(Vl + (t_) * 64 + r0); } while (0)
        f32x4 ca, cbv, ck, cr; f32x2 cv;
        f32x4 n0_a, n0_b, n0_k, n0_r; f32x2 n0_v;
        { RW_LOAD(n0_, 0); ca = n0_a; cbv = n0_b; ck = n0_k; cr = n0_r; cv = n0_v; }
#ifdef RW_DUPSTEPS
        const f32x4 Sa_sv = Sa, Sb_sv = Sb;
        for (int rep_ = 0; rep_ < 2; ++rep_) { if (rep_) { Sa = Sa_sv; Sb = Sb_sv; RW_LOAD(n0_, 0); ca = n0_a; cbv = n0_b; ck = n0_k; cr = n0_r; cv = n0_v; }
#endif
        for (int g = 0; g < ngrp; ++g) {
            float ya[16], yb[16];
#pragma unroll
            for (int j = 0; j < 16; ++j) {
                const int t = 16 * g + j;
                f32x4 na, nb, nk, nr; f32x2 nv;
                RW_LOAD(n, t + 1);
                __builtin_amdgcn_sched_barrier(0);
                const f32x2 a_lo = (f32x2){ca[0], ca[1]}, a_hi = (f32x2){ca[2], ca[3]};
                f32x2 qa = (f32x2){Sa[0], Sa[1]} * a_lo; qa = (f32x2){Sa[2], Sa[3]} * a_hi + qa;
                f32x2 qb = (f32x2){Sb[0], Sb[1]} * a_lo; qb = (f32x2){Sb[2], Sb[3]} * a_hi + qb;
                float pa = qa[0] + qa[1], pb = qb[0] + qb[1];
                const f32x4 ta = Sa + ck * cv[0], tbv = Sb + ck * cv[1];
                pa = row16_sum(pa); pb = row16_sum(pb);
                Sa = ta + cbv * pa; Sb = tbv + cbv * pb;
                const f32x2 r_lo = (f32x2){cr[0], cr[1]}, r_hi = (f32x2){cr[2], cr[3]};
                f32x2 za = (f32x2){Sa[0], Sa[1]} * r_lo; za = (f32x2){Sa[2], Sa[3]} * r_hi + za;
                f32x2 zb = (f32x2){Sb[0], Sb[1]} * r_lo; zb = (f32x2){Sb[2], Sb[3]} * r_hi + zb;
                ya[j] = za[0] + za[1]; yb[j] = zb[0] + zb[1];
                ca = na; cbv = nb; ck = nk; cr = nr; cv = nv;
                __builtin_amdgcn_sched_barrier(0);
            }
            RS_STAGE(8, b0, xch1); RS_STAGE(4, b1, xch2); RS_STAGE(2, b3, xch8); RS_STAGE(1, b2, xch4);
            *(LAS f32x2*)(Yl + (16 * g + jmap) * 64 + r0) = (f32x2){ya[0], yb[0]};
        }
#ifdef RW_DUPSTEPS
        }
#endif
#undef RW_LOAD
        { const f32x4 wl = *(const LAS f32x4*)(WCl + 4 * kp); Sa = Sa * wl; Sb = Sb * wl; }
        __syncthreads();
        if (tt < nvt) {
            const size_t row = (size_t)(rowbase + tb + tt);
            float y[8]; float s = 0.f;
#pragma unroll
            for (int e = 0; e < 8; ++e) { y[e] = Yl[tt * 64 + 8 * part + e]; s += y[e]; }
            s += __shfl_xor(s, 1); s += __shfl_xor(s, 2); s += __shfl_xor(s, 4);
            const float mu = s * (1.f / 64.f); float s2 = 0.f;
#pragma unroll
            for (int e = 0; e < 8; ++e) { y[e] -= mu; s2 += y[e] * y[e]; }
            s2 += __shfl_xor(s2, 1); s2 += __shfl_xor(s2, 2); s2 += __shfl_xor(s2, 4);
            const float rstd = 1.0f / sqrtf(s2 * (1.f / 64.f) + GN_EPS);
            float o[8];
            const float cb = CBl[tt];
#pragma unroll
            for (int e = 0; e < 8; ++e) o[e] = (y[e] * rstd * clg[e] + clb[e] + cb * Vl[tt * 64 + 8 * part + e]) * gcur[e];
            *(GAS u32x4*)(ycat + row * D + hk) = pack8(o);
        }
    }
#undef RW_PREFETCH
    *(GAS f32x4*)(Sout + (size_t)r0 * 64 + 4 * kp) = Sa; *(GAS f32x4*)(Sout + (size_t)(r0 + 1) * 64 + 4 * kp) = Sb;
    __syncthreads();
}


namespace rwc {
constexpr int TB = 64, LD = 66, LDG = 34, LDT = 18;
constexpr int LDB = 72;
constexpr int O_W = 0, O_B = O_W + TB * LD * 4, O_K = O_B + TB * LD * 4, O_V = O_K + TB * LD * 4, O_SB = O_V + TB * LD * 4,
              O_AB = O_SB + 64 * LDB * 2, O_RB = O_AB + TB * LDB * 2, O_BB = O_RB + TB * LDB * 2, O_KB = O_BB + TB * LDB * 2, O_U = O_KB + TB * LDB * 2, O_G = O_U + 16 * LD * 4, O_T = O_G + 4 * 32 * LDG * 4,
              O_WC = O_T + 4 * 16 * LDT * 4, O_CB = O_WC + 4 * 64 * 4, O_VT = O_CB + TB * 4, O_UT = O_VT + 64 * LDB * 2, O_LK = O_UT + 64 * 24 * 2, O_TB = O_LK + 4 * 16 * 20 * 2, O_ENDL = O_TB + 4 * 16 * 20 * 2;
constexpr int LDK = 20;
constexpr int LDU = 24;
constexpr int O_BT = O_B, O_KT = O_K;
constexpr int O_A = O_U;
static_assert(O_A + TB * LD * 4 <= O_WC, "rwkv temp alias");
static_assert(O_ENDL <= RING_BYTES, "rwkv chunk lds");
template <int K> __device__ __forceinline__ f32x4 mm(f32x4 acc, const LAS float* pa, int sak, const LAS float* pb, int sbk) {
    float a[K / 4], b[K / 4];
#pragma unroll
    for (int s4 = 0; s4 < K / 4; ++s4) { a[s4] = pa[4 * s4 * sak]; b[s4] = pb[4 * s4 * sbk]; }
    __builtin_amdgcn_sched_barrier(0);
#pragma unroll
    for (int s4 = 0; s4 < K / 4; ++s4) acc = __builtin_amdgcn_mfma_f32_16x16x4f32(a[s4], b[s4], acc, 0, 0, 0);
    return acc;
}
}
template <bool PUB, bool BAT = false>
__device__ __forceinline__ void rwkv_job_c(Frame& F, const Args& args, int rowbase, int T, int h, const float* S0, float* Sout, unsigned* prog = nullptr, size_t sstride = 0) {
    using namespace rwc;
    const int tid = F.tid, lane = F.lane, w = F.wave, q0 = lane >> 4, c0 = lane & 15;
    LAS unsigned char* L = F.lds;
    LAS float* Wl = (LAS float*)(L + O_W); LAS float* Al = (LAS float*)(L + O_A); LAS float* Bl = (LAS float*)(L + O_B); LAS float* Kl = (LAS float*)(L + O_K);
    LAS bf16_t* Bb = (LAS bf16_t*)(L + O_BB); LAS bf16_t* Kb = (LAS bf16_t*)(L + O_KB); LAS bf16_t* BTb = (LAS bf16_t*)(L + O_BT); LAS bf16_t* KTb = (LAS bf16_t*)(L + O_KT); LAS bf16_t* VTb = (LAS bf16_t*)(L + O_VT); LAS bf16_t* UTb = (LAS bf16_t*)(L + O_UT); LAS bf16_t* LKb = (LAS bf16_t*)(L + O_LK); LAS bf16_t* Tbb = (LAS bf16_t*)(L + O_TB); LAS float* Vl = (LAS float*)(L + O_V); LAS bf16_t* Sb = (LAS bf16_t*)(L + O_SB); LAS bf16_t* Ab = (LAS bf16_t*)(L + O_AB); LAS bf16_t* Rb = (LAS bf16_t*)(L + O_RB); LAS float* UL = (LAS float*)(L + O_U);
    LAS float* GL = (LAS float*)(L + O_G); LAS float* TL = (LAS float*)(L + O_T); LAS float* WCl = (LAS float*)(L + O_WC); LAS float* CBl = (LAS float*)(L + O_CB);
    LAS float* Yl = Wl;
    const bf16_t* rb = (const bf16_t*)(F.ws + WS_RKV); const bf16_t* kb = rb + (size_t)MP * D; const bf16_t* vb = kb + (size_t)MP * D;
    const float* wd = (const float*)(F.ws + WS_WDEC); const bf16_t* ab = (const bf16_t*)(F.ws + WS_AG); const bf16_t* gb = (const bf16_t*)(F.ws + WS_GG);
    bf16_t* ycat = (bf16_t*)(F.ws + WS_YCAT);
    const int rt = w >> 1, kh = w & 1;
    f32x4 st[2];
#pragma unroll
    for (int e = 0; e < 2; ++e)
#pragma unroll
        for (int r = 0; r < 4; ++r) st[e][r] = S0 ? S0[(size_t)(16 * rt + 4 * q0 + r) * 64 + 16 * (2 * kh + e) + c0] : 0.f;
    const int tt = tid >> 3, part = tid & 7, hk = h * 64 + 8 * part;
    float ckk[8], cka[8], crk[8], clg[8], clb[8];
#pragma unroll
    for (int e = 0; e < 8; ++e) { ckk[e] = args.in[I_KK][hk + e]; cka[e] = args.in[I_KA][hk + e]; crk[e] = args.in[I_RK][hk + e]; clg[e] = args.in[I_LNXG][hk + e]; clb[e] = args.in[I_LNXB][hk + e]; }
    u32x4 q_r = (u32x4){0u, 0u, 0u, 0u}, q_k = q_r, q_v = q_r, q_a = q_r, q_g = q_r; f32x4 q_w0 = (f32x4){0.f, 0.f, 0.f, 0.f}, q_w1 = q_w0;
#define RW_PREFETCH(tb_) do { if (BAT ? ((tb_) == 0 && (tt & 15) < DS) : ((tb_) + tt < T)) { const size_t row_ = BAT ? (size_t)(rowbase + (tt >> 4) * DS + (tt & 15)) : (size_t)(rowbase + (tb_) + tt); \
        q_r = *(const GAS u32x4*)(rb + row_ * D + hk); q_k = *(const GAS u32x4*)(kb + row_ * D + hk); q_v = *(const GAS u32x4*)(vb + row_ * D + hk); q_a = *(const GAS u32x4*)(ab + row_ * D + hk); \
        q_g = *(const GAS u32x4*)(gb + row_ * D + hk); q_w0 = *(const GAS f32x4*)(wd + row_ * D + hk); q_w1 = *(const GAS f32x4*)(wd + row_ * D + hk + 4); } } while (0)
    RW_PREFETCH(0);
    for (int tb = 0; tb < T; tb += TB) {
        int q = q0, c = c0; asm volatile("" : "+v"(q), "+v"(c));
        const int nvt = (T - tb) < TB ? (T - tb) : TB;
        const int nch = (nvt + 15) >> 4;
        __syncthreads();
        float gcur[8];
        {
            const int o = tt * LD + 8 * part;
            if (BAT ? ((tt & 15) < DS) : (tt < nvt)) {
                float r[8], k[8], v[8], a[8], wv[8];
                unpack8(q_r, r); unpack8(q_k, k); unpack8(q_v, v); unpack8(q_a, a); unpack8(q_g, gcur);
#pragma unroll
                for (int e = 0; e < 4; ++e) { wv[e] = q_w0[e]; wv[4 + e] = q_w1[e]; }
                float kkv[8], ss = 0.f, cb = 0.f, kp2[8];
#pragma unroll
                for (int e = 0; e < 8; ++e) { kkv[e] = k[e] * ckk[e]; ss += kkv[e] * kkv[e]; kp2[e] = k[e] * (1.0f + (a[e] - 1.0f) * cka[e]); cb += r[e] * kp2[e] * crk[e]; }
                ss += __shfl_xor(ss, 1); ss += __shfl_xor(ss, 2); ss += __shfl_xor(ss, 4);
                cb += __shfl_xor(cb, 1); cb += __shfl_xor(cb, 2); cb += __shfl_xor(cb, 4);
                const float inv = 1.0f / fmaxf(sqrtf(ss), 1e-12f);
#pragma unroll
                for (int e = 0; e < 8; ++e) { const float kk = kkv[e] * inv; Wl[o + e] = wv[e]; Al[o + e] = -kk; Bl[o + e] = kk * a[e]; Kl[o + e] = kp2[e]; Vl[o + e] = v[e]; }
                *(LAS u32x4*)(Rb + tt * LDB + 8 * part) = q_r;
                if (part == 0) CBl[tt] = cb;
            } else {
#pragma unroll
                for (int e = 0; e < 8; ++e) { Wl[o + e] = 1.f; Al[o + e] = 0.f; Bl[o + e] = 0.f; Kl[o + e] = 0.f; Vl[o + e] = 0.f; gcur[e] = 0.f; }
                *(LAS u32x4*)(Rb + tt * LDB + 8 * part) = (u32x4){0u, 0u, 0u, 0u};
            }
        }
        RW_PREFETCH(tb + TB);
        __syncthreads();
        {
            const int kk_ = tid & 63, sg_ = tid >> 6;
            float bin[8], kin[8];
            {
                unsigned vt[4];
#pragma unroll
                for (int e = 0; e < 8; ++e) { const int o_ = (8 * sg_ + e) * LD + kk_; bin[e] = Bl[o_]; kin[e] = Kl[o_]; const unsigned vb_ = f2bf(Vl[o_]); if (e & 1) vt[e >> 1] |= vb_ << 16; else vt[e >> 1] = vb_; }
                *(LAS u32x4*)(VTb + kk_ * LDB + 8 * sg_) = (u32x4){vt[0], vt[1], vt[2], vt[3]};
            }
            __syncthreads();
            float wseg[8]; float wc = 1.f;
#pragma unroll
            for (int e = 0; e < 8; ++e) wseg[e] = Wl[(8 * sg_ + e) * LD + kk_];
            if (sg_ & 1) {
#pragma unroll
                for (int e = 0; e < 8; ++e) wc *= Wl[(8 * (sg_ - 1) + e) * LD + kk_];
            }
            unsigned bt[4], kt4[4];
#pragma unroll
            for (int e = 0; e < 8; ++e) { const int o_ = (8 * sg_ + e) * LD + kk_; const int ob_ = (8 * sg_ + e) * LDB + kk_;
                const float av = Al[o_] * wc; wc *= wseg[e]; const float iw = __builtin_amdgcn_rcpf(wc); const float bv = bin[e] * iw, kv = kin[e] * iw, rv = bf2f(Rb[ob_]) * wc;
                const unsigned bb_ = f2bf(bv), kb_ = f2bf(kv);
                Ab[ob_] = (bf16_t)f2bf(av); Rb[ob_] = (bf16_t)f2bf(rv); Bb[ob_] = (bf16_t)bb_; Kb[ob_] = (bf16_t)kb_;
                if (e & 1) { bt[e >> 1] |= bb_ << 16; kt4[e >> 1] |= kb_ << 16; } else { bt[e >> 1] = bb_; kt4[e >> 1] = kb_; } }
            *(LAS u32x4*)(BTb + kk_ * LDB + 8 * sg_) = (u32x4){bt[0], bt[1], bt[2], bt[3]};
            *(LAS u32x4*)(KTb + kk_ * LDB + 8 * sg_) = (u32x4){kt4[0], kt4[1], kt4[2], kt4[3]};
            if (sg_ & 1) WCl[(sg_ >> 1) * 64 + kk_] = wc;
        }
        __syncthreads();
        {
            const int gc = w >> 1, mt = w & 1; const int t0 = 16 * gc;
            const LAS bf16_t* pa = (mt ? Rb : Ab) + (t0 + c) * LDB + 8 * q;
            const bf16x8 a0 = *(const LAS bf16x8*)pa, a1 = *(const LAS bf16x8*)(pa + 32);
#pragma unroll
            for (int nt = 0; nt < 2; ++nt) {
                const LAS bf16_t* pb = (nt ? Kb : Bb) + (t0 + c) * LDB + 8 * q;
                const bf16x8 b0 = *(const LAS bf16x8*)pb, b1 = *(const LAS bf16x8*)(pb + 32);
                f32x4 g = __builtin_amdgcn_mfma_f32_16x16x32_bf16(a0, b0, (f32x4){0.f, 0.f, 0.f, 0.f}, 0, 0, 0);
                g = __builtin_amdgcn_mfma_f32_16x16x32_bf16(a1, b1, g, 0, 0, 0);
#pragma unroll
                for (int r = 0; r < 4; ++r) { const int t = 4 * q + r; const bool keep = mt ? (c <= t) : (c < t); const float gv = keep ? g[r] : 0.f;
                    if (mt) ((LAS bf16_t*)(GL + gc * 32 * LDG + (16 + t) * LDG))[16 * nt + c] = (bf16_t)f2bf(gv);
                    else { GL[gc * 32 * LDG + t * LDG + 16 * nt + c] = gv; if (nt == 1) LKb[(gc * 16 + t) * LDK + c] = (bf16_t)f2bf(gv); } }
            }
        }
        __syncthreads();
        if (w == 0) {
            float tr[16];
            const LAS float* Lg = GL + q * 32 * LDG;
#pragma unroll
            for (int t = 0; t < 16; ++t) { float acc = (t == c) ? 1.f : 0.f;
#pragma unroll
                for (int i = 0; i < t; ++i) acc += Lg[t * LDG + i] * tr[i];
                tr[t] = acc; TL[q * 16 * LDT + t * LDT + c] = acc; Tbb[(q * 16 + t) * LDK + c] = (bf16_t)f2bf(acc); }
        }
#pragma unroll
        for (int e = 0; e < 2; ++e)
#pragma unroll
            for (int r = 0; r < 4; ++r) Sb[(16 * rt + 4 * q + r) * LDB + 16 * (2 * kh + e) + c] = (bf16_t)f2bf(st[e][r]);
        if (PUB) asm volatile("s_waitcnt vmcnt(0)" ::: "memory");
        __syncthreads();
        if (PUB && tid == 0 && tb > 0) __hip_atomic_store(prog, (unsigned)tb, __ATOMIC_RELAXED, __HIP_MEMORY_SCOPE_AGENT);
        for (int ch = 0; ch < nch; ++ch) {
            const int t0 = 16 * ch;
            const int xm = w >> 2, nt = w & 3;
            f32x4 x;
            {
                const LAS bf16_t* xa = (xm ? Rb : Ab) + (t0 + c) * LDB + 8 * q; const LAS bf16_t* xs = Sb + (16 * nt + c) * LDB + 8 * q;
                const bf16x8 a0 = *(const LAS bf16x8*)xa, a1 = *(const LAS bf16x8*)(xa + 32), s0 = *(const LAS bf16x8*)xs, s1 = *(const LAS bf16x8*)(xs + 32);
                x = __builtin_amdgcn_mfma_f32_16x16x32_bf16(a0, s0, (f32x4){0.f, 0.f, 0.f, 0.f}, 0, 0, 0);
                x = __builtin_amdgcn_mfma_f32_16x16x32_bf16(a1, s1, x, 0, 0, 0);
            }
            const LAS float* Gc = GL + ch * 32 * LDG;
            if (xm == 0) {
                typedef short s16x4_t __attribute__((ext_vector_type(4)));
                const s16x4_t lkf = *(const LAS s16x4_t*)(LKb + (ch * 16 + c) * LDK + 4 * q), vtf = *(const LAS s16x4_t*)(VTb + (16 * nt + c) * LDB + t0 + 4 * q);
                const s16x4_t tbf = *(const LAS s16x4_t*)(Tbb + (ch * 16 + c) * LDK + 4 * q);
                x = __builtin_amdgcn_mfma_f32_16x16x16bf16_1k(lkf, vtf, x, 0, 0, 0);
                const unsigned rh0 = pk2(x[0], x[1]), rh1 = pk2(x[2], x[3]);
                const s16x4_t rhf = __builtin_bit_cast(s16x4_t, (u32x2){rh0, rh1});
                f32x4 u = __builtin_amdgcn_mfma_f32_16x16x16bf16_1k(tbf, rhf, (f32x4){0.f, 0.f, 0.f, 0.f}, 0, 0, 0);
                *(LAS u32x2*)(UTb + (16 * nt + c) * LDU + 4 * q) = (u32x2){pk2(u[0], u[1]), pk2(u[2], u[3])};
            }
            __syncthreads();
            if (xm == 1) {
                typedef short s16x4_t __attribute__((ext_vector_type(4)));
                const LAS bf16_t* mrow = (const LAS bf16_t*)(Gc + (16 + c) * LDG) + 4 * q;
                const s16x4_t mbf = *(const LAS s16x4_t*)mrow, mkf = *(const LAS s16x4_t*)(mrow + 16);
                const s16x4_t utf = *(const LAS s16x4_t*)(UTb + (16 * nt + c) * LDU + 4 * q), vtf = *(const LAS s16x4_t*)(VTb + (16 * nt + c) * LDB + t0 + 4 * q);
                x = __builtin_amdgcn_mfma_f32_16x16x16bf16_1k(mbf, utf, x, 0, 0, 0);
                x = __builtin_amdgcn_mfma_f32_16x16x16bf16_1k(mkf, vtf, x, 0, 0, 0);
#pragma unroll
                for (int r = 0; r < 4; ++r) Yl[(t0 + 4 * q + r) * LD + 16 * nt + c] = x[r];
            }
            {
                const LAS bf16_t* pf = (q < 2) ? UTb + (16 * rt + c) * LDU + 8 * q : VTb + (16 * rt + c) * LDB + t0 + 8 * (q - 2);
                const bf16x8 uvf = *(const LAS bf16x8*)pf;
#pragma unroll
                for (int e = 0; e < 2; ++e) {
                    const int kt = 2 * kh + e;
                    const LAS bf16_t* ps = (q < 2) ? BTb + (16 * kt + c) * LDB + t0 + 8 * q : KTb + (16 * kt + c) * LDB + t0 + 8 * (q - 2);
                    const bf16x8 bkf = *(const LAS bf16x8*)ps;
                    st[e] = __builtin_amdgcn_mfma_f32_16x16x32_bf16(uvf, bkf, st[e], 0, 0, 0);
                    const float wcv = WCl[ch * 64 + 16 * kt + c];
                    st[e] = st[e] * wcv;
                }
            }
            if (BAT) {
#pragma unroll
                for (int e = 0; e < 2; ++e)
#pragma unroll
                    for (int r = 0; r < 4; ++r) Sout[(size_t)ch * sstride + (size_t)(16 * rt + 4 * q + r) * 64 + 16 * (2 * kh + e) + c] = st[e][r];
                if (ch + 1 < nch) {
#pragma unroll
                    for (int e = 0; e < 2; ++e)
#pragma unroll
                        for (int r = 0; r < 4; ++r) st[e][r] = S0[(size_t)(ch + 1) * sstride + (size_t)(16 * rt + 4 * q + r) * 64 + 16 * (2 * kh + e) + c];
                }
            }
            if (ch + 1 < nch) {
#pragma unroll
                for (int e = 0; e < 2; ++e)
#pragma unroll
                    for (int r = 0; r < 4; ++r) Sb[(16 * rt + 4 * q + r) * LDB + 16 * (2 * kh + e) + c] = (bf16_t)f2bf(st[e][r]);
            }
            __syncthreads();
        }
        if (BAT ? ((tt & 15) < DS) : (tt < nvt)) {
            const size_t row = BAT ? (size_t)(rowbase + (tt >> 4) * DS + (tt & 15)) : (size_t)(rowbase + tb + tt);
            float y[8]; float s = 0.f;
#pragma unroll
            for (int e = 0; e < 8; ++e) { y[e] = Yl[tt * LD + 8 * part + e]; s += y[e]; }
            s += __shfl_xor(s, 1); s += __shfl_xor(s, 2); s += __shfl_xor(s, 4);
            const float mu = s * (1.f / 64.f); float s2 = 0.f;
#pragma unroll
            for (int e = 0; e < 8; ++e) { y[e] -= mu; s2 += y[e] * y[e]; }
            s2 += __shfl_xor(s2, 1); s2 += __shfl_xor(s2, 2); s2 += __shfl_xor(s2, 4);
            const float rstd = 1.0f / sqrtf(s2 * (1.f / 64.f) + GN_EPS);
            float o[8];
            const float cb = CBl[tt];
#pragma unroll
            for (int e = 0; e < 8; ++e) o[e] = (y[e] * rstd * clg[e] + clb[e] + cb * Vl[tt * LD + 8 * part + e]) * gcur[e];
            if (PUB) { const u32x4 yv = pack8(o); const bf16_t* yp = ycat + row * D + hk; asm volatile("global_store_dwordx4 %0, %1, off sc1" :: "v"(yp), "v"(yv) : "memory"); }
            else *(GAS u32x4*)(ycat + row * D + hk) = pack8(o);
        }
    }
#undef RW_PREFETCH
    if (!BAT)
#pragma unroll
    for (int e = 0; e < 2; ++e)
#pragma unroll
        for (int r = 0; r < 4; ++r) Sout[(size_t)(16 * rt + 4 * q0 + r) * 64 + 16 * (2 * kh + e) + c0] = st[e][r];
    if (PUB) asm volatile("s_waitcnt vmcnt(0)" ::: "memory");
    __syncthreads();
    if (PUB && tid == 0) __hip_atomic_store(prog, (unsigned)T, __ATOMIC_RELAXED, __HIP_MEMORY_SCOPE_AGENT);
}
__global__ void __launch_bounds__(NTHREADS, 2) mega_fwd(Args args) {
    extern __shared__ __attribute__((aligned(16))) unsigned char lds_raw[];
    Frame F;
    F.lds = (LAS unsigned char*)lds_raw;
    F.out = args.out; F.ws = args.ws;
    F.tid = threadIdx.x; F.lane = F.tid & 63; F.wave = __builtin_amdgcn_readfirstlane(F.tid >> 6);
    F.G = gridDim.x; { const int bx = blockIdx.x; const int vcu = (F.G % 8 == 0) ? (bx % 8) * (F.G / 8) + bx / 8 : bx; F.gw = vcu * NWAVES + F.wave; }
    F.NGW = F.G * NWAVES;
    volatile LAS unsigned* MISC = (volatile LAS unsigned*)(F.lds + MISC_OFF);
    for (int u = F.tid; u < (LDS_BYTES - LDSCTL_OFF) / 4; u += NTHREADS) ((LAS unsigned*)(F.lds + LDSCTL_OFF))[u] = 0u;
    __syncthreads();
    unsigned* ctl = (unsigned*)(F.ws + WS_CTL);
    XcdBarrier bar = xcd_barrier_post(ctl + CW_BAR, MISC + 8);
    const int lo = args.ph_lo, hi = args.ph_hi;
#ifndef PHASE_MASK
#define PHASE_MASK 0x1ffffu
#endif
#define IN(k) (((PHASE_MASK >> (k)) & 1u) && lo <= (k) && (k) < hi)
#define SEAM(k) do { if (IN(k) && IN((k) + 1)) xcd_barrier(bar); } while (0)
#ifndef DUP_MASK
#define DUP_MASK 0u
#endif
#define RUNPH(k, ...) if (IN(k)) { __VA_ARGS__; if ((DUP_MASK >> (k)) & 1u) { xcd_barrier(bar); __VA_ARGS__; } }

    const int vcu = F.gw >> 3;
    unsigned char* ws = F.ws;
    RUNPH(0, { p0_prologue(F, args); __syncthreads(); p0_rows(F, args); })
    SEAM(0);
    RUNPH(1, pg8::gemm_phase<1u << pg8::EM_BF16>(F.lds, c_ph[0], ws, args.in[I_W0], args.in[I_A0], F.G, (int)blockIdx.x, ctl + CW_SPLIT + 1 * 256, MISC + 16);)
    SEAM(1);
    RUNPH(2, {    \
        if (vcu < 128) { mlstm_prompt_job(F, args, vcu); } \
        else { for (int j = vcu - 128; j < 384; j += 128) { if (j < 128) rglru_job(F, args, 0, j >> 5, (j >> 2) & 7, j & 3); else { const int k = j - 128; rglru_job(F, args, 1, k >> 5, (k >> 2) & 7, k & 3); } } \
               for (int j = vcu - 128; j < DB * NHA; j += 128) mlstm_sample_job(F, args, j); } \
    })
    SEAM(2);
    RUNPH(3, headnorm_pass(F, args);)
    SEAM(3);
    RUNPH(4, { pg8::gemm_phase<1u << pg8::EM_RESID>(F.lds, c_ph[1], ws, args.in[I_W0], args.in[I_A0], F.G, (int)blockIdx.x, ctl + CW_SPLIT + 4 * 256, MISC + 16); \
        constexpr int BUSY4 = ((MP / 256) * (D / 256) - 256) * 4;       \
        if ((int)blockIdx.x >= BUSY4) { Frame F2 = F; F2.gw = ((int)blockIdx.x - BUSY4) * NWAVES + F.wave; F2.NGW = (F.G - BUSY4) * NWAVES; int cursor = 0; convert_wup(F2, args, 0, cursor, (LAS float*)(F.lds + F.wave * 16896)); } })
    SEAM(4);
    RUNPH(5, ln_pass(F, (const bf16_t*)(ws + WS_ZRES), args.in[I_LN1G], args.in[I_LN1B], (bf16_t*)(ws + WS_HA));)
    SEAM(5);
    RUNPH(6, { pg8::gemm_phase<1u << pg8::EM_RELU2>(F.lds, c_ph[2], ws, args.in[I_W0], args.in[I_A0], F.G, (int)blockIdx.x, ctl + CW_SPLIT + 6 * 256, MISC + 16); \
        constexpr int BUSY6 = (MP / 256) * (DFF / 256) - 4 * 256;       \
        if ((int)blockIdx.x >= BUSY6) { Frame F2 = F; F2.gw = ((int)blockIdx.x - BUSY6) * NWAVES + F.wave; F2.NGW = (F.G - BUSY6) * NWAVES; int cursor = 0; convert_wdn(F2, args, 0, cursor, (LAS float*)(F.lds + F.wave * 16896)); } })
    SEAM(6);
    RUNPH(7, { pg8::gemm_phase<1u << pg8::EM_RESID>(F.lds, c_ph[3], ws, args.in[I_W0], args.in[I_A0], F.G, (int)blockIdx.x, ctl + CW_SPLIT + 7 * 256, MISC + 16); \
        constexpr int BUSY = ((MP / 256) * (D / 256) - 256) * 4;        \
        if ((int)blockIdx.x >= BUSY) { Frame F2 = F; F2.gw = ((int)blockIdx.x - BUSY) * NWAVES + F.wave; F2.NGW = (F.G - BUSY) * NWAVES; convert_rwkv_weights(F2, args, (LAS float*)(F.lds + F.wave * 16896)); } })
    SEAM(7);
    RUNPH(8, ln_mix_pass(F, args, (const bf16_t*)(ws + WS_ZRES), args.in[I_LN2G], args.in[I_LN2B]);)
    SEAM(8);
    RUNPH(9, pg8::gemm_phase<(1u << pg8::EM_BF16) | (1u << pg8::EM_TANH) | (1u << pg8::EM_SIGM)>(F.lds, c_ph[4], ws, args.in[I_W0], args.in[I_A0], F.G, (int)blockIdx.x, ctl + CW_SPLIT + 9 * 256, MISC + 16);)
    SEAM(9);
    RUNPH(10, pg8::gemm_phase<(1u << pg8::EM_BF16) | (1u << pg8::EM_WDEC) | (1u << pg8::EM_ASIG)>(F.lds, c_ph[5], ws, args.in[I_W0], args.in[I_A0], F.G, (int)blockIdx.x, ctl + CW_SPLIT + 10 * 256, MISC + 16);)
    SEAM(10);
    RUNPH(11, {   \
        const int rep_a = ((DUP_MASK >> 17) & 1u) ? 2 : 1; const int rep_b = ((DUP_MASK >> 18) & 1u) ? 2 : 1; \
        if (vcu < NB * NHC) { const int bb = vcu >> 5; const int h = vcu & 31; for (int rep = 0; rep < rep_a; ++rep) rwkv_job_c<true>(F, args, bb * TP, TP, h, nullptr, F.out + O_PS + (size_t)(bb * NHC + h) * HDC * HDC, ctl + CW_PROG + vcu); } \
        else { for (int rep = 0; rep < rep_b; ++rep) for (int j = vcu - NB * NHC; j < (DB / 4) * NHC; j += F.G - NB * NHC) { const int bb = 4 * (j >> 5); const int h = j & 31; \
            rwkv_job_c<false, true>(F, args, MPR + bb * DS, 64, h, args.in[I_RS] + (size_t)(bb * NHC + h) * HDC * HDC, F.out + O_SS + (size_t)(bb * NHC + h) * HDC * HDC, nullptr, (size_t)NHC * HDC * HDC); } \
              \
            asm volatile("s_waitcnt vmcnt(0)" ::: "memory"); __syncthreads(); \
            if (F.tid == 0) { __builtin_amdgcn_fence(__ATOMIC_RELEASE, "agent"); asm volatile("s_waitcnt vmcnt(0)" ::: "memory"); __hip_atomic_fetch_add(ctl + CW_PROG + 256, 1u, __ATOMIC_RELAXED, __HIP_MEMORY_SCOPE_AGENT); } \
            Frame F2 = F; F2.gw = (vcu - NB * NHC) * NWAVES + F.wave; F2.NGW = (F.G - NB * NHC) * NWAVES; int cursor = 0; \
            convert_wup(F2, args, 1, cursor, (LAS float*)(F.lds + F.wave * 16896)); \
            __syncthreads(); \
            pg8::gemm_phase<1u << pg8::EM_RESID, 1>(F.lds, c_ph[7], ws, args.in[I_W0], args.in[I_A0], F.G - NB * NHC, vcu - NB * NHC, ctl + CW_SPLIT + 11 * 256, MISC + 16, ctl + CW_PROG); } \
    })
    SEAM(11);
    RUNPH(12, { pg8::gemm_phase<1u << pg8::EM_RESID>(F.lds, c_ph[6], ws, args.in[I_W0], args.in[I_A0], F.G, (int)blockIdx.x, ctl + CW_SPLIT + 12 * 256, MISC + 16); \
        constexpr int BUSY12 = pg8::N_LATE * (D / 256);                \
        if ((int)blockIdx.x >= BUSY12) { Frame F2 = F; F2.gw = ((int)blockIdx.x - BUSY12) * NWAVES + F.wave; F2.NGW = (F.G - BUSY12) * NWAVES; int cursor = 0; \
            convert_wdn(F2, args, 1, cursor, (LAS float*)(F.lds + F.wave * 16896)); } })
    SEAM(12);
    RUNPH(13, ln_pass(F, (const bf16_t*)(ws + WS_ZRES), args.in[I_LN1G] + D, args.in[I_LN1B] + D, (bf16_t*)(ws + WS_HA));)
    SEAM(13);
    RUNPH(14, pg8::gemm_phase<1u << pg8::EM_RELU2>(F.lds, c_ph[2], ws, args.in[I_W0], args.in[I_A0], F.G, (int)blockIdx.x, ctl + CW_SPLIT + 14 * 256, MISC + 16);)
    SEAM(14);
    RUNPH(15, pg8::gemm_phase<1u << pg8::EM_RESID>(F.lds, c_ph[3], ws, args.in[I_W0], args.in[I_A0], F.G, (int)blockIdx.x, ctl + CW_SPLIT + 15 * 256, MISC + 16);)
    SEAM(15);
    RUNPH(16, ln_final(F, (const bf16_t*)(ws + WS_ZRES), args.in[I_LN2G] + D, args.in[I_LN2B] + D);)
#undef IN
#undef SEAM
}

constexpr int N_PHASES = 17;
extern "C" void kernel_launch(void* const* d_in, const int* in_sizes, int n_in, void* d_out, int out_size, void* d_ws, size_t ws_size, hipStream_t stream) {
    static int grid = 0;
    if (grid == 0) {
        if (n_in != N_IN || (size_t)out_size != O_END || ws_size < WS_END) { fprintf(stderr, "kernel_launch: unexpected sizes n_in %d out %d ws %zu (need %zu)\n", n_in, out_size, ws_size, (size_t)WS_END); grid = -1; return; }
        int dev = 0, cus = 0;
        if (hipGetDevice(&dev) != hipSuccess || hipDeviceGetAttribute(&cus, hipDeviceAttributeMultiprocessorCount, dev) != hipSuccess) { grid = -1; return; }
        if (hipFuncSetAttribute((const void*)mega_fwd, hipFuncAttributeMaxDynamicSharedMemorySize, LDS_BYTES) != hipSuccess) { fprintf(stderr, "kernel_launch: hipFuncSetAttribute failed\n"); grid = -1; return; }
        grid = cus;
    }
    if (grid < 0) return;
    (void)hipMemsetAsync((char*)d_ws + WS_CTL, 0, CTL_ZERO_BYTES, stream);
    Args a{};
    for (int i = 0; i < N_IN; ++i) a.in[i] = (const float*)d_in[i];
    a.out = (float*)d_out; a.ws = (unsigned char*)d_ws;
    a.ph_lo = 0; a.ph_hi = N_PHASES;
    hipLaunchKernelGGL(mega_fwd, dim3(grid), dim3(NTHREADS), LDS_BYTES, stream, a);
}
```

```cpp
#include <hip/hip_runtime.h>
#include <cstdio>
#include <cstdint>

#define GAS __attribute__((address_space(1)))
#define LAS __attribute__((address_space(3)))
typedef unsigned short bf16_t;
typedef short bf16x8 __attribute__((ext_vector_type(8)));
typedef short s16x4 __attribute__((ext_vector_type(4)));
typedef float f32x4 __attribute__((ext_vector_type(4)));
typedef float f32x2 __attribute__((ext_vector_type(2)));
typedef unsigned u32x4 __attribute__((ext_vector_type(4)));
typedef unsigned u32x2 __attribute__((ext_vector_type(2)));

constexpr int D = 2048, NB = 4, SEQ = 2048, NMETA = 16, TP = SEQ + NMETA  , DB = 128, DS = 8;
constexpr int MPR = NB * TP  , MSA = DB * DS  , M = MPR + MSA  , MP = 9472  ;
constexpr int NHA = 4, HDA = 256, MIXA = 1024, RGW = 1024, PROJ = 6152, NZ = 6144, DFF = 8192;
constexpr int NHC = 32, HDC = 64;
constexpr float ALPHA = 1.4142135623730951f;
constexpr float LN_EPS = 1e-5f, GN_EPS = 64e-5f;
constexpr int NWAVES = 8, NTHREADS = 512;

constexpr size_t O_YP = 0, O_YS = O_YP + (size_t)NB * SEQ * D, O_PC = O_YS + (size_t)DB * DS * D, O_PN = O_PC + (size_t)NB * NHA * HDA * HDA,
                 O_PM = O_PN + (size_t)NB * NHA * HDA, O_PH = O_PM + NB * NHA, O_PCV = O_PH + (size_t)NB * RGW, O_PS = O_PCV + (size_t)NB * 3 * RGW,
                 O_PX = O_PS + (size_t)NB * NHC * HDC * HDC, O_SC = O_PX + (size_t)NB * D, O_SN = O_SC + (size_t)DB * NHA * HDA * HDA,
                 O_SM = O_SN + (size_t)DB * NHA * HDA, O_SH = O_SM + DB * NHA, O_SCV = O_SH + (size_t)DB * RGW, O_SS = O_SCV + (size_t)DB * 3 * RGW,
                 O_SX = O_SS + (size_t)DB * NHC * HDC * HDC, O_END = O_SX + (size_t)DB * D;
static_assert(O_END == 71725584, "output size");

enum { I_XP = 0, I_XS, I_MC, I_MN, I_MM, I_RH, I_RC, I_RS, I_RX, I_META, I_WIN, I_BIF, I_MNG, I_CVW, I_CVB, I_WA, I_BA, I_WX, I_BX, I_LAM, I_WOUT,
       I_MU, I_WR, I_WK, I_WV, I_WO, I_W0, I_W1, I_W2, I_A0, I_A1, I_A2, I_G1, I_G2, I_KK, I_KA, I_RK, I_LNXG, I_LNXB, I_LN1G, I_LN1B, I_LN2G, I_LN2B, I_WUP, I_WDN, N_IN };
static_assert(N_IN == 45, "inputs");

constexpr size_t MiB = 1u << 20;
constexpr size_t U37 = (size_t)MP * D * 2;
constexpr size_t WS_CTL = 0, CTL_ZERO_BYTES = 1 * MiB;
constexpr size_t WS_WIN = 1 * MiB;
constexpr size_t WS_WOUT = WS_WIN + 24 * MiB;
constexpr size_t WS_WR = WS_WOUT + 8 * MiB, WS_WK = WS_WR + 8 * MiB, WS_WV = WS_WK + 8 * MiB, WS_WO = WS_WV + 8 * MiB;
constexpr size_t WS_L1 = WS_WO + 8 * MiB;
constexpr size_t WS_L2 = WS_L1 + 3 * MiB;
constexpr size_t WS_WUP = WS_L2 + 3 * MiB;
constexpr size_t WS_WDN = WS_WUP + 32 * MiB;
constexpr size_t WS_ZRES = WS_WDN + 32 * MiB;
constexpr size_t WS_HA = WS_ZRES + U37, WS_HB = WS_HA + U37;
constexpr size_t WS_GATES = WS_HB + U37;
constexpr size_t WS_BIG = WS_GATES + 1 * MiB;
constexpr size_t WS_X0 = WS_BIG, WS_ZIN = WS_X0 + U37, WS_HM = WS_ZIN + (size_t)MP * NZ * 2, WS_CAT = WS_HM + (size_t)MP * MIXA * 2;
constexpr size_t WS_U = WS_BIG;
constexpr size_t WS_XS = WS_BIG;
constexpr size_t WS_RKV = WS_XS + 6 * U37;
constexpr size_t WS_LO1 = WS_RKV + 3 * U37;
constexpr size_t WS_WDEC = WS_XS;
constexpr size_t WS_AG = WS_WDEC + 2 * U37;
constexpr size_t WS_GG = WS_AG + U37;
constexpr size_t WS_YCAT = WS_GG + U37;
constexpr size_t WS_END = WS_LO1 + 3 * (size_t)MP * 256 * 2;
constexpr size_t WS_SLAB = WS_RKV;
static_assert(240 * (size_t)262144 <= 3 * U37, "slab overlay");
static_assert(WS_YCAT + U37 <= WS_RKV, "overlay");
static_assert(WS_CAT + U37 <= WS_END && WS_U + (size_t)MP * DFF * 2 <= WS_END, "big region");

constexpr int CW_BAR = 4096;
constexpr int CW_SPLIT = 16384;
constexpr int CW_PROG = 24576;

__device__ __forceinline__ unsigned f2bf(float f) { unsigned u = __builtin_bit_cast(unsigned, f); return (u + 0x7fffu + ((u >> 16) & 1u)) >> 16; }
__device__ __forceinline__ unsigned pk2(float lo, float hi) { return f2bf(lo) | (f2bf(hi) << 16); }
__device__ __forceinline__ float bf2f(unsigned short b) { return __builtin_bit_cast(float, (unsigned)b << 16); }
__device__ __forceinline__ float bflo(unsigned w) { return __builtin_bit_cast(float, w << 16); }
__device__ __forceinline__ float bfhi(unsigned w) { return __builtin_bit_cast(float, w & 0xffff0000u); }
typedef __bf16 bf16x2_hw __attribute__((ext_vector_type(2)));
__device__ __forceinline__ unsigned cvt_pk_bf16(float lo, float hi) { const f32x2 v = {lo, hi}; const bf16x2_hw b = __builtin_convertvector(v, bf16x2_hw); return __builtin_bit_cast(unsigned, b); }
__device__ __forceinline__ void lds_barrier() { asm volatile("s_waitcnt lgkmcnt(0)" ::: "memory"); __builtin_amdgcn_s_barrier(); asm volatile("" ::: "memory"); }
__device__ __forceinline__ float wave_sum(float v) {
#pragma unroll
    for (int o = 1; o < 64; o <<= 1) v += __shfl_xor(v, o);
    return v;
}
__device__ __forceinline__ float sigmoidf_(float x) { return __builtin_amdgcn_rcpf(1.0f + __expf(-x)); }
__device__ __forceinline__ float softplusf_(float x) { return fmaxf(x, 0.f) + __logf(1.0f + __expf(-fabsf(x))); }
__device__ __forceinline__ float sigm3_(float x) { return __builtin_amdgcn_rcpf(1.0f + __expf(-x)); }
__device__ __forceinline__ float wdecayf_(float x) { return __expf(-0.6065306597126334f * sigm3_(x)); }
__device__ __forceinline__ float tanhf_(float x) { const float e = __expf(2.0f * x); return 1.0f - 2.0f * __builtin_amdgcn_rcpf(e + 1.0f); }
#define LDS_WAIT() asm volatile("s_waitcnt lgkmcnt(0)" ::: "memory")
#define VM_WAIT() asm volatile("s_waitcnt vmcnt(0)" ::: "memory")

#define XB_TMO      128
#define XB_XCNT(j)  (256  + 64 * (j))
#define XB_XSUB(j)  (1280 + 64 * (j))
#define XB_XGEN(j)  (2304 + 64 * (j))
#define XB_TOP      3328
#define XB_TOPGEN   3392
#define XCD_BAR_WORDS 3456
#define XB_SPIN_CAP (1u << 18)
__device__ __forceinline__ unsigned xb_ld(unsigned* p)              { return __hip_atomic_load(p, __ATOMIC_RELAXED, __HIP_MEMORY_SCOPE_AGENT); }
__device__ __forceinline__ unsigned xb_add(unsigned* p, unsigned v) { return __hip_atomic_fetch_add(p, v, __ATOMIC_RELAXED, __HIP_MEMORY_SCOPE_AGENT); }
__device__ __forceinline__ unsigned xb_xcc_id() { return (unsigned)__builtin_amdgcn_s_getreg((3 << 11) | 20) & 0xFu; }
#define XB_SPIN(cond, bar) do { unsigned _sp = 0; while (cond) { __builtin_amdgcn_s_sleep(1); \
    if ((++_sp & 255u) == 0u) { if (xb_ld(&(bar)[XB_TMO])) break; if (_sp > XB_SPIN_CAP) { atomicAdd(&(bar)[XB_TMO], 1u); break; } } } } while (0)
struct XcdBarrier { unsigned* bar; unsigned x; volatile LAS unsigned* st; };
__device__ __forceinline__ XcdBarrier xcd_barrier_post(unsigned* bar, volatile LAS unsigned* st) {
    XcdBarrier b; b.bar = bar; b.x = xb_xcc_id(); b.st = st;
    if (threadIdx.x == 0) (void)xb_add(&bar[XB_XCNT(b.x)], 1u);
    return b;
}
__device__ __forceinline__ void xcd_barrier_complete(unsigned* bar, unsigned x, unsigned& nloc, unsigned& nx) {
    const unsigned G = gridDim.x * gridDim.y * gridDim.z;
    unsigned sum, cnt, mine, sp = 0u;
    for (;;) {
        sum = 0u; cnt = 0u; mine = 0u;
#pragma unroll
        for (unsigned j = 0; j < 16; ++j) { const unsigned c = xb_ld(&bar[XB_XCNT(j)]); sum += c; cnt += (c > 0u) ? 1u : 0u; mine = (j == x) ? c : mine; }
        if (sum == G) break;
        __builtin_amdgcn_s_sleep(1);
        if ((++sp & 255u) == 0u) { if (xb_ld(&bar[XB_TMO])) break; if (sp > XB_SPIN_CAP) { atomicAdd(&bar[XB_TMO], 1u); break; } }
    }
    nloc = mine > 0u ? mine : 1u; nx = cnt > 0u ? cnt : 1u;
}
__device__ __forceinline__ void xcd_barrier(const XcdBarrier& b) {
    asm volatile("s_waitcnt vmcnt(0)" ::: "memory");
    __syncthreads();
    if (threadIdx.x == 0) {
        unsigned* bar = b.bar;
        __builtin_amdgcn_s_waitcnt(0);
        unsigned nloc = b.st[0], nx = b.st[1];
        if (nloc == 0u) { xcd_barrier_complete(bar, b.x, nloc, nx); b.st[0] = nloc; b.st[1] = nx; }
        const unsigned old = xb_add(&bar[XB_XSUB(b.x)], 1u);
        const unsigned gen = old / nloc;
        if (old + 1u == (gen + 1u) * nloc) {
            __builtin_amdgcn_fence(__ATOMIC_RELEASE, "agent");
            asm volatile("s_waitcnt vmcnt(0)" ::: "memory");
            const unsigned og = xb_add(&bar[XB_TOP], 1u);
            const unsigned tg = og / nx;
            if (og + 1u == (tg + 1u) * nx) xb_add(&bar[XB_TOPGEN], 1u);
            else XB_SPIN(xb_ld(&bar[XB_TOPGEN]) == tg, bar);
            __builtin_amdgcn_fence(__ATOMIC_ACQUIRE, "agent");
            xb_add(&bar[XB_XGEN(b.x)], 1u);
            asm volatile("s_waitcnt vmcnt(0)" ::: "memory");
        } else {
            XB_SPIN(xb_ld(&bar[XB_XGEN(b.x)]) == gen, bar);
            __builtin_amdgcn_fence(__ATOMIC_ACQUIRE, "agent");
            asm volatile("s_waitcnt vmcnt(0)" ::: "memory");
        }
    }
    __syncthreads();
}

namespace pg8 {
constexpr int BM = 256, BK = 64, HALF = 128, HTB = HALF * BK * 2, STAGE_BYTES = 8 * HTB, NXCD = 8, WGM = 8;
__host__ __device__ __forceinline__ int lds_byte(int r, int c) { const int st = (r >> 4) * 2 + (c >> 5), rr = r & 15, cc = c & 31, ob = rr * 64 + cc * 2; return st * 1024 + (ob ^ (((ob >> 9) & 1) << 5)); }
__host__ __device__ __forceinline__ void stage_rc(int b, int& R, int& C) { const int st = b / 1024, sb = b % 1024, swz = sb ^ (((sb >> 9) & 1) << 5); R = (st >> 1) * 16 + swz / 64; C = (st & 1) * 32 + (swz % 64) / 2; }
__host__ __device__ __forceinline__ int perm32(int rho) { const int n = rho >> 4, i = rho & 15; return 8 * (i >> 2) + 4 * n + (i & 3); }

struct Unit { int pm, pn, job, split, kpart, tail; };
enum { EM_BF16 = 0, EM_RELU2 = 1, EM_TANH = 2, EM_SIGM = 3, EM_RESID = 4, EM_WDEC = 5, EM_ASIG = 6 };
struct JobC { unsigned A, B, out, aux; int nN, ldc, mode, pad; };
struct PhaseC { int njobs, K, lda, totN, split, pad0, pad1, pad2; JobC job[6]; };
__constant__ int c_plist[2][32] = {
    {33, 34, 35, 36, 0, 25, 17, 9, 1, 26, 18, 10, 2, 27, 19, 11, 0, 0, 0, 0, 0, 0, 0, 0, 0, 0, 0, 0, 0, 0, 0, 0},
    {3, 28, 20, 12, 4, 29, 21, 13, 5, 30, 22, 14, 6, 7, 8, 15, 16, 23, 24, 31, 32, 0, 0, 0, 0, 0, 0, 0, 0, 0, 0, 0}};
constexpr int N_EARLY = 16, N_LATE = 21;
static_assert(N_EARLY + N_LATE == MP / 256, "panel lists");
struct Order {
    int nwg, G, c;
    __device__ __forceinline__ void init(int nM, int totN, int G_, int c_) { nwg = nM * totN; G = G_; c = c_; }
    __device__ __forceinline__ bool next(const PhaseC& P, int i, Unit& u) const {
        long L = (long)i * G + c;
        const int nfull = (nwg / G) * G, sp = P.split;
        if (L >= nwg && !(sp > 1 && L >= nfull)) return false;
        u.split = 1; u.kpart = 0; u.tail = 0;
        if (sp > 1 && L >= nfull) { const int j = (int)(L - nfull); if (j >= (nwg - nfull) * sp) return false; u.split = sp; u.kpart = j % sp; u.tail = j / sp; L = nfull + j / sp; }
        if (P.pad0) { u.pm = c_plist[P.pad0 - 1][(int)L / P.totN]; u.pn = (int)L % P.totN; u.job = 0; return true; }
        int wgid = (int)L; { const int q = nwg / NXCD, r = nwg % NXCD, xcd = wgid % NXCD, off = wgid / NXCD; wgid = (xcd < r ? xcd * (q + 1) : r * (q + 1) + (xcd - r) * q) + off; }
        const int nM = MP / BM, nN = P.totN;
        const int nig = WGM * nN, gid = wgid / nig, fm = gid * WGM, gsz = (nM - fm) < WGM ? (nM - fm) : WGM;
        u.pm = fm + ((wgid % nig) % gsz); int pnv = (wgid % nig) / gsz; int job = 0;
        while (pnv >= P.job[job].nN) { pnv -= P.job[job].nN; ++job; }
        u.pn = pnv; u.job = job; return true;
    }
};

template <int MODE>
__device__ __forceinline__ void epilogue_mode(const f32x4 (&acc)[2][2][4][2], char* outp, const void* aux, int ldc, int row0, int col0) {
#pragma unroll
    for (int ai = 0; ai < 2; ++ai)
#pragma unroll
        for (int m = 0; m < 4; ++m) {
            const int row = row0 + ai * HALF + m * 16;
#pragma unroll
            for (int bj = 0; bj < 2; ++bj) {
                const int col = col0 + bj * HALF;
                f32x4 v0 = acc[ai][bj][m][0], v1 = acc[ai][bj][m][1];
                if (MODE == EM_WDEC) {
                    const float* w0 = (const float*)aux; const f32x4 b0 = *(const f32x4*)(w0 + col), b1 = *(const f32x4*)(w0 + col + 4);
#pragma unroll
                    for (int j = 0; j < 4; ++j) { v0[j] = wdecayf_(v0[j] + b0[j]); v1[j] = wdecayf_(v1[j] + b1[j]); }
                    float* o = (float*)outp + (size_t)row * ldc + col; *(f32x4*)o = v0; *(f32x4*)(o + 4) = v1;
                } else {
                    if (MODE == EM_RELU2) {
#pragma unroll
                        for (int j = 0; j < 4; ++j) {
                            const float a0 = v0[j], a1 = v1[j]; int i0 = __builtin_bit_cast(int, a0), i1 = __builtin_bit_cast(int, a1); i0 = i0 > 0 ? i0 : 0; i1 = i1 > 0 ? i1 : 0;
                            const float x0 = __builtin_bit_cast(float, i0), x1 = __builtin_bit_cast(float, i1); v0[j] = x0 * x0; v1[j] = x1 * x1; }
                    } else if (MODE == EM_TANH) {
#pragma unroll
                        for (int j = 0; j < 4; ++j) { v0[j] = tanhf_(v0[j]); v1[j] = tanhf_(v1[j]); }
                    } else if (MODE == EM_SIGM) {
#pragma unroll
                        for (int j = 0; j < 4; ++j) { v0[j] = sigmoidf_(v0[j]); v1[j] = sigmoidf_(v1[j]); }
                    } else if (MODE == EM_ASIG) {
                        const float* a0 = (const float*)aux; const f32x4 b0 = *(const f32x4*)(a0 + col), b1 = *(const f32x4*)(a0 + col + 4);
#pragma unroll
                        for (int j = 0; j < 4; ++j) { v0[j] = sigm3_(v0[j] + b0[j]); v1[j] = sigm3_(v1[j] + b1[j]); }
                    } else if (MODE == EM_RESID) {
                        const u32x4 r = *(const u32x4*)((const bf16_t*)aux + (size_t)row * D + col);
                        v0[0] += ALPHA * bflo(r.x); v0[1] += ALPHA * bfhi(r.x); v0[2] += ALPHA * bflo(r.y); v0[3] += ALPHA * bfhi(r.y);
                        v1[0] += ALPHA * bflo(r.z); v1[1] += ALPHA * bfhi(r.z); v1[2] += ALPHA * bflo(r.w); v1[3] += ALPHA * bfhi(r.w);
                    }
                    u32x4 w; w.x = cvt_pk_bf16(v0[0], v0[1]); w.y = cvt_pk_bf16(v0[2], v0[3]); w.z = cvt_pk_bf16(v1[0], v1[1]); w.w = cvt_pk_bf16(v1[2], v1[3]);
                    *(u32x4*)((bf16_t*)outp + (size_t)row * ldc + col) = w;
                }
            }
        }
}
template <int MODE>
__device__ __forceinline__ void epi_frag(f32x4 v0, f32x4 v1, char* outp, const void* aux, int ldc, int row, int col) {
    if (MODE == EM_RESID) {
        const u32x4 r = *(const u32x4*)((const bf16_t*)aux + (size_t)row * D + col);
        v0[0] += ALPHA * bflo(r.x); v0[1] += ALPHA * bfhi(r.x); v0[2] += ALPHA * bflo(r.y); v0[3] += ALPHA * bfhi(r.y);
        v1[0] += ALPHA * bflo(r.z); v1[1] += ALPHA * bfhi(r.z); v1[2] += ALPHA * bflo(r.w); v1[3] += ALPHA * bfhi(r.w);
    }
    u32x4 w; w.x = cvt_pk_bf16(v0[0], v0[1]); w.y = cvt_pk_bf16(v0[2], v0[3]); w.z = cvt_pk_bf16(v1[0], v1[1]); w.w = cvt_pk_bf16(v1[2], v1[3]);
    *(u32x4*)((bf16_t*)outp + (size_t)row * ldc + col) = w;
}
template <unsigned MM>
__device__ __forceinline__ void epilogue(const f32x4 (&acc)[2][2][4][2], const Unit& u, const PhaseC& P, unsigned char* ws, const float* w0p, const float* a0p, int wr, int wc, int fr, int fq) {
    const int mode = P.job[u.job].mode, ldc = P.job[u.job].ldc;
    char* outp = (char*)ws + P.job[u.job].out; const void* aux = (mode == EM_WDEC) ? (const void*)w0p : (mode == EM_ASIG) ? (const void*)a0p : (const void*)(ws + P.job[u.job].aux);
    const int row0 = u.pm * BM + wr * 64 + fr, col0 = u.pn * BM + wc * 32 + 8 * fq;
    if ((MM & (1u << EM_WDEC)) && mode == EM_WDEC) epilogue_mode<EM_WDEC>(acc, outp, aux, ldc, row0, col0);
    else if ((MM & (1u << EM_RELU2)) && mode == EM_RELU2) epilogue_mode<EM_RELU2>(acc, outp, aux, ldc, row0, col0);
    else if ((MM & (1u << EM_TANH)) && mode == EM_TANH) epilogue_mode<EM_TANH>(acc, outp, aux, ldc, row0, col0);
    else if ((MM & (1u << EM_SIGM)) && mode == EM_SIGM) epilogue_mode<EM_SIGM>(acc, outp, aux, ldc, row0, col0);
    else if ((MM & (1u << EM_ASIG)) && mode == EM_ASIG) epilogue_mode<EM_ASIG>(acc, outp, aux, ldc, row0, col0);
    else if ((MM & (1u << EM_RESID)) && mode == EM_RESID) epilogue_mode<EM_RESID>(acc, outp, aux, ldc, row0, col0);
    else epilogue_mode<EM_BF16>(acc, outp, aux, ldc, row0, col0);
}

__device__ __forceinline__ void wait_panel(int pm, const unsigned* prog, int wid, int lane) {
    if (wid == 0) {
        unsigned spins = 0;
        if (pm >= 33) { while (__hip_atomic_load(prog + 256, __ATOMIC_RELAXED, __HIP_MEMORY_SCOPE_AGENT) < 128u && ++spins < (1u << 22)) __builtin_amdgcn_s_sleep(8); }
        else { const int b = (256 * pm) / TP; const unsigned need = (unsigned)(256 * pm + 256 - TP * b);
            for (;;) { const unsigned v = __hip_atomic_load(prog + b * 32 + (lane & 31), __ATOMIC_RELAXED, __HIP_MEMORY_SCOPE_AGENT);
                if (__all(v >= need) || ++spins >= (1u << 22)) break; __builtin_amdgcn_s_sleep(8); } }
        __builtin_amdgcn_fence(__ATOMIC_ACQUIRE, "agent"); asm volatile("s_waitcnt vmcnt(0)" ::: "memory");
    }
    asm volatile("s_waitcnt lgkmcnt(0)" ::: "memory"); __builtin_amdgcn_s_barrier(); asm volatile("" ::: "memory");
}
template <unsigned MM, int WAITA = 0>
__device__ __forceinline__ void gemm_phase(LAS unsigned char* lds, const PhaseC& P, unsigned char* ws, const float* w0p, const float* a0p, int G, int c, unsigned* cntw, volatile LAS unsigned* flagw, const unsigned* prog = nullptr) {
    const int tid = threadIdx.x, wid = __builtin_amdgcn_readfirstlane(tid >> 6), lane = tid & 63, wr = wid >> 2, wc = wid & 3, fr = lane & 15, fq = lane >> 4;
    const int K = P.K, nt = K / BK, lda = P.lda; const size_t kpartB = (size_t)(K / P.split) * 2;
    Order S; S.init(P.pad0 ? P.pad1 : MP / BM, P.totN, G, c);
    unsigned voffA[2], voffB[2];
#pragma unroll
    for (int i = 0; i < 2; ++i) { int R, C; stage_rc(tid * 16 + i * 8192, R, C); const int Rb = (R & ~31) + perm32(R & 31);
        voffA[i] = (unsigned)(R * lda + C) * 2u; voffB[i] = (unsigned)(Rb * K + C) * 2u; }
    const size_t kstep = (size_t)(BK * 2);
    const size_t hstepA = (size_t)HALF * lda * 2, hstepB = (size_t)HALF * K * 2;
    const size_t tstepA = 2 * hstepA, tstepB = 2 * hstepB;
    const unsigned ldsw = (unsigned)wid * 1024u;
    const int aoff = lds_byte(wr * 64 + fr, fq * 8), boff = lds_byte(wc * 32 + fr, fq * 8);
#define PG8_SA(b, h) (((b) * 2 + (h)) * HTB)
#define PG8_SB(b, h) ((4 + (b) * 2 + (h)) * HTB)
#define PG8_STAGE(bufoff, gbase, voff) do { _Pragma("unroll") for (int _i = 0; _i < 2; ++_i) \
        __builtin_amdgcn_global_load_lds((const unsigned*)((const char*)(gbase) + (voff)[_i]), (LAS unsigned*)(lds + (bufoff) + ldsw + _i * 8192), 16, 0, 0); } while (0)
#define PG8_LDA(dst, b, h) do { _Pragma("unroll") for (int m = 0; m < 4; ++m) _Pragma("unroll") for (int k = 0; k < 2; ++k) dst[m][k] = *(const LAS bf16x8*)(lds + PG8_SA(b, h) + aoff + m * 2048 + k * 1024); } while (0)
#define PG8_LDB(dst, b, h) do { _Pragma("unroll") for (int n = 0; n < 2; ++n) _Pragma("unroll") for (int k = 0; k < 2; ++k) dst[n][k] = *(const LAS bf16x8*)(lds + PG8_SB(b, h) + boff + n * 2048 + k * 1024); } while (0)
#define PG8_MMA(ai, bj, At, Bt) do { __builtin_amdgcn_s_setprio(1); _Pragma("unroll") for (int m = 0; m < 4; ++m) _Pragma("unroll") for (int n = 0; n < 2; ++n) _Pragma("unroll") for (int k = 0; k < 2; ++k) \
        acc[ai][bj][m][n] = __builtin_amdgcn_mfma_f32_16x16x32_bf16(Bt[n][k], At[m][k], acc[ai][bj][m][n], 0, 0, 0); __builtin_amdgcn_s_setprio(0); } while (0)
#define PG8_WAIT_V(n) asm volatile("s_waitcnt vmcnt(" #n ")" ::: "memory")
#define PG8_WAIT_L(n) asm volatile("s_waitcnt lgkmcnt(" #n ")" ::: "memory")
#define PG8_BAR __builtin_amdgcn_s_barrier()
#define PG8_SCHED __builtin_amdgcn_sched_barrier(0)
    Unit cur, nxt; int ui = 0;
    if (!S.next(P, 0, cur)) return;
    if (WAITA) wait_panel(cur.pm, prog, wid, lane);
    f32x4 acc[2][2][4][2];
#pragma unroll
    for (int a = 0; a < 2; ++a)
#pragma unroll
        for (int b = 0; b < 2; ++b)
#pragma unroll
            for (int m = 0; m < 4; ++m)
#pragma unroll
                for (int n = 0; n < 2; ++n) acc[a][b][m][n] = (f32x4){0.f, 0.f, 0.f, 0.f};
    bf16x8 At[4][2], B0[2][2], B1[2][2];
    const char* cA = (const char*)ws + P.job[cur.job].A + (size_t)cur.pm * tstepA + cur.kpart * kpartB; const char* cB = (const char*)ws + P.job[cur.job].B + (size_t)cur.pn * tstepB + cur.kpart * kpartB;
    PG8_STAGE(PG8_SB(0, 0), cB, voffB); PG8_STAGE(PG8_SB(0, 1), cB + hstepB, voffB); PG8_STAGE(PG8_SA(0, 0), cA, voffA); PG8_STAGE(PG8_SA(0, 1), cA + hstepA, voffA);
    if (wr == 1) PG8_BAR;
    PG8_WAIT_V(2); PG8_BAR;
    PG8_STAGE(PG8_SB(1, 0), cB + kstep, voffB); PG8_STAGE(PG8_SA(1, 0), cA + kstep, voffA); PG8_STAGE(PG8_SB(1, 1), cB + hstepB + kstep, voffB);
    PG8_WAIT_V(6); PG8_BAR;
    for (;;) {
        const bool has_next = S.next(P, ui + 1, nxt);
        if (WAITA && has_next) wait_panel(nxt.pm, prog, wid, lane);
        const char* nA = has_next ? (const char*)ws + P.job[nxt.job].A + (size_t)nxt.pm * tstepA + nxt.kpart * kpartB : cA; const char* nB = has_next ? (const char*)ws + P.job[nxt.job].B + (size_t)nxt.pn * tstepB + nxt.kpart * kpartB : cB;
        const int ntc = nt / cur.split;
        for (int t = 0; t < ntc; t += 2) {
            const bool last = (t == ntc - 2);
            const char* a1 = cA + (size_t)(t + 1) * kstep;
            const char* a2 = last ? nA : cA + (size_t)(t + 2) * kstep; const char* b2 = last ? nB : cB + (size_t)(t + 2) * kstep;
            const char* a3 = a2 + kstep; const char* b3 = b2 + kstep;
            PG8_LDB(B0, 0, 0); PG8_LDB(B1, 0, 1); PG8_SCHED; PG8_LDA(At, 0, 0); PG8_STAGE(PG8_SA(1, 1), a1 + hstepA, voffA);
            PG8_WAIT_V(8); PG8_WAIT_L(0); PG8_BAR; PG8_MMA(0, 0, At, B0); PG8_MMA(0, 1, At, B1); PG8_BAR; PG8_SCHED;
            PG8_LDA(At, 0, 1); PG8_STAGE(PG8_SB(0, 0), b2, voffB); PG8_STAGE(PG8_SB(0, 1), b2 + hstepB, voffB); PG8_STAGE(PG8_SA(0, 0), a2, voffA);
            PG8_WAIT_V(8); PG8_WAIT_L(0); PG8_BAR; PG8_MMA(1, 0, At, B0); PG8_MMA(1, 1, At, B1); PG8_BAR; PG8_SCHED;
            PG8_LDB(B0, 1, 0); PG8_LDB(B1, 1, 1); PG8_SCHED; PG8_LDA(At, 1, 0); PG8_STAGE(PG8_SA(0, 1), a2 + hstepA, voffA);
            PG8_WAIT_V(8); PG8_WAIT_L(0); PG8_BAR; PG8_MMA(0, 0, At, B0); PG8_MMA(0, 1, At, B1); PG8_BAR; PG8_SCHED;
            PG8_LDA(At, 1, 1); PG8_STAGE(PG8_SB(1, 0), b3, voffB); PG8_STAGE(PG8_SB(1, 1), b3 + hstepB, voffB); PG8_STAGE(PG8_SA(1, 0), a3, voffA);
            PG8_WAIT_V(8); PG8_WAIT_L(0); PG8_BAR; PG8_MMA(1, 0, At, B0); PG8_MMA(1, 1, At, B1); PG8_BAR; PG8_SCHED;
        }
        if (wr == 0) PG8_BAR;
        if (cur.split > 1) {
            {
                asm volatile("s_nop 15\n\ts_nop 7" ::: "memory");
                f32x4* sp_ = (f32x4*)(ws + WS_SLAB) + (size_t)(cur.tail * cur.split + cur.kpart) * (32 * NTHREADS) + tid;
#pragma unroll
                for (int a = 0; a < 2; ++a)
#pragma unroll
                    for (int b = 0; b < 2; ++b)
#pragma unroll
                        for (int m = 0; m < 4; ++m)
#pragma unroll
                            for (int n = 0; n < 2; ++n) { asm volatile("global_store_dwordx4 %0, %1, off sc1\n\ts_nop 1" :: "v"(sp_), "v"(acc[a][b][m][n]) : "memory"); sp_ += NTHREADS; asm volatile("" : "+v"(sp_)); }
            }
            asm volatile("s_waitcnt vmcnt(0)" ::: "memory");
            PG8_BAR;
            if (tid == 0) {
                __hip_atomic_fetch_add(cntw + cur.tail, 1u, __ATOMIC_RELAXED, __HIP_MEMORY_SCOPE_AGENT);
                unsigned spins = 0;
                while (__hip_atomic_load(cntw + cur.tail, __ATOMIC_RELAXED, __HIP_MEMORY_SCOPE_AGENT) < (unsigned)cur.split && ++spins < (1u << 22)) __builtin_amdgcn_s_sleep(1);
                __builtin_amdgcn_fence(__ATOMIC_ACQUIRE, "agent"); asm volatile("s_waitcnt vmcnt(0)" ::: "memory");
            }
            asm volatile("" ::: "memory"); PG8_BAR; asm volatile("" ::: "memory");
            {
                const int nreg = 32 / cur.split, i0 = cur.kpart * nreg;
                f32x4 red[16];
#pragma unroll
                for (int r = 0; r < 16; ++r) red[r] = (f32x4){0.f, 0.f, 0.f, 0.f};
                for (int p = 0; p < cur.split; ++p) {
                    const f32x4* sl = (const f32x4*)(ws + WS_SLAB) + (size_t)(cur.tail * cur.split + p) * (32 * NTHREADS) + (size_t)i0 * NTHREADS + tid;
#pragma unroll
                    for (int r = 0; r < 16; ++r) { if (r < nreg) red[r] += *sl; sl += NTHREADS; }
                    asm volatile("" : "+v"(sl));
                }
                const int mode = P.job[cur.job].mode, ldc = P.job[cur.job].ldc;
                char* outp = (char*)ws + P.job[cur.job].out; const void* aux = (const void*)(ws + P.job[cur.job].aux);
                const int row0 = cur.pm * BM + wr * 64 + fr, col0 = cur.pn * BM + wc * 32 + 8 * fq;
#pragma unroll
                for (int pr = 0; pr < 8; ++pr) if (2 * pr < nreg) {
                    const int g = (i0 >> 1) + pr, ai = g >> 3, bj = (g >> 2) & 1, m = g & 3;
                    const int row = row0 + ai * HALF + m * 16, col = col0 + bj * HALF;
                    if ((MM & (1u << EM_RESID)) && mode == EM_RESID) epi_frag<EM_RESID>(red[2 * pr], red[2 * pr + 1], outp, aux, ldc, row, col);
                    else epi_frag<EM_BF16>(red[2 * pr], red[2 * pr + 1], outp, aux, ldc, row, col);
                }
            }
            PG8_BAR;
        } else
        epilogue<MM>(acc, cur, P, ws, w0p, a0p, wr, wc, fr, fq);
        if (!has_next) break;
#pragma unroll
        for (int a = 0; a < 2; ++a)
#pragma unroll
            for (int b = 0; b < 2; ++b)
#pragma unroll
                for (int m = 0; m < 4; ++m)
#pragma unroll
                    for (int n = 0; n < 2; ++n) acc[a][b][m][n] = (f32x4){0.f, 0.f, 0.f, 0.f};
        cur = nxt; cA = nA; cB = nB; ++ui;
        if (wr == 1) PG8_BAR;
    }
    PG8_WAIT_V(0);
    PG8_BAR;
#undef PG8_SA
#undef PG8_SB
#undef PG8_STAGE
#undef PG8_LDA
#undef PG8_LDB
#undef PG8_MMA
#undef PG8_WAIT_V
#undef PG8_WAIT_L
#undef PG8_BAR
#undef PG8_SCHED
}
}


#define JOB(A, B, O, AUX, NN, LDC, MODE) {(unsigned)(A), (unsigned)(B), (unsigned)(O), (unsigned)(AUX), (NN), (LDC), (MODE), 0}
#define NOJOB {0u, 0u, 0u, 0u, 1 << 30, 0, 0, 0}
constexpr size_t LO1S = (size_t)MP * 256 * 2;
__constant__ pg8::PhaseC c_ph[8] = {
      {1, D, D, NZ / 256, 2, 0, 0, 0, {JOB(WS_X0, WS_WIN, WS_ZIN, 0, NZ / 256, NZ, pg8::EM_BF16), NOJOB, NOJOB, NOJOB, NOJOB, NOJOB}},
      {1, D, D, D / 256, 4, 0, 0, 0, {JOB(WS_CAT, WS_WOUT, WS_ZRES, WS_X0, D / 256, D, pg8::EM_RESID), NOJOB, NOJOB, NOJOB, NOJOB, NOJOB}},
      {1, D, D, DFF / 256, 1, 0, 0, 0, {JOB(WS_HA, WS_WUP, WS_U, 0, DFF / 256, DFF, pg8::EM_RELU2), NOJOB, NOJOB, NOJOB, NOJOB, NOJOB}},
      {1, DFF, DFF, D / 256, 4, 0, 0, 0, {JOB(WS_U, WS_WDN, WS_ZRES, WS_HA, D / 256, D, pg8::EM_RESID), NOJOB, NOJOB, NOJOB, NOJOB, NOJOB}},
      {6, D, D, 27, 1, 0, 0, 0, {JOB(WS_XS + 0 * U37, WS_WR, WS_RKV + 0 * U37, 0, 8, D, pg8::EM_BF16), JOB(WS_XS + 2 * U37, WS_WK, WS_RKV + 1 * U37, 0, 8, D, pg8::EM_BF16),
                                    JOB(WS_XS + 3 * U37, WS_WV, WS_RKV + 2 * U37, 0, 8, D, pg8::EM_BF16), JOB(WS_XS + 1 * U37, WS_L1, WS_LO1, 0, 1, 256, pg8::EM_TANH),
                                    JOB(WS_XS + 4 * U37, WS_L1 + 1 * MiB, WS_LO1 + LO1S, 0, 1, 256, pg8::EM_BF16), JOB(WS_XS + 5 * U37, WS_L1 + 2 * MiB, WS_LO1 + 2 * LO1S, 0, 1, 256, pg8::EM_SIGM)}},
      {3, 256, 256, 24, 1, 0, 0, 0, {JOB(WS_LO1, WS_L2, WS_WDEC, 0, 8, D, pg8::EM_WDEC), JOB(WS_LO1 + LO1S, WS_L2 + 1 * MiB, WS_AG, 0, 8, D, pg8::EM_ASIG),
                                      JOB(WS_LO1 + 2 * LO1S, WS_L2 + 2 * MiB, WS_GG, 0, 8, D, pg8::EM_BF16), NOJOB, NOJOB, NOJOB}},
      {1, D, D, D / 256, 1, 2, pg8::N_LATE, 0, {JOB(WS_YCAT, WS_WO, WS_ZRES, WS_HB, D / 256, D, pg8::EM_RESID), NOJOB, NOJOB, NOJOB, NOJOB, NOJOB}},
      {1, D, D, D / 256, 1, 1, pg8::N_EARLY, 0, {JOB(WS_YCAT, WS_WO, WS_ZRES, WS_HB, D / 256, D, pg8::EM_RESID), NOJOB, NOJOB, NOJOB, NOJOB, NOJOB}},
};
static_assert(WS_END < (1ull << 32), "ws offsets fit 32 bits");

constexpr int RING_BYTES = 158720;
constexpr int LDSCTL_OFF = RING_BYTES, MISC_OFF = LDSCTL_OFF + 64;
constexpr int LDS_BYTES = RING_BYTES + 512;

struct Args { const float* in[N_IN]; float* out; unsigned char* ws; int ph_lo, ph_hi; };
struct Frame {
    LAS unsigned char* lds;
    float* out; unsigned char* ws;
    int tid, lane, wave, G, gw, NGW;
};

__device__ __forceinline__ void transpose_item(const float* W, int ldw, int klim, int nsrc0, bf16_t* WT, int ldwt, int ndst0, float scale, LAS float* scr, int kb, int nb, int lane) {
    const int k0 = 64 * kb, n0 = 32 * nb;
#pragma unroll 8
    for (int i = 0; i < 32; ++i) { const int kk = 2 * i + (lane >> 5); const int k = k0 + kk;
        scr[kk * 33 + (lane & 31)] = (k < klim) ? W[(size_t)k * ldw + nsrc0 + n0 + (lane & 31)] * scale : 0.f; }
    LDS_WAIT(); asm volatile("" ::: "memory");
    const int c = lane & 7;
#pragma unroll
    for (int j = 0; j < 4; ++j) { const int n = (lane >> 3) + 8 * j; const LAS float* s = scr + (8 * c) * 33 + n;
        u32x4 o; o.x = pk2(s[0 * 33], s[1 * 33]); o.y = pk2(s[2 * 33], s[3 * 33]); o.z = pk2(s[4 * 33], s[5 * 33]); o.w = pk2(s[6 * 33], s[7 * 33]);
        *(GAS u32x4*)(WT + (size_t)(ndst0 + n0 + n) * ldwt + k0 + 8 * c) = o; }
    LDS_WAIT(); asm volatile("" ::: "memory");
}
__device__ __forceinline__ void transpose_item64(const float* W, int ldw, int nsrc0, bf16_t* WT, int ldwt, int ndst0, float scale, LAS float* scr, int kb, int nb, int lane) {
    const int k0 = 64 * kb, n0 = 64 * nb;
    f32x4 v[16];
#pragma unroll
    for (int i = 0; i < 16; ++i) { const int kk = 4 * i + (lane >> 4); v[i] = *(const GAS f32x4*)(W + (size_t)(k0 + kk) * ldw + nsrc0 + n0 + 4 * (lane & 15)); }
#pragma unroll
    for (int i = 0; i < 16; ++i) { const int kk = 4 * i + (lane >> 4); LAS float* d = scr + kk * 65 + 4 * (lane & 15); d[0] = v[i][0] * scale; d[1] = v[i][1] * scale; d[2] = v[i][2] * scale; d[3] = v[i][3] * scale; }
    LDS_WAIT(); asm volatile("" ::: "memory");
    const int c = lane & 7;
#pragma unroll
    for (int j = 0; j < 8; ++j) { const int n = (lane >> 3) + 8 * j; const LAS float* sp = scr + (8 * c) * 65 + n;
        u32x4 o; o.x = pk2(sp[0 * 65], sp[1 * 65]); o.y = pk2(sp[2 * 65], sp[3 * 65]); o.z = pk2(sp[4 * 65], sp[5 * 65]); o.w = pk2(sp[6 * 65], sp[7 * 65]);
        *(GAS u32x4*)(WT + (size_t)(ndst0 + n0 + n) * ldwt + k0 + 8 * c) = o; }
    LDS_WAIT(); asm volatile("" ::: "memory");
}
__device__ __forceinline__ void convert_matrix64(Frame& F, int& cursor, const float* W, int ldw, int K, int nsrc0, int N, bf16_t* WT, int ldwt, int ndst0, float scale, LAS float* scr) {
    const int nblk = N / 64, kblk = K / 64, items = nblk * kblk;
    int first = (F.gw - cursor % F.NGW + F.NGW) % F.NGW;
    for (int it = first; it < items; it += F.NGW) transpose_item64(W, ldw, nsrc0, WT, ldwt, ndst0, scale, scr, it / nblk, it % nblk, F.lane);
    cursor += items;
}
__device__ __forceinline__ void convert_matrix(Frame& F, int& cursor, const float* W, int ldw, int Ksrc, int Kdst, int nsrc0, int N, bf16_t* WT, int ldwt, int ndst0, float scale, LAS float* scr) {
    const int nblk = N / 32, kblk = Kdst / 64, items = nblk * kblk;
    int first = (F.gw - cursor % F.NGW + F.NGW) % F.NGW;
    for (int it = first; it < items; it += F.NGW) transpose_item(W, ldw, Ksrc, nsrc0, WT, ldwt, ndst0, scale, scr, it / nblk, it % nblk, F.lane);
    cursor += items;
}
__device__ __forceinline__ void convert_wup(Frame& F, const Args& args, int layer, int& cursor, LAS float* scr) {
    convert_matrix64(F, cursor, args.in[I_WUP] + (size_t)layer * D * DFF, DFF, D, 0, DFF, (bf16_t*)(F.ws + WS_WUP), D, 0, 1.f, scr);
}
__device__ __forceinline__ void convert_wdn(Frame& F, const Args& args, int layer, int& cursor, LAS float* scr) {
    convert_matrix64(F, cursor, args.in[I_WDN] + (size_t)layer * DFF * D, D, DFF, 0, D, (bf16_t*)(F.ws + WS_WDN), DFF, 0, 1.f, scr);
}
__device__ __forceinline__ void convert_mlp_weights(Frame& F, const Args& args, int layer, int& cursor, LAS float* scr) {
    convert_wup(F, args, layer, cursor, scr); convert_wdn(F, args, layer, cursor, scr);
}
__device__ __forceinline__ void p0_prologue(Frame& F, const Args& args) {
    LAS float* scr = (LAS float*)(F.lds + F.wave * 16896);
    int cursor = 0;
    const float* win = args.in[I_WIN];
    convert_matrix64(F, cursor, win, PROJ, D, 0, 1024, (bf16_t*)(F.ws + WS_WIN), D, 0, 1.f, scr);
    convert_matrix64(F, cursor, win, PROJ, D, 1024, 1024, (bf16_t*)(F.ws + WS_WIN), D, 1024, 0.0625f, scr);
    convert_matrix64(F, cursor, win, PROJ, D, 2048, 2048, (bf16_t*)(F.ws + WS_WIN), D, 2048, 1.f, scr);
    convert_matrix64(F, cursor, win, PROJ, D, 4104, 2048, (bf16_t*)(F.ws + WS_WIN), D, 4096, 1.f, scr);
    convert_matrix64(F, cursor, args.in[I_WOUT], D, D, 0, D, (bf16_t*)(F.ws + WS_WOUT), D, 0, 1.f, scr);
}
__device__ __forceinline__ void convert_rwkv_weights(Frame& F, const Args& args, LAS float* scr) {
    int cursor = 0;
    convert_matrix64(F, cursor, args.in[I_WR], D, D, 0, D, (bf16_t*)(F.ws + WS_WR), D, 0, 1.f, scr);
    convert_matrix64(F, cursor, args.in[I_WK], D, D, 0, D, (bf16_t*)(F.ws + WS_WK), D, 0, 1.f, scr);
    convert_matrix64(F, cursor, args.in[I_WV], D, D, 0, D, (bf16_t*)(F.ws + WS_WV), D, 0, 1.f, scr);
    convert_matrix64(F, cursor, args.in[I_WO], D, D, 0, D, (bf16_t*)(F.ws + WS_WO), D, 0, 1.f, scr);
    convert_matrix(F, cursor, args.in[I_W1], 96, D, D, 0, 96, (bf16_t*)(F.ws + WS_L1), D, 0, 1.f, scr);
    convert_matrix(F, cursor, args.in[I_A1], 96, D, D, 0, 96, (bf16_t*)(F.ws + WS_L1 + 1 * MiB), D, 0, 1.f, scr);
    convert_matrix(F, cursor, args.in[I_G1], 256, D, D, 0, 256, (bf16_t*)(F.ws + WS_L1 + 2 * MiB), D, 0, 1.f, scr);
    convert_matrix(F, cursor, args.in[I_W2], D, 96, 256, 0, D, (bf16_t*)(F.ws + WS_L2), 256, 0, 1.f, scr);
    convert_matrix(F, cursor, args.in[I_A2], D, 96, 256, 0, D, (bf16_t*)(F.ws + WS_L2 + 1 * MiB), 256, 0, 1.f, scr);
    convert_matrix(F, cursor, args.in[I_G2], D, 256, 256, 0, D, (bf16_t*)(F.ws + WS_L2 + 2 * MiB), 256, 0, 1.f, scr);
    for (int p = F.gw * 64 + F.lane; p < 2 * 40960; p += F.NGW * 64) { const int mtx = p / 40960, q = p % 40960;
        *(GAS u32x4*)(F.ws + WS_L1 + (size_t)mtx * MiB + (size_t)96 * D * 2 + (size_t)q * 16) = (u32x4){0u, 0u, 0u, 0u}; }
}
__device__ __forceinline__ int balanced_row(const Frame& F, int it) {
    const int full = (M / F.NGW) * F.NGW;
    if ((it + 1) * F.NGW <= full) return it * F.NGW + F.gw;
    if (it * F.NGW != full) return M;
    const int r2 = F.wave * F.G + F.gw / NWAVES;
    return (full + r2 < M) ? full + r2 : M;
}
__device__ __forceinline__ void p0_rows(Frame& F, const Args& args) {
    LAS f32x4* Glo = (LAS f32x4*)(F.lds); LAS f32x4* Ghi = (LAS f32x4*)(F.lds + 32768);
    const float* win = args.in[I_WIN];
    for (int k = F.tid; k < D; k += NTHREADS) { const f32x4 a = *(const f32x4*)(win + (size_t)k * PROJ + 4096), b = *(const f32x4*)(win + (size_t)k * PROJ + 4100);
        const int l = (k & 255) >> 2, c = k & 3, j = k >> 8, p = (4 * j + c) * 64 + l; Glo[p] = a; Ghi[p] = b; }
    __syncthreads();
    const float* bif = args.in[I_BIF];
    for (int it_ = 0, row = F.gw; row < M; ++it_, row = balanced_row(F, it_)) {
        const float* src;
        if (row < MPR) { const int b = row / TP, t = row % TP; src = (t < NMETA) ? args.in[I_META] + (size_t)t * D : args.in[I_XP] + ((size_t)b * SEQ + (t - NMETA)) * D; }
        else src = args.in[I_XS] + (size_t)(row - MPR) * D;
        f32x4 v[8]; float g[8];
#pragma unroll
        for (int j = 0; j < 8; ++j) v[j] = *(const GAS f32x4*)(src + 4 * F.lane + 256 * j);
#pragma unroll
        for (int q = 0; q < 8; ++q) g[q] = 0.f;
        GAS u32x2* o8 = (GAS u32x2*)(F.ws + WS_X0 + (size_t)row * D * 2) + F.lane;
#pragma unroll
        for (int j = 0; j < 8; ++j) {
            o8[64 * j] = (u32x2){pk2(v[j][0], v[j][1]), pk2(v[j][2], v[j][3])};
#pragma unroll
            for (int c = 0; c < 4; ++c) { const int p = (4 * j + c) * 64 + F.lane; const f32x4 a = Glo[p], b = Ghi[p]; const float x = v[j][c];
                g[0] += x * a[0]; g[1] += x * a[1]; g[2] += x * a[2]; g[3] += x * a[3]; g[4] += x * b[0]; g[5] += x * b[1]; g[6] += x * b[2]; g[7] += x * b[3]; }
            asm volatile("" ::: "memory");
        }
#pragma unroll
        for (int q = 0; q < 8; ++q) g[q] = wave_sum(g[q]);
        if (F.lane == 0) { float* go = (float*)(F.ws + WS_GATES) + (size_t)row * 8;
#pragma unroll
            for (int q = 0; q < 8; ++q) go[q] = g[q] + bif[q]; }
    }
}


__device__ __forceinline__ void unpack8(const u32x4 w, float (&x)[8]) { x[0] = bflo(w.x); x[1] = bfhi(w.x); x[2] = bflo(w.y); x[3] = bfhi(w.y); x[4] = bflo(w.z); x[5] = bfhi(w.z); x[6] = bflo(w.w); x[7] = bfhi(w.w); }
__device__ __forceinline__ u32x4 pack8(const float (&x)[8]) { u32x4 w; w.x = pk2(x[0], x[1]); w.y = pk2(x[2], x[3]); w.z = pk2(x[4], x[5]); w.w = pk2(x[6], x[7]); return w; }
__device__ __forceinline__ void ln_row_load_norm(const bf16_t* zrow, int lane, float (&x)[4][8]) {
    float s = 0.f;
#pragma unroll
    for (int j = 0; j < 4; ++j) { const u32x4 w = *(const GAS u32x4*)(zrow + 8 * lane + 512 * j); unpack8(w, x[j]);
#pragma unroll
        for (int e = 0; e < 8; ++e) s += x[j][e]; }
    const float mean = wave_sum(s) * (1.f / D); float s2 = 0.f;
#pragma unroll
    for (int j = 0; j < 4; ++j)
#pragma unroll
        for (int e = 0; e < 8; ++e) { x[j][e] -= mean; s2 += x[j][e] * x[j][e]; }
    const float rstd = 1.0f / sqrtf(wave_sum(s2) * (1.f / D) + LN_EPS);
#pragma unroll
    for (int j = 0; j < 4; ++j)
#pragma unroll
        for (int e = 0; e < 8; ++e) x[j][e] *= rstd;
}
__device__ __forceinline__ void stage_lds(LAS float* dst, const float* src, int n, int tid) {
    for (int i = tid * 4; i < n; i += NTHREADS * 4) *(LAS f32x4*)(dst + i) = *(const GAS f32x4*)(src + i);
}
__device__ __forceinline__ void ln_affine(const LAS float* gl, int lane, float (&x)[4][8]) {
#pragma unroll
    for (int j = 0; j < 4; ++j) { const int c = 8 * lane + 512 * j; const f32x4 g0 = *(const LAS f32x4*)(gl + c), g1 = *(const LAS f32x4*)(gl + c + 4), b0 = *(const LAS f32x4*)(gl + D + c), b1 = *(const LAS f32x4*)(gl + D + c + 4);
#pragma unroll
        for (int e = 0; e < 4; ++e) { x[j][e] = x[j][e] * g0[e] + b0[e]; x[j][4 + e] = x[j][4 + e] * g1[e] + b1[e]; } }
}
__device__ __forceinline__ void ln_pass(Frame& F, const bf16_t* z, const float* g, const float* b, bf16_t* out) {
    LAS float* gl = (LAS float*)F.lds; stage_lds(gl, g, D, F.tid); stage_lds(gl + D, b, D, F.tid); __syncthreads();
    for (int it_ = 0, row = F.gw; row < M; ++it_, row = balanced_row(F, it_)) {
        float x[4][8]; ln_row_load_norm(z + (size_t)row * D, F.lane, x); ln_affine(gl, F.lane, x);
#pragma unroll
        for (int j = 0; j < 4; ++j) *(GAS u32x4*)(out + (size_t)row * D + 8 * F.lane + 512 * j) = pack8(x[j]);
    }
}
__device__ __forceinline__ void ln_final(Frame& F, const bf16_t* z, const float* g, const float* b) {
    LAS float* gl = (LAS float*)F.lds; stage_lds(gl, g, D, F.tid); stage_lds(gl + D, b, D, F.tid); __syncthreads();
    for (int it_ = 0, row = F.gw; row < M; ++it_, row = balanced_row(F, it_)) {
        float* dst;
        if (row < MPR) { const int bb = row / TP, t = row % TP; if (t < NMETA) continue; dst = F.out + O_YP + ((size_t)bb * SEQ + (t - NMETA)) * D; }
        else dst = F.out + O_YS + (size_t)(row - MPR) * D;
        const bf16_t* zrow = z + (size_t)row * D;
        float x[8][4]; float s = 0.f;
#pragma unroll
        for (int j = 0; j < 8; ++j) { const u32x2 w = *(const GAS u32x2*)(zrow + 4 * F.lane + 256 * j); x[j][0] = bflo(w.x); x[j][1] = bfhi(w.x); x[j][2] = bflo(w.y); x[j][3] = bfhi(w.y);
            s += (x[j][0] + x[j][1]) + (x[j][2] + x[j][3]); }
        const float mean = wave_sum(s) * (1.f / D); float s2 = 0.f;
#pragma unroll
        for (int j = 0; j < 8; ++j)
#pragma unroll
            for (int e = 0; e < 4; ++e) { x[j][e] -= mean; s2 += x[j][e] * x[j][e]; }
        const float rstd = 1.0f / sqrtf(wave_sum(s2) * (1.f / D) + LN_EPS);
#pragma unroll
        for (int j = 0; j < 8; ++j) { const int c = 4 * F.lane + 256 * j; const f32x4 g0 = *(const LAS f32x4*)(gl + c), b0 = *(const LAS f32x4*)(gl + D + c);
            f32x4 o;
#pragma unroll
            for (int e = 0; e < 4; ++e) o[e] = x[j][e] * rstd * g0[e] + b0[e];
            *(GAS f32x4*)(dst + c) = o; }
    }
}
__device__ __forceinline__ void ln_mix_pass(Frame& F, const Args& args, const bf16_t* z, const float* g, const float* b) {
    LAS float* gl = (LAS float*)F.lds; LAS float* mul = gl + 2 * D;
    stage_lds(gl, g, D, F.tid); stage_lds(gl + D, b, D, F.tid); stage_lds(mul, args.in[I_MU], 6 * D, F.tid); __syncthreads();
    const int body = (4 * F.NGW < M) ? 4 * F.NGW : M, vcu_ = F.gw / NWAVES;
#pragma unroll 1
    for (int k = 0; k < 2; ++k) {
        int row0, nr;
        if (k == 0) { row0 = 4 * F.gw; nr = 4; if (row0 >= body) continue; }
        else { const int r2 = F.wave * F.G + vcu_; if (body + r2 >= M) break; row0 = body + r2; nr = 1; }
        int t0, T; const float* xlast = nullptr; float* shift_out;
        if (row0 < MPR) { const int bb = row0 / TP; t0 = row0 % TP; T = TP; shift_out = F.out + O_PX + (size_t)bb * D; }
        else { const int r = row0 - MPR; const int bb = r / DS; t0 = r % DS; T = DS; xlast = args.in[I_RX] + (size_t)bb * D; shift_out = F.out + O_SX + (size_t)bb * D; }
        float prev[4][8], cur[4][8];
        if (t0 == 0) {
#pragma unroll
            for (int j = 0; j < 4; ++j)
#pragma unroll
                for (int e = 0; e < 8; ++e) prev[j][e] = 0.f;
            if (xlast) {
#pragma unroll
                for (int j = 0; j < 4; ++j) { const f32x4 a = *(const GAS f32x4*)(xlast + 8 * F.lane + 512 * j), c = *(const GAS f32x4*)(xlast + 8 * F.lane + 512 * j + 4);
#pragma unroll
                    for (int e = 0; e < 4; ++e) { prev[j][e] = a[e]; prev[j][4 + e] = c[e]; } }
            }
        } else { ln_row_load_norm(z + (size_t)(row0 - 1) * D, F.lane, prev); ln_affine(gl, F.lane, prev); }
#pragma unroll 1
        for (int r = 0; r < nr; ++r) {
            const int row = row0 + r;
            ln_row_load_norm(z + (size_t)row * D, F.lane, cur); ln_affine(gl, F.lane, cur);
#pragma unroll
            for (int j = 0; j < 4; ++j) *(GAS u32x4*)((bf16_t*)(F.ws + WS_HB) + (size_t)row * D + 8 * F.lane + 512 * j) = pack8(cur[j]);
            if (t0 + r == T - 1) {
#pragma unroll
                for (int j = 0; j < 4; ++j) { GAS f32x4* o = (GAS f32x4*)(shift_out + 8 * F.lane + 512 * j); o[0] = (f32x4){cur[j][0], cur[j][1], cur[j][2], cur[j][3]}; o[1] = (f32x4){cur[j][4], cur[j][5], cur[j][6], cur[j][7]}; }
            }
#pragma unroll 1
            for (int mx = 0; mx < 6; ++mx) {
                bf16_t* dst = (bf16_t*)(F.ws + WS_XS + (size_t)mx * U37) + (size_t)row * D;
#pragma unroll
                for (int j = 0; j < 4; ++j) { const int c = 8 * F.lane + 512 * j; const f32x4 m0 = *(const LAS f32x4*)(mul + mx * D + c), m1 = *(const LAS f32x4*)(mul + mx * D + c + 4);
                    float o[8];
#pragma unroll
                    for (int e = 0; e < 4; ++e) { o[e] = cur[j][e] + (prev[j][e] - cur[j][e]) * m0[e]; o[4 + e] = cur[j][4 + e] + (prev[j][4 + e] - cur[j][4 + e]) * m1[e]; }
                    *(GAS u32x4*)(dst + c) = pack8(o); asm volatile("" ::: "memory"); }
            }
#pragma unroll
            for (int j = 0; j < 4; ++j)
#pragma unroll
                for (int e = 0; e < 8; ++e) prev[j][e] = cur[j][e];
        }
    }
}
__device__ __forceinline__ void headnorm_pass(Frame& F, const Args& args) {
    const float* ng = args.in[I_MNG];
    const bf16_t* hm = (const bf16_t*)(F.ws + WS_HM); const bf16_t* zin = (const bf16_t*)(F.ws + WS_ZIN); bf16_t* cat = (bf16_t*)(F.ws + WS_CAT);
    for (int it_ = 0, row = F.gw; row < M; ++it_, row = balanced_row(F, it_)) {
        const int c = 16 * F.lane;
        float x[16], o[16];
        { const u32x4 w0 = *(const GAS u32x4*)(hm + (size_t)row * MIXA + c), w1 = *(const GAS u32x4*)(hm + (size_t)row * MIXA + c + 8);
          float a[8], bq[8]; unpack8(w0, a); unpack8(w1, bq);
#pragma unroll
          for (int e = 0; e < 8; ++e) { x[e] = a[e]; x[8 + e] = bq[e]; } }
        { const u32x4 w0 = *(const GAS u32x4*)(zin + (size_t)row * NZ + 3072 + c), w1 = *(const GAS u32x4*)(zin + (size_t)row * NZ + 3072 + c + 8);
          float a[8], bq[8]; unpack8(w0, a); unpack8(w1, bq);
#pragma unroll
          for (int e = 0; e < 8; ++e) { o[e] = a[e]; o[8 + e] = bq[e]; } }
        float s = 0.f;
#pragma unroll
        for (int e = 0; e < 16; ++e) s += x[e];
        s += __shfl_xor(s, 1); s += __shfl_xor(s, 2); s += __shfl_xor(s, 4); s += __shfl_xor(s, 8);
        const float mean = s * (1.f / 256.f); float s2 = 0.f;
#pragma unroll
        for (int e = 0; e < 16; ++e) { x[e] -= mean; s2 += x[e] * x[e]; }
        s2 += __shfl_xor(s2, 1); s2 += __shfl_xor(s2, 2); s2 += __shfl_xor(s2, 4); s2 += __shfl_xor(s2, 8);
        const float rstd = 1.0f / sqrtf(s2 * (1.f / 256.f) + LN_EPS);
        float y0[8], y1[8];
#pragma unroll
        for (int e = 0; e < 8; ++e) { y0[e] = x[e] * rstd * ng[c + e] * sigmoidf_(o[e]); y1[e] = x[8 + e] * rstd * ng[c + 8 + e] * sigmoidf_(o[8 + e]); }
        *(GAS u32x4*)(cat + (size_t)row * D + c) = pack8(y0); *(GAS u32x4*)(cat + (size_t)row * D + c + 8) = pack8(y1);
    }
}


namespace ml {
constexpr int NVR = 2, NVT = NVR + 1, SLW = 16 * NVR, NSL = HDA / SLW;
constexpr int QS = 144;
constexpr int CS = 272;
constexpr int LO_QH = 0, LO_KH = LO_QH + 128 * QS * 2, LO_VT = LO_KH + 128 * QS * 2, LO_VW = LO_VT + 16 * NVT * QS * 2, LO_CT = LO_VW + 16 * NVT * QS * 2,
              LO_GF = LO_CT + 16 * NVT * CS * 2, LO_GG = LO_GF + 512, LO_GM = LO_GG + 512, LO_SC = LO_GM + 512, GATE_BLK = 1600, LO_END = LO_GF + 2 * GATE_BLK;
constexpr int LO_PS = LO_QH;
static_assert(LO_END <= RING_BYTES, "mlstm lds");
__device__ __forceinline__ bf16x8 ldfrag(const LAS unsigned char* base, int row, int stride_el, int col) { return *(const LAS bf16x8*)(base + ((size_t)row * stride_el + col) * 2); }
__device__ __forceinline__ s16x4 trread(const LAS unsigned char* p) { typedef short v4i16_t __attribute__((ext_vector_type(4))); return __builtin_bit_cast(s16x4, __builtin_amdgcn_ds_read_tr16_b64_v4i16((LAS v4i16_t*)p)); }
}
__device__ __forceinline__ float log_sigmoidf_(float x) { return fminf(x, 0.f) - __logf(1.0f + __expf(-fabsf(x))); }
template <int CTRL> __device__ __forceinline__ float dpp_fill(float fill, float v) { return __builtin_bit_cast(float, __builtin_amdgcn_update_dpp(__builtin_bit_cast(int, fill), __builtin_bit_cast(int, v), CTRL, 0xf, 0xf, false)); }
__device__ __forceinline__ float wave_scan_sum(float v, int lane) {
    v += dpp_fill<0x111>(0.f, v); v += dpp_fill<0x112>(0.f, v); v += dpp_fill<0x114>(0.f, v); v += dpp_fill<0x118>(0.f, v);
    const int b = __builtin_bit_cast(int, v);
    const float t0 = __builtin_bit_cast(float, __builtin_amdgcn_readlane(b, 15)), t1 = __builtin_bit_cast(float, __builtin_amdgcn_readlane(b, 31)), t2 = __builtin_bit_cast(float, __builtin_amdgcn_readlane(b, 47));
    const int q = lane >> 4;
    return v + ((q >= 1 ? t0 : 0.f) + (q >= 2 ? t1 : 0.f) + (q >= 3 ? t2 : 0.f));
}
__device__ __forceinline__ float wave_scan_max(float v, int lane) {
    v = fmaxf(v, dpp_fill<0x111>(-3e38f, v)); v = fmaxf(v, dpp_fill<0x112>(-3e38f, v)); v = fmaxf(v, dpp_fill<0x114>(-3e38f, v)); v = fmaxf(v, dpp_fill<0x118>(-3e38f, v));
    const int b = __builtin_bit_cast(int, v);
    const float t0 = __builtin_bit_cast(float, __builtin_amdgcn_readlane(b, 15)), t1 = __builtin_bit_cast(float, __builtin_amdgcn_readlane(b, 31)), t2 = __builtin_bit_cast(float, __builtin_amdgcn_readlane(b, 47));
    const int q = lane >> 4;
    return fmaxf(v, fmaxf(fmaxf(q >= 1 ? t0 : -3e38f, q >= 2 ? t1 : -3e38f), q >= 3 ? t2 : -3e38f));
}
__device__ __forceinline__ void mlstm_prompt_job(Frame& F, const Args& args, int jid) {
    using namespace ml;
    const int b = jid / (NHA * NSL), h = (jid / NSL) % NHA, sl = jid % NSL;
    const int tid = F.tid, lane = F.lane, w = F.wave, q0_ = lane >> 4, c0_ = lane & 15;
    LAS unsigned char* L = F.lds;
    const bf16_t* zin = (const bf16_t*)(F.ws + WS_ZIN); const float* gates = (const float*)(F.ws + WS_GATES);
    bf16_t* hm = (bf16_t*)(F.ws + WS_HM);
    const int rb = b * TP;
    for (int i = tid; i < (LO_GF - LO_VT) / 4; i += NTHREADS) ((LAS unsigned*)(L + LO_VT))[i] = 0u;
    f32x4 st[2][NVT];
#pragma unroll
    for (int a = 0; a < 2; ++a)
#pragma unroll
        for (int v = 0; v < NVT; ++v) st[a][v] = (f32x4){0.f, 0.f, 0.f, 0.f};
    float m_run = 0.f;
    float gq_i0 = -1e30f, gq_i1 = -1e30f, gq_f0 = 1e30f, gq_f1 = 1e30f, m_gate = 0.f;
#define ML_GATES_LOAD(chn_) do { const int r0n_ = ((chn_) == 0) ? 0 : 16 + 128 * ((chn_) - 1), Lcn_ = ((chn_) == 0) ? 16 : 128; const size_t gr_ = (size_t)(rb + r0n_); \
        gq_i0 = -1e30f; gq_i1 = -1e30f; gq_f0 = 1e30f; gq_f1 = 1e30f; \
        if (2 * lane < Lcn_) { gq_i0 = gates[(gr_ + 2 * lane) * 8 + h]; gq_f0 = gates[(gr_ + 2 * lane) * 8 + 4 + h]; } \
        if (2 * lane + 1 < Lcn_) { gq_i1 = gates[(gr_ + 2 * lane + 1) * 8 + h]; gq_f1 = gates[(gr_ + 2 * lane + 1) * 8 + 4 + h]; } } while (0)
#define ML_GATES_MATH(buf_) do { LAS float* gF_ = (LAS float*)(L + LO_GF + (buf_) * GATE_BLK); LAS float* gG_ = gF_ + 128; LAS float* gM_ = gF_ + 256; LAS float* sc_ = gF_ + 384; \
        const int j0 = 2 * lane, j1 = 2 * lane + 1; \
        const float lf0 = log_sigmoidf_(gq_f0), lf1 = log_sigmoidf_(gq_f1);         \
        const float ps = wave_scan_sum(lf0 + lf1, lane); \
        const float ex = ps - (lf0 + lf1); \
        const float F0 = ex + lf0, F1 = F0 + lf1; \
        const float g0 = gq_i0 - F0, g1 = gq_i1 - F1; \
        const float pm = wave_scan_max(fmaxf(g0, g1), lane); \
        const float pme = dpp_fill<0x138>(-3e38f, pm);                                \
        const float pm0 = fmaxf(pme, g0), pm1 = fmaxf(pm0, g1); \
        const float M0 = fmaxf(m_gate, pm0), M1 = fmaxf(m_gate, pm1); \
        gF_[j0] = F0; gF_[j1] = F1; gG_[j0] = g0; gG_[j1] = g1; gM_[j0] = M0; gM_[j1] = M1; \
        if (lane == 63) { sc_[0] = m_gate; sc_[1] = M1; sc_[2] = __expf(m_gate - M1); sc_[3] = F1 + M1; } \
        m_gate = __builtin_bit_cast(float, __builtin_amdgcn_readlane(__builtin_bit_cast(int, F1 + M1), 63)); } while (0)
    u32x4 pq[4], pk[4], pv = (u32x4){0u, 0u, 0u, 0u};
#define ML_QK_LOAD(chn_, half_) do { const int r0n_ = ((chn_) == 0) ? 0 : 16 + 128 * ((chn_) - 1), Lcn_ = ((chn_) == 0) ? 16 : 128; \
        _Pragma("unroll") for (int i = 0; i < 4; ++i) { const int p = tid + NTHREADS * i, row = p >> 4, c16 = p & 15; pq[i] = (u32x4){0u, 0u, 0u, 0u}; pk[i] = (u32x4){0u, 0u, 0u, 0u}; \
            if (row < Lcn_) { const bf16_t* src = zin + (size_t)(rb + r0n_ + row) * NZ + h * 256 + (half_) * 128 + c16 * 8; pq[i] = *(const GAS u32x4*)src; pk[i] = *(const GAS u32x4*)(src + 1024); } } } while (0)
#define ML_V_LOAD(chn_) do { const int r0n_ = ((chn_) == 0) ? 0 : 16 + 128 * ((chn_) - 1), Lcn_ = ((chn_) == 0) ? 16 : 128; pv = (u32x4){0u, 0u, 0u, 0u}; \
        if ((tid >> 2) < Lcn_) pv = *(const GAS u32x4*)(zin + (size_t)(rb + r0n_ + (tid >> 2)) * NZ + 2048 + h * 256 + sl * SLW + (tid & 3) * 8); } while (0)
    ML_V_LOAD(0); ML_QK_LOAD(0, 0);
    if (w == 0) { ML_GATES_LOAD(0); ML_GATES_MATH(0); }
    __syncthreads();
    for (int ch = 0; ch < 17; ++ch) {
        int q = q0_, c = c0_; asm volatile("" : "+v"(q), "+v"(c));
        const int r0 = (ch == 0) ? 0 : 16 + 128 * (ch - 1), Lc = (ch == 0) ? 16 : 128;
        const int grow = rb + r0;
        LAS float* gF = (LAS float*)(L + LO_GF + (ch & 1) * GATE_BLK); LAS float* gG = gF + 128; LAS float* gM = gF + 256; LAS float* sc = gF + 384;
        if (w == 0 && ch + 1 < 17) ML_GATES_LOAD(ch + 1);
        const float m_old = sc[0], Mlast = sc[1], dec = sc[2], m_new = sc[3];
        {
            const int j = tid >> 2, v8 = (tid & 3) * 8;
            float vv[8];
#pragma unroll
            for (int e = 0; e < 8; ++e) vv[e] = 0.f;
            if (j < Lc) unpack8(pv, vv);
            if (ch + 1 < 17) ML_V_LOAD(ch + 1);
            const float we = __expf(gG[j] - Mlast);
#pragma unroll
            for (int e = 0; e < 8; ++e) { ((LAS bf16_t*)(L + LO_VT))[(v8 + e) * QS + j] = (bf16_t)f2bf(vv[e]); ((LAS bf16_t*)(L + LO_VW))[(v8 + e) * QS + j] = (bf16_t)f2bf(vv[e] * we); }
            if ((tid & 3) == 0) { ((LAS bf16_t*)(L + LO_VT))[SLW * QS + j] = (j < Lc) ? (bf16_t)0x3F80 : (bf16_t)0; ((LAS bf16_t*)(L + LO_VW))[SLW * QS + j] = (bf16_t)f2bf(we); }
        }
        f32x4 accS[8], accR[NVT];
#pragma unroll
        for (int i = 0; i < 8; ++i) accS[i] = (f32x4){0.f, 0.f, 0.f, 0.f};
#pragma unroll
        for (int i = 0; i < NVT; ++i) accR[i] = (f32x4){0.f, 0.f, 0.f, 0.f};
#pragma unroll
        for (int half = 0; half < 2; ++half) {
#pragma unroll
            for (int i = 0; i < 4; ++i) { const int p = tid + NTHREADS * i, row = p >> 4, c16 = p & 15;
                *(LAS u32x4*)(L + LO_QH + (row * QS + c16 * 8) * 2) = pq[i]; *(LAS u32x4*)(L + LO_KH + (row * QS + c16 * 8) * 2) = pk[i]; }
            if (half == 0) ML_QK_LOAD(ch, 1); else if (ch + 1 < 17) ML_QK_LOAD(ch + 1, 0);
            __syncthreads();
#pragma unroll
            for (int ks = 0; ks < 4; ++ks) {
                const bf16x8 qf = ldfrag(L + LO_QH, 16 * w + c, QS, 32 * ks + 8 * q);
#pragma unroll
                for (int jt = 0; jt < 8; ++jt) if (jt <= (w | 1)) { const bf16x8 kf = ldfrag(L + LO_KH, 16 * jt + c, QS, 32 * ks + 8 * q); accS[jt] = __builtin_amdgcn_mfma_f32_16x16x32_bf16(kf, qf, accS[jt], 0, 0, 0); }
#pragma unroll
                for (int vt = 0; vt < NVT; ++vt) { const bf16x8 cf = ldfrag(L + LO_CT, 16 * vt + c, CS, half * 128 + 32 * ks + 8 * q); accR[vt] = __builtin_amdgcn_mfma_f32_16x16x32_bf16(cf, qf, accR[vt], 0, 0, 0); }
                asm volatile("" ::: "memory");
            }
#pragma unroll
            for (int vt = 0; vt < NVT; ++vt) st[half][vt] = st[half][vt] * dec;
#pragma unroll
            for (int ks = 0; ks < 4; ++ks) {
                const LAS unsigned char* kp = L + LO_KH + ((32 * ks + 8 * q + (c >> 2)) * QS + 16 * w + 4 * (c & 3)) * 2;
                const s16x4 t0 = ml::trread(kp), t1 = ml::trread(kp + 4 * QS * 2);
                const bf16x8 kb = (bf16x8){t0[0], t0[1], t0[2], t0[3], t1[0], t1[1], t1[2], t1[3]};
#pragma unroll
                for (int vt = 0; vt < NVT; ++vt) { const bf16x8 vf = ldfrag(L + LO_VW, 16 * vt + c, QS, 32 * ks + 8 * q); st[half][vt] = __builtin_amdgcn_mfma_f32_16x16x32_bf16(vf, kb, st[half][vt], 0, 0, 0); }
            }
            if (half == 0 && w == 0 && ch + 1 < 17) ML_GATES_MATH((ch + 1) & 1);
            __syncthreads();
        }
        {
            int q = lane >> 4, c = lane & 15; asm volatile("" : "+v"(q), "+v"(c));
            const int i = 16 * w + c; const float Mi = gM[i];
#pragma unroll
            for (int jt = 0; jt < 8; ++jt) if (jt <= (w | 1)) {
                float p[4];
#pragma unroll
                for (int r = 0; r < 4; ++r) { const int j = 16 * jt + 4 * q + r; p[r] = (j <= i) ? accS[jt][r] * __expf(gG[j] - Mi) : 0.f; }
                *(LAS u32x2*)(L + LO_PS + (i * QS + 16 * jt + 4 * q) * 2) = (u32x2){pk2(p[0], p[1]), pk2(p[2], p[3])};
            }
#pragma unroll
            for (int half = 0; half < 2; ++half)
#pragma unroll
                for (int vt = 0; vt < NVT; ++vt)
#pragma unroll
                    for (int r = 0; r < 4; ++r) ((LAS bf16_t*)(L + LO_CT))[(16 * vt + 4 * q + r) * CS + half * 128 + 16 * w + c] = (bf16_t)f2bf(st[half][vt][r]);
        }
        __syncthreads();
        {
            f32x4 accN[NVT];
#pragma unroll
            for (int i = 0; i < NVT; ++i) accN[i] = (f32x4){0.f, 0.f, 0.f, 0.f};
#pragma unroll
            for (int ks = 0; ks < 4; ++ks) if (ks <= (w >> 1)) {
                const bf16x8 pf = ldfrag(L + LO_PS, 16 * w + c, QS, 32 * ks + 8 * q);
#pragma unroll
                for (int vt = 0; vt < NVT; ++vt) { const bf16x8 vf = ldfrag(L + LO_VT, 16 * vt + c, QS, 32 * ks + 8 * q); accN[vt] = __builtin_amdgcn_mfma_f32_16x16x32_bf16(vf, pf, accN[vt], 0, 0, 0); }
            }
            const int i = 16 * w + c; const float Mi = gM[i], Fi = gF[i];
            const float inter = __expf(m_old - Mi);
            float den = accN[NVR][0] + inter * accR[NVR][0];
            den = __shfl(den, c);
            const float dd = fmaxf(fabsf(den), __expf(-(Fi + Mi)));
            const float inv = 1.0f / dd;
#pragma unroll
            for (int vt = 0; vt < NVR; ++vt) {
                float hv[4];
#pragma unroll
                for (int r = 0; r < 4; ++r) hv[r] = (accN[vt][r] + inter * accR[vt][r]) * inv;
                if (i < Lc) *(GAS u32x2*)(hm + (size_t)(grow + i) * MIXA + h * 256 + sl * SLW + 16 * vt + 4 * q) = (u32x2){pk2(hv[0], hv[1]), pk2(hv[2], hv[3])};
            }
        }
        m_run = m_new;
        __syncthreads();
    }
#undef ML_GATES_LOAD
#undef ML_GATES_MATH
#undef ML_QK_LOAD
#undef ML_V_LOAD
    float* out = F.out;
#pragma unroll
    for (int half = 0; half < 2; ++half) {
        const int dk = half * 128 + 16 * w + c0_;
#pragma unroll
        for (int vt = 0; vt < NVR; ++vt) *(GAS f32x4*)(out + O_PC + (((size_t)(b * NHA + h) * HDA + dk) * HDA) + sl * SLW + 16 * vt + 4 * q0_) = st[half][vt];
        if (sl == 0 && q0_ == 0) out[O_PN + (size_t)(b * NHA + h) * HDA + dk] = st[half][NVR][0];
    }
    if (sl == 0 && tid == 0) out[O_PM + b * NHA + h] = m_run;
    __syncthreads();
}

__device__ __forceinline__ void mlstm_sample_job(Frame& F, const Args& args, int jid) {
    const int b = jid >> 2, h = jid & 3;
    const int tid = F.tid, lane = F.lane, w = F.wave;
    LAS float* qs = (LAS float*)(F.lds);
    LAS float* ks = qs + 2048;
    LAS float* vs = ks + 2048;
    LAS float* kw = vs + 2048;
    LAS float* sm = kw + 2048;
    LAS float* gv = sm + 128;
    LAS float* red = gv + 64;
    const bf16_t* zin = (const bf16_t*)(F.ws + WS_ZIN); const float* gates = (const float*)(F.ws + WS_GATES);
    const int row0 = MPR + b * DS;
    const float* C0 = args.in[I_MC] + (size_t)(b * NHA + h) * HDA * HDA; const float* n0 = args.in[I_MN] + (size_t)(b * NHA + h) * HDA;
    const float m0 = args.in[I_MM][b * NHA + h];
    float gl[16];
#pragma unroll
    for (int j = 0; j < 16; ++j) gl[j] = 0.f;
    if (tid == NTHREADS - 64) {
#pragma unroll
        for (int j = 0; j < 8; ++j) { gl[j] = gates[(size_t)(row0 + j) * 8 + h]; gl[8 + j] = gates[(size_t)(row0 + j) * 8 + 4 + h]; }
    }
    for (int i = tid; i < 3 * 8 * 32; i += NTHREADS) { const int which = i / 256, r = (i % 256) / 32, c8 = (i % 32) * 8;
        const u32x4 wv = *(const GAS u32x4*)(zin + (size_t)(row0 + r) * NZ + which * 1024 + h * 256 + c8); float x[8]; unpack8(wv, x);
        LAS float* dst = qs + which * 2048 + r * 256 + c8;
#pragma unroll
        for (int e = 0; e < 8; ++e) dst[e] = x[e]; }
    {
        if (tid == NTHREADS - 64) {
            float Fv[8], gg[8], Mi[8]; float cum = 0.f, pmx = -3e38f;
#pragma unroll
            for (int j = 0; j < 8; ++j) { const float ig = gl[j]; cum += log_sigmoidf_(gl[8 + j]); Fv[j] = cum; gg[j] = ig - cum; pmx = fmaxf(pmx, gg[j]); Mi[j] = fmaxf(m0, pmx); }
            const float Ml = Mi[7];
#pragma unroll
            for (int j = 0; j < 8; ++j) { gv[j] = Fv[j]; gv[8 + j] = gg[j]; gv[16 + j] = Mi[j]; gv[24 + j] = __expf(m0 - Mi[j]); gv[32 + j] = __expf(-(Fv[j] + Mi[j])); gv[40 + j] = __expf(gg[j] - Ml); }
            gv[48] = __expf(m0 - Ml); gv[49] = Fv[7] + Ml;
        }
    }
    __syncthreads();
    f32x4 cvA[8], cvB[8];
#define MS_LOAD(cv_, kb_) do { _Pragma("unroll") for (int u = 0; u < 8; ++u) cv_[u] = *(const GAS f32x4*)(C0 + (size_t)(32 * w + (kb_) + u) * HDA + 4 * lane); } while (0)
    MS_LOAD(cvA, 0); MS_LOAD(cvB, 8);
    for (int i = tid; i < 2048; i += NTHREADS) kw[i] = ks[i] * gv[40 + (i >> 8)];
    {
        const int i = w, j = lane >> 3, part = lane & 7;
        float d = 0.f, dn = 0.f;
        for (int k = part * 32; k < part * 32 + 32; ++k) { const float qv = qs[i * 256 + k]; d += qv * ks[j * 256 + k]; if (j == 0) dn += qv * n0[k]; }
        d += __shfl_xor(d, 1); d += __shfl_xor(d, 2); d += __shfl_xor(d, 4);
        dn += __shfl_xor(dn, 1); dn += __shfl_xor(dn, 2); dn += __shfl_xor(dn, 4);
        if (part == 0) { sm[i * 16 + j] = (j <= i) ? d * __expf(gv[8 + j] - gv[16 + i]) : 0.f; if (j == 0) sm[i * 16 + 8] = dn; }
    }
    lds_barrier();
    const float dec = gv[48];
    f32x4 vr[8], hacc[8];
#pragma unroll
    for (int j = 0; j < 8; ++j) { vr[j] = *(const LAS f32x4*)(vs + j * 256 + 4 * lane); hacc[j] = (f32x4){0.f, 0.f, 0.f, 0.f}; }
    float* Cout = F.out + O_SC + (size_t)(b * NHA + h) * HDA * HDA;
#define MS_USE(cv_, kb_) do { _Pragma("unroll") for (int u = 0; u < 8; ++u) { const int k = 32 * w + (kb_) + u; \
            f32x4 cn = cv_[u] * dec; \
            _Pragma("unroll") for (int j = 0; j < 8; ++j) { hacc[j] += cv_[u] * qs[j * 256 + k]; cn += vr[j] * kw[j * 256 + k]; } \
            *(GAS f32x4*)(Cout + (size_t)k * HDA + 4 * lane) = cn; } } while (0)
    MS_USE(cvA, 0);  MS_LOAD(cvA, 16);
    MS_USE(cvB, 8);  MS_LOAD(cvB, 24);
    MS_USE(cvA, 16);
    MS_USE(cvB, 24);
#undef MS_LOAD
#undef MS_USE
#pragma unroll
    for (int j = 0; j < 8; ++j) *(LAS f32x4*)(red + (w * 8 + j) * 256 + 4 * lane) = hacc[j];
    __syncthreads();
    {
        const int i = tid >> 6; f32x4 qc = (f32x4){0.f, 0.f, 0.f, 0.f};
#pragma unroll
        for (int ww = 0; ww < 8; ++ww) qc += *(const LAS f32x4*)(red + (ww * 8 + i) * 256 + 4 * lane);
        f32x4 num = qc * gv[24 + i]; float den = gv[24 + i] * sm[i * 16 + 8];
#pragma unroll
        for (int j = 0; j < 8; ++j) { const float sij = sm[i * 16 + j]; num += vr[j] * sij; den += sij; }
        const float inv = 1.0f / fmaxf(fabsf(den), gv[32 + i]);
        num = num * inv;
        *(GAS u32x2*)((bf16_t*)(F.ws + WS_HM) + (size_t)(row0 + i) * MIXA + h * 256 + 4 * lane) = (u32x2){pk2(num[0], num[1]), pk2(num[2], num[3])};
    }
    if (tid < 256) { float nn = dec * n0[tid];
#pragma unroll
        for (int j = 0; j < 8; ++j) nn += kw[j * 256 + tid];
        F.out[O_SN + (size_t)(b * NHA + h) * HDA + tid] = nn; }
    if (tid == 0) F.out[O_SM + b * NHA + h] = gv[49];
    __syncthreads();
}


namespace rg {
constexpr int XS = 128, AS = 144, HS = 132;
constexpr int O_XP = 0, O_XC = O_XP + 176 * XS * 2, O_WA = O_XC + 128 * AS * 2, O_WX = O_WA + 32 * AS * 2, O_AL = O_WX + 32 * AS * 2, O_UL = O_AL + 32 * HS * 4, O_CR = O_UL + 32 * HS * 4, O_ENDL = O_CR + 128;
static_assert(O_ENDL <= RING_BYTES, "rglru lds");
}
__device__ __forceinline__ float gelu_tanh_(float x) { const float u = 0.7978845608028654f * (x + 0.044715f * x * x * x); return 0.5f * x * (1.0f + tanhf_(u)); }

__device__ __forceinline__ void rglru_job(Frame& F, const Args& args, int kind, int sq, int n, int qt) {
    using namespace rg;
    const int tid = F.tid, lane = F.lane, w = F.wave, q = lane >> 4, c = lane & 15;
    LAS unsigned char* L = F.lds;
    LAS bf16_t* xp = (LAS bf16_t*)(L + O_XP); LAS bf16_t* xc = (LAS bf16_t*)(L + O_XC);
    LAS float* aL = (LAS float*)(L + O_AL); LAS float* uL = (LAS float*)(L + O_UL); LAS float* carry = (LAS float*)(L + O_CR);
    const bf16_t* zin = (const bf16_t*)(F.ws + WS_ZIN); bf16_t* cat = (bf16_t*)(F.ws + WS_CAT);
    const int cb0 = n * 128;
    const int c0 = cb0 + qt * 32;
    for (int i = tid; i < 2 * 32 * 128; i += NTHREADS) { const int which = i >> 12, cc = (i >> 7) & 31, ii = i & 127;
        const float v = args.in[which ? I_WX : I_WA][((size_t)n * 128 + ii) * 128 + qt * 32 + cc];
        ((LAS bf16_t*)(L + (which ? O_WX : O_WA)))[cc * AS + ii] = (bf16_t)f2bf(v); }
    const int chn = tid & 127;
    const int rq = tid >> 4, cq = tid & 15;
    float cw[4][8], cbias[8];
#pragma unroll
    for (int j = 0; j < 4; ++j)
#pragma unroll
        for (int e = 0; e < 8; ++e) cw[j][e] = args.in[I_CVW][j * RGW + cb0 + 8 * cq + e];
#pragma unroll
    for (int e = 0; e < 8; ++e) cbias[e] = args.in[I_CVB][cb0 + 8 * cq + e];
    float bav[2], bxv[2], spv[2];
#pragma unroll
    for (int e = 0; e < 2; ++e) { const int cg = c0 + 16 * e + c; bav[e] = args.in[I_BA][cg]; bxv[e] = args.in[I_BX][cg]; spv[e] = softplusf_(-args.in[I_LAM][cg]); }
    if (tid < 32) carry[tid] = 0.f;
    const int ntiles = kind ? 1 : 17;
    const int T = kind ? DS : TP;
    u32x4 pre[5];
#define RG_PREFETCH(t0_) do { _Pragma("unroll") for (int i_ = 0; i_ < 5; ++i_) { const int p_ = tid + NTHREADS * i_; const int r_ = p_ >> 4, c16_ = p_ & 15; const int tok_ = (t0_) - 3 + r_; \
        pre[i_] = (u32x4){0u, 0u, 0u, 0u}; if (p_ < 131 * 16 && tok_ >= 0 && tok_ < TP) pre[i_] = *(const GAS u32x4*)(zin + (size_t)(sq * TP + tok_) * NZ + 4096 + cb0 + c16_ * 8); } } while (0)
    if (kind == 0) RG_PREFETCH(0);
    for (int ti = 0; ti < ntiles; ++ti) {
        const int t0 = ti * 128;
        const int nv = kind ? 128 : ((TP - t0) < 128 ? (TP - t0) : 128);
        __syncthreads();
        if (kind == 0) {
#pragma unroll
            for (int i = 0; i < 5; ++i) { const int p = tid + NTHREADS * i; if (p < 131 * 16) *(LAS u32x4*)(xp + (p >> 4) * XS + (p & 15) * 8) = pre[i]; }
        } else {
            for (int p = tid; p < 176 * 16; p += NTHREADS) { const int r = p >> 4, c16 = p & 15; const int sg = r / 11, lr = r % 11; const int bq = sq * 16 + sg;
                u32x4 v;
                if (lr < 3) { const float* src = args.in[I_RC] + ((size_t)bq * 3 + lr) * RGW + cb0 + c16 * 8; const f32x4 a = *(const GAS f32x4*)src, bb = *(const GAS f32x4*)(src + 4);
                    v.x = pk2(a[0], a[1]); v.y = pk2(a[2], a[3]); v.z = pk2(bb[0], bb[1]); v.w = pk2(bb[2], bb[3]); }
                else v = *(const GAS u32x4*)(zin + (size_t)(MPR + bq * DS + lr - 3) * NZ + 4096 + cb0 + c16 * 8);
                *(LAS u32x4*)(xp + r * XS + c16 * 8) = v; }
        }
        u32x4 gpre = (u32x4){0u, 0u, 0u, 0u};
        { const int rho = tid >> 2, c8 = (tid & 3) * 8;
          if (rho < nv) { const int grow = kind ? (MPR + (sq * 16 + (rho >> 3)) * DS + (rho & 7)) : (sq * TP + t0 + rho); gpre = *(const GAS u32x4*)(zin + (size_t)grow * NZ + 5120 + c0 + c8); } }
        __syncthreads();
        if (kind == 0 && ti + 1 < ntiles) RG_PREFETCH(t0 + 128);
        {
            const int rho0 = 4 * rq; const int idx0 = kind ? ((rho0 >> 3) * 11 + (rho0 & 7)) : rho0;
            float xr[7][8];
#pragma unroll
            for (int j = 0; j < 7; ++j) unpack8(*(const LAS u32x4*)(xp + (idx0 + j) * XS + 8 * cq), xr[j]);
#pragma unroll
            for (int r = 0; r < 4; ++r) { float o[8];
#pragma unroll
                for (int e = 0; e < 8; ++e) o[e] = cbias[e] + cw[0][e] * xr[r][e] + cw[1][e] * xr[r + 1][e] + cw[2][e] * xr[r + 2][e] + cw[3][e] * xr[r + 3][e];
                *(LAS u32x4*)(xc + (rho0 + r) * AS + 8 * cq) = pack8(o); }
        }
        __syncthreads();
        f32x4 acc[4];
#pragma unroll
        for (int i = 0; i < 4; ++i) acc[i] = (f32x4){0.f, 0.f, 0.f, 0.f};
#pragma unroll
        for (int ks = 0; ks < 4; ++ks) {
            const bf16x8 xf = *(const LAS bf16x8*)(xc + (16 * w + c) * AS + 32 * ks + 8 * q);
#pragma unroll
            for (int nt = 0; nt < 4; ++nt) { const bf16x8 wf = *(const LAS bf16x8*)((LAS bf16_t*)(L + ((nt >> 1) ? O_WX : O_WA)) + (16 * (nt & 1) + c) * AS + 32 * ks + 8 * q);
                acc[nt] = __builtin_amdgcn_mfma_f32_16x16x32_bf16(xf, wf, acc[nt], 0, 0, 0); }
        }
#pragma unroll
        for (int e = 0; e < 2; ++e) {
            f32x4 av, uv;
#pragma unroll
            for (int r = 0; r < 4; ++r) { const int t = 16 * w + 4 * q + r;
                const float rr = sigmoidf_(acc[e][r] + bav[e]), gi = sigmoidf_(acc[2 + e][r] + bxv[e]);
                const float la = -8.0f * rr * spv[e]; const float a = __expf(la); const float mult = sqrtf(fmaxf(1.0f - a * a, 0.f));
                const float xv = bf2f(xc[t * AS + qt * 32 + 16 * e + c]);
                const bool valid = t < nv;
                av[r] = valid ? a : 1.0f; uv[r] = valid ? mult * gi * xv : 0.f; }
            *(LAS f32x4*)(aL + (16 * e + c) * HS + 16 * w + 4 * q) = av; *(LAS f32x4*)(uL + (16 * e + c) * HS + 16 * w + 4 * q) = uv;
        }
        __syncthreads();
        {
            const int sg = tid & 15, ch = tid >> 4;
            float a8[8], u8[8];
            { const f32x4 a0 = *(const LAS f32x4*)(aL + ch * HS + 8 * sg), a1 = *(const LAS f32x4*)(aL + ch * HS + 8 * sg + 4), u0 = *(const LAS f32x4*)(uL + ch * HS + 8 * sg), u1 = *(const LAS f32x4*)(uL + ch * HS + 8 * sg + 4);
#pragma unroll
              for (int e = 0; e < 4; ++e) { a8[e] = a0[e]; a8[4 + e] = a1[e]; u8[e] = u0[e]; u8[4 + e] = u1[e]; } }
            float hin;
            if (kind == 0) {
                float A = 1.f, H = 0.f;
#pragma unroll
                for (int k = 0; k < 8; ++k) { H = a8[k] * H + u8[k]; A *= a8[k]; }
#pragma unroll
                for (int d = 1; d < 16; d <<= 1) { const float Ap = __shfl_up(A, d, 16), Hp = __shfl_up(H, d, 16); if (sg >= d) { H = A * Hp + H; A = A * Ap; } }
                float Ae = __shfl_up(A, 1, 16), He = __shfl_up(H, 1, 16); if (sg == 0) { Ae = 1.f; He = 0.f; }
                hin = Ae * carry[ch] + He;
            } else {
                hin = args.in[I_RH][(size_t)(sq * 16 + sg) * RGW + c0 + ch];
            }
            float hcur = hin; float h8[8];
#pragma unroll
            for (int k = 0; k < 8; ++k) { hcur = a8[k] * hcur + u8[k]; h8[k] = hcur; }
            __syncthreads();
            *(LAS f32x4*)(uL + ch * HS + 8 * sg) = (f32x4){h8[0], h8[1], h8[2], h8[3]}; *(LAS f32x4*)(uL + ch * HS + 8 * sg + 4) = (f32x4){h8[4], h8[5], h8[6], h8[7]};
            if (kind == 0) { if (sg == 15) carry[ch] = hcur; }
            else F.out[O_SH + (size_t)(sq * 16 + sg) * RGW + c0 + ch] = hcur;
            if (kind == 0 && ti == ntiles - 1 && sg == 15) F.out[O_PH + (size_t)sq * RGW + c0 + ch] = hcur;
        }
        __syncthreads();
        {
            const int rho = tid >> 2, c8 = (tid & 3) * 8;
            if (rho < nv) {
                const int grow = kind ? (MPR + (sq * 16 + (rho >> 3)) * DS + (rho & 7)) : (sq * TP + t0 + rho);
                float gr[8], o[8]; unpack8(gpre, gr);
#pragma unroll
                for (int e = 0; e < 8; ++e) o[e] = uL[(c8 + e) * HS + rho] * gelu_tanh_(gr[e]);
                *(GAS u32x4*)(cat + (size_t)grow * D + 1024 + c0 + c8) = pack8(o);
            }
        }
        if (qt == 0) {
            if (kind == 0) { if (ti == ntiles - 1 && tid < 384) { const int i3 = tid >> 7; F.out[O_PCV + ((size_t)sq * 3 + i3) * RGW + cb0 + chn] = bf2f(xp[(nv + i3) * XS + chn]); } }
            else { for (int p = tid; p < 16 * 3 * 128; p += NTHREADS) { const int sg = p / 384, i3 = (p % 384) >> 7, ch2 = p & 127; F.out[O_SCV + ((size_t)(sq * 16 + sg) * 3 + i3) * RGW + cb0 + ch2] = bf2f(xp[(sg * 11 + 8 + i3) * XS + ch2]); } }
        }
    }
#undef RG_PREFETCH
    __syncthreads();
    (void)T;
}


namespace rw {
constexpr int TB = 64;
constexpr int O_W = 0, O_A = O_W + TB * 64 * 4, O_B = O_A + TB * 64 * 4, O_K = O_B + TB * 64 * 4, O_R = O_K + TB * 64 * 4, O_V = O_R + TB * 64 * 4, O_Y = O_V + TB * 64 * 4, O_CB = O_Y + TB * 64 * 4, O_WC = O_CB + TB * 4, O_SP = O_WC + 256, O_ENDL = O_SP + 8 * 64 * 4;
static_assert(O_ENDL <= RING_BYTES, "rwkv lds");
}
__device__ __forceinline__ float row16_sum(float v) {
    v += __builtin_bit_cast(float, __builtin_amdgcn_update_dpp(0, __builtin_bit_cast(int, v), 0x128, 0xf, 0xf, false));
    v += __builtin_bit_cast(float, __builtin_amdgcn_update_dpp(0, __builtin_bit_cast(int, v), 0x124, 0xf, 0xf, false));
    v += __builtin_bit_cast(float, __builtin_amdgcn_update_dpp(0, __builtin_bit_cast(int, v), 0x122, 0xf, 0xf, false));
    v += __builtin_bit_cast(float, __builtin_amdgcn_update_dpp(0, __builtin_bit_cast(int, v), 0x121, 0xf, 0xf, false));
    return v;
}
template <int CTRL> __device__ __forceinline__ float dppf(float v) { return __builtin_bit_cast(float, __builtin_amdgcn_update_dpp(0, __builtin_bit_cast(int, v), CTRL, 0xf, 0xf, false)); }
#define RS_STAGE(n, bit, XCH) do { _Pragma("unroll") for (int j_ = 0; j_ < (n); ++j_) { \
        const float lo_ = ya[j_], hi_ = ya[j_ + (n)]; const float keep_ = (bit) ? hi_ : lo_, send_ = (bit) ? lo_ : hi_; ya[j_] = keep_ + XCH(send_); \
        const float lo2_ = yb[j_], hi2_ = yb[j_ + (n)]; const float keep2_ = (bit) ? hi2_ : lo2_, send2_ = (bit) ? lo2_ : hi2_; yb[j_] = keep2_ + XCH(send2_); } } while (0)
__device__ __forceinline__ float xch1(float v) { return dppf<0xB1>(v); }
__device__ __forceinline__ float xch2(float v) { return dppf<0x4E>(v); }
__device__ __forceinline__ float xch8(float v) { return dppf<0x128>(v); }
__device__ __forceinline__ float xch4(float v) { return dppf<0x1B>(dppf<0x141>(v)); }

__device__ __forceinline__ void rwkv_job(Frame& F, const Args& args, int rowbase, int T, int h, const float* S0, float* Sout) {
    using namespace rw;
    const int tid = F.tid, lane = F.lane, w = F.wave, rp = lane >> 4, kp = lane & 15;
    LAS unsigned char* L = F.lds;
    LAS float* Wl = (LAS float*)(L + O_W); LAS float* Al = (LAS float*)(L + O_A); LAS float* Bl = (LAS float*)(L + O_B); LAS float* Kl = (LAS float*)(L + O_K);
    LAS float* Rl = (LAS float*)(L + O_R); LAS float* Vl = (LAS float*)(L + O_V); LAS float* Yl = (LAS float*)(L + O_Y); LAS float* CBl = (LAS float*)(L + O_CB); LAS float* WCl = (LAS float*)(L + O_WC); LAS float* SPl = (LAS float*)(L + O_SP);
    const bf16_t* rb = (const bf16_t*)(F.ws + WS_RKV); const bf16_t* kb = rb + (size_t)MP * D; const bf16_t* vb = kb + (size_t)MP * D;
    const float* wd = (const float*)(F.ws + WS_WDEC); const bf16_t* ab = (const bf16_t*)(F.ws + WS_AG); const bf16_t* gb = (const bf16_t*)(F.ws + WS_GG);
    bf16_t* ycat = (bf16_t*)(F.ws + WS_YCAT);
    const int r0 = 8 * w + 2 * rp;
    f32x4 Sa, Sb;
    if (S0) { Sa = *(const GAS f32x4*)(S0 + (size_t)r0 * 64 + 4 * kp); Sb = *(const GAS f32x4*)(S0 + (size_t)(r0 + 1) * 64 + 4 * kp); }
    else { Sa = (f32x4){0.f, 0.f, 0.f, 0.f}; Sb = Sa; }
    const bool b0 = kp & 1, b1 = kp & 2, b2 = kp & 4, b3 = kp & 8;
    const int jmap = 8 * (kp & 1) + 4 * ((kp >> 1) & 1) + 2 * ((kp >> 3) & 1) + ((kp >> 2) & 1);
    const int tt = tid >> 3, part = tid & 7, hk = h * 64 + 8 * part;
    float ckk[8], cka[8], crk[8], clg[8], clb[8];
#pragma unroll
    for (int e = 0; e < 8; ++e) { ckk[e] = args.in[I_KK][hk + e]; cka[e] = args.in[I_KA][hk + e]; crk[e] = args.in[I_RK][hk + e]; clg[e] = args.in[I_LNXG][hk + e]; clb[e] = args.in[I_LNXB][hk + e]; }
    u32x4 q_r = (u32x4){0u, 0u, 0u, 0u}, q_k = q_r, q_v = q_r, q_a = q_r, q_g = q_r; f32x4 q_w0 = (f32x4){0.f, 0.f, 0.f, 0.f}, q_w1 = q_w0;
#define RW_PREFETCH(tb_) do { if ((tb_) + tt < T) { const size_t row_ = (size_t)(rowbase + (tb_) + tt); \
        q_r = *(const GAS u32x4*)(rb + row_ * D + hk); q_k = *(const GAS u32x4*)(kb + row_ * D + hk); q_v = *(const GAS u32x4*)(vb + row_ * D + hk); q_a = *(const GAS u32x4*)(ab + row_ * D + hk); \
        q_g = *(const GAS u32x4*)(gb + row_ * D + hk); q_w0 = *(const GAS f32x4*)(wd + row_ * D + hk); q_w1 = *(const GAS f32x4*)(wd + row_ * D + hk + 4); } } while (0)
    RW_PREFETCH(0);
    for (int tb = 0; tb < T; tb += TB) {
        const int nvt = (T - tb) < TB ? (T - tb) : TB;
        __syncthreads();
        float gcur[8];
        {
            const int o = tt * 64 + 8 * part;
            if (tt < nvt) {
                float r[8], k[8], v[8], a[8], wv[8];
                unpack8(q_r, r); unpack8(q_k, k); unpack8(q_v, v); unpack8(q_a, a); unpack8(q_g, gcur);
#pragma unroll
                for (int e = 0; e < 4; ++e) { wv[e] = q_w0[e]; wv[4 + e] = q_w1[e]; }
                float kkv[8], ss = 0.f, cb = 0.f, kp2[8];
#pragma unroll
                for (int e = 0; e < 8; ++e) { kkv[e] = k[e] * ckk[e]; ss += kkv[e] * kkv[e]; kp2[e] = k[e] * (1.0f + (a[e] - 1.0f) * cka[e]); cb += r[e] * kp2[e] * crk[e]; }
                ss += __shfl_xor(ss, 1); ss += __shfl_xor(ss, 2); ss += __shfl_xor(ss, 4);
                cb += __shfl_xor(cb, 1); cb += __shfl_xor(cb, 2); cb += __shfl_xor(cb, 4);
                const float inv = 1.0f / fmaxf(sqrtf(ss), 1e-12f);
#pragma unroll
                for (int e = 0; e < 8; ++e) { const float kk = kkv[e] * inv; Wl[o + e] = wv[e]; Al[o + e] = -kk; Bl[o + e] = kk * a[e]; Kl[o + e] = kp2[e]; Rl[o + e] = r[e]; Vl[o + e] = v[e]; }
                if (part == 0) CBl[tt] = cb;
            } else {
#pragma unroll
                for (int e = 0; e < 8; ++e) { Wl[o + e] = 1.f; Al[o + e] = 0.f; Bl[o + e] = 0.f; Kl[o + e] = 0.f; Rl[o + e] = 0.f; Vl[o + e] = 0.f; gcur[e] = 0.f; }
            }
        }
        RW_PREFETCH(tb + TB);
        __syncthreads();
        {
            const int kk_ = tid & 63, sg_ = tid >> 6;
            float wseg[8]; float pr = 1.f;
#pragma unroll
            for (int e = 0; e < 8; ++e) { wseg[e] = Wl[(8 * sg_ + e) * 64 + kk_]; pr *= wseg[e]; }
            SPl[sg_ * 64 + kk_] = pr;
            __syncthreads();
            float wc = 1.f;
#pragma unroll
            for (int q_ = 0; q_ < 8; ++q_) if (q_ < sg_) wc *= SPl[q_ * 64 + kk_];
#pragma unroll
            for (int e = 0; e < 8; ++e) { const int o_ = (8 * sg_ + e) * 64 + kk_;
                Al[o_] *= wc; wc *= wseg[e]; const float iw = 1.0f / wc; Bl[o_] *= iw; Kl[o_] *= iw; Rl[o_] *= wc; }
            if (sg_ == 7) WCl[kk_] = wc;
        }
        __syncthreads();
        const int ngrp = (nvt + 15) >> 4;
#define RW_LOAD(P, t_) do { P##a = *(const LAS f32x4*)(Al + (t_) * 64 + 4 * kp); P##b = *(const LAS f32x4*)(Bl + (t_) * 64 + 4 * kp); \
            P##k = *(const LAS f32x4*)(Kl + (t_) * 64 + 4 * kp); P##r = *(const LAS f32x4*)(Rl + (t_) * 64 + 4 * kp); P##v = *(const LAS f32x2*)(Vl + (t_) * 64 + r0); } while (0)
        f32x4 ca, cbv, ck, cr; f32x2 cv;
        f32x4 n0_a, n0_b, n0_k, n0_r; f32x2 n0_v;
        { RW_LOAD(n0_, 0); ca = n0_a; cbv = n0_b; ck = n0_k; cr = n0_r; cv = n0_v; }
#ifdef RW_DUPSTEPS
        const f32x4 Sa_sv = Sa, Sb_sv = Sb;
        for (int rep_ = 0; rep_ < 2; ++rep_) { if (rep_) { Sa = Sa_sv; Sb = Sb_sv; RW_LOAD(n0_, 0); ca = n0_a; cbv = n0_b; ck = n0_k; cr = n0_r; cv = n0_v; }
#endif
        for (int g = 0; g < ngrp; ++g) {
            float ya[16], yb[16];
#pragma unroll
            for (int j = 0; j < 16; ++j) {
                const int t = 16 * g + j;
                f32x4 na, nb, nk, nr; f32x2 nv;
                RW_LOAD(n, t + 1);
                __builtin_amdgcn_sched_barrier(0);
                const f32x2 a_lo = (f32x2){ca[0], ca[1]}, a_hi = (f32x2){ca[2], ca[3]};
                f32x2 qa = (f32x2){Sa[0], Sa[1]} * a_lo; qa = (f32x2){Sa[2], Sa[3]} * a_hi + qa;
                f32x2 qb = (f32x2){Sb[0], Sb[1]} * a_lo; qb = (f32x2){Sb[2], Sb[3]} * a_hi + qb;
                float pa = qa[0] + qa[1], pb = qb[0] + qb[1];
                const f32x4 ta = Sa + ck * cv[0], tbv = Sb + ck * cv[1];
                pa = row16_sum(pa); pb = row16_sum(pb);
                Sa = ta + cbv * pa; Sb = tbv + cbv * pb;
                const f32x2 r_lo = (f32x2){cr[0], cr[1]}, r_hi = (f32x2){cr[2], cr[3]};
                f32x2 za = (f32x2){Sa[0], Sa[1]} * r_lo; za = (f32x2){Sa[2], Sa[3]} * r_hi + za;
                f32x2 zb = (f32x2){Sb[0], Sb[1]} * r_lo; zb = (f32x2){Sb[2], Sb[3]} * r_hi + zb;
                ya[j] = za[0] + za[1]; yb[j] = zb[0] + zb[1];
                ca = na; cbv = nb; ck = nk; cr = nr; cv = nv;
                __builtin_amdgcn_sched_barrier(0);
            }
            RS_STAGE(8, b0, xch1); RS_STAGE(4, b1, xch2); RS_STAGE(2, b3, xch8); RS_STAGE(1, b2, xch4);
            *(LAS f32x2*)(Yl + (16 * g + jmap) * 64 + r0) = (f32x2){ya[0], yb[0]};
        }
#ifdef RW_DUPSTEPS
        }
#endif
#undef RW_LOAD
        { const f32x4 wl = *(const LAS f32x4*)(WCl + 4 * kp); Sa = Sa * wl; Sb = Sb * wl; }
        __syncthreads();
        if (tt < nvt) {
            const size_t row = (size_t)(rowbase + tb + tt);
            float y[8]; float s = 0.f;
#pragma unroll
            for (int e = 0; e < 8; ++e) { y[e] = Yl[tt * 64 + 8 * part + e]; s += y[e]; }
            s += __shfl_xor(s, 1); s += __shfl_xor(s, 2); s += __shfl_xor(s, 4);
            const float mu = s * (1.f / 64.f); float s2 = 0.f;
#pragma unroll
            for (int e = 0; e < 8; ++e) { y[e] -= mu; s2 += y[e] * y[e]; }
            s2 += __shfl_xor(s2, 1); s2 += __shfl_xor(s2, 2); s2 += __shfl_xor(s2, 4);
            const float rstd = 1.0f / sqrtf(s2 * (1.f / 64.f) + GN_EPS);
            float o[8];
            const float cb = CBl[tt];
#pragma unroll
            for (int e = 0; e < 8; ++e) o[e] = (y[e] * rstd * clg[e] + clb[e] + cb * Vl[tt * 64 + 8 * part + e]) * gcur[e];
            *(GAS u32x4*)(ycat + row * D + hk) = pack8(o);
        }
    }
#undef RW_PREFETCH
    *(GAS f32x4*)(Sout + (size_t)r0 * 64 + 4 * kp) = Sa; *(GAS f32x4*)(Sout + (size_t)(r0 + 1) * 64 + 4 * kp) = Sb;
    __syncthreads();
}


namespace rwc {
constexpr int TB = 64, LD = 66, LDG = 34, LDT = 18;
constexpr int LDB = 72;
constexpr int O_W = 0, O_B = O_W + TB * LD * 4, O_K = O_B + TB * LD * 4, O_V = O_K + TB * LD * 4, O_SB = O_V + TB * LD * 4,
              O_AB = O_SB + 64 * LDB * 2, O_RB = O_AB + TB * LDB * 2, O_BB = O_RB + TB * LDB * 2, O_KB = O_BB + TB * LDB * 2, O_U = O_KB + TB * LDB * 2, O_G = O_U + 16 * LD * 4, O_T = O_G + 4 * 32 * LDG * 4,
              O_WC = O_T + 4 * 16 * LDT * 4, O_CB = O_WC + 4 * 64 * 4, O_VT = O_CB + TB * 4, O_UT = O_VT + 64 * LDB * 2, O_LK = O_UT + 64 * 24 * 2, O_TB = O_LK + 4 * 16 * 20 * 2, O_ENDL = O_TB + 4 * 16 * 20 * 2;
constexpr int LDK = 20;
constexpr int LDU = 24;
constexpr int O_BT = O_B, O_KT = O_K;
constexpr int O_A = O_U;
static_assert(O_A + TB * LD * 4 <= O_WC, "rwkv temp alias");
static_assert(O_ENDL <= RING_BYTES, "rwkv chunk lds");
template <int K> __device__ __forceinline__ f32x4 mm(f32x4 acc, const LAS float* pa, int sak, const LAS float* pb, int sbk) {
    float a[K / 4], b[K / 4];
#pragma unroll
    for (int s4 = 0; s4 < K / 4; ++s4) { a[s4] = pa[4 * s4 * sak]; b[s4] = pb[4 * s4 * sbk]; }
    __builtin_amdgcn_sched_barrier(0);
#pragma unroll
    for (int s4 = 0; s4 < K / 4; ++s4) acc = __builtin_amdgcn_mfma_f32_16x16x4f32(a[s4], b[s4], acc, 0, 0, 0);
    return acc;
}
}
__device__ __forceinline__ float rw_sum8(float v) { v += dppf<0xB1>(v); v += dppf<0x4E>(v); v += dppf<0x141>(v); return v; }
template <bool PUB, bool BAT = false>
__device__ __forceinline__ void rwkv_job_c(Frame& F, const Args& args, int rowbase, int T, int h, const float* S0, float* Sout, unsigned* prog = nullptr, size_t sstride = 0) {
    using namespace rwc;
    const int tid = F.tid, lane = F.lane, w = F.wave, q0 = lane >> 4, c0 = lane & 15;
    LAS unsigned char* L = F.lds;
    LAS float* Wl = (LAS float*)(L + O_W); LAS float* Al = (LAS float*)(L + O_A); LAS float* Bl = (LAS float*)(L + O_B); LAS float* Kl = (LAS float*)(L + O_K);
    LAS bf16_t* Bb = (LAS bf16_t*)(L + O_BB); LAS bf16_t* Kb = (LAS bf16_t*)(L + O_KB); LAS bf16_t* BTb = (LAS bf16_t*)(L + O_BT); LAS bf16_t* KTb = (LAS bf16_t*)(L + O_KT); LAS bf16_t* VTb = (LAS bf16_t*)(L + O_VT); LAS bf16_t* UTb = (LAS bf16_t*)(L + O_UT); LAS bf16_t* LKb = (LAS bf16_t*)(L + O_LK); LAS bf16_t* Tbb = (LAS bf16_t*)(L + O_TB); LAS float* Vl = (LAS float*)(L + O_V); LAS bf16_t* Sb = (LAS bf16_t*)(L + O_SB); LAS bf16_t* Ab = (LAS bf16_t*)(L + O_AB); LAS bf16_t* Rb = (LAS bf16_t*)(L + O_RB); LAS float* UL = (LAS float*)(L + O_U);
    LAS float* GL = (LAS float*)(L + O_G); LAS float* TL = (LAS float*)(L + O_T); LAS float* WCl = (LAS float*)(L + O_WC); LAS float* CBl = (LAS float*)(L + O_CB);
    LAS float* Yl = Wl;
    const bf16_t* rb = (const bf16_t*)(F.ws + WS_RKV); const bf16_t* kb = rb + (size_t)MP * D; const bf16_t* vb = kb + (size_t)MP * D;
    const float* wd = (const float*)(F.ws + WS_WDEC); const bf16_t* ab = (const bf16_t*)(F.ws + WS_AG); const bf16_t* gb = (const bf16_t*)(F.ws + WS_GG);
    bf16_t* ycat = (bf16_t*)(F.ws + WS_YCAT);
    f32x4 st[4];
#pragma unroll
    for (int kt = 0; kt < 4; ++kt) st[kt] = (S0 && w < 4) ? *(const GAS f32x4*)(S0 + (size_t)(16 * w + c0) * 64 + 16 * kt + 4 * q0) : (f32x4){0.f, 0.f, 0.f, 0.f};
    const int tt = tid >> 3, part = tid & 7, hk = h * 64 + 8 * part;
    float ckk[8], cka[8], crk[8], clg[8], clb[8];
#pragma unroll
    for (int e = 0; e < 8; ++e) { ckk[e] = args.in[I_KK][hk + e]; cka[e] = args.in[I_KA][hk + e]; crk[e] = args.in[I_RK][hk + e]; clg[e] = args.in[I_LNXG][hk + e]; clb[e] = args.in[I_LNXB][hk + e]; }
    u32x4 q_r = (u32x4){0u, 0u, 0u, 0u}, q_k = q_r, q_v = q_r, q_a = q_r, q_g = q_r; f32x4 q_w0 = (f32x4){0.f, 0.f, 0.f, 0.f}, q_w1 = q_w0;
#define RW_PREFETCH(tb_) do { if (BAT ? ((tb_) == 0 && (tt & 15) < DS) : ((tb_) + tt < T)) { const size_t row_ = BAT ? (size_t)(rowbase + (tt >> 4) * DS + (tt & 15)) : (size_t)(rowbase + (tb_) + tt); \
        q_r = *(const GAS u32x4*)(rb + row_ * D + hk); q_k = *(const GAS u32x4*)(kb + row_ * D + hk); q_v = *(const GAS u32x4*)(vb + row_ * D + hk); q_a = *(const GAS u32x4*)(ab + row_ * D + hk); \
        q_g = *(const GAS u32x4*)(gb + row_ * D + hk); q_w0 = *(const GAS f32x4*)(wd + row_ * D + hk); q_w1 = *(const GAS f32x4*)(wd + row_ * D + hk + 4); } } while (0)
    RW_PREFETCH(0);
    for (int tb = 0; tb < T; tb += TB) {
        int q = q0, c = c0; asm volatile("" : "+v"(q), "+v"(c));
        const int nvt = (T - tb) < TB ? (T - tb) : TB;
        const int nch = (nvt + 15) >> 4;
        __syncthreads();
        float gcur[8];
        {
            const int o = tt * LD + 8 * part;
            if (BAT ? ((tt & 15) < DS) : (tt < nvt)) {
                float r[8], k[8], v[8], a[8], wv[8];
                unpack8(q_r, r); unpack8(q_k, k); unpack8(q_v, v); unpack8(q_a, a); unpack8(q_g, gcur);
#pragma unroll
                for (int e = 0; e < 4; ++e) { wv[e] = q_w0[e]; wv[4 + e] = q_w1[e]; }
                float kkv[8], ss = 0.f, cb = 0.f, kp2[8];
#pragma unroll
                for (int e = 0; e < 8; ++e) { kkv[e] = k[e] * ckk[e]; ss += kkv[e] * kkv[e]; kp2[e] = k[e] * (1.0f + (a[e] - 1.0f) * cka[e]); cb += r[e] * kp2[e] * crk[e]; }
                ss = rw_sum8(ss);
                cb = rw_sum8(cb);
                const float inv = 1.0f / fmaxf(sqrtf(ss), 1e-12f);
#pragma unroll
                for (int e = 0; e < 8; ++e) { const float kk = kkv[e] * inv; Wl[o + e] = wv[e]; Al[o + e] = -kk; Bl[o + e] = kk * a[e]; Kl[o + e] = kp2[e]; Vl[o + e] = v[e]; }
                *(LAS u32x4*)(Rb + tt * LDB + 8 * part) = q_r;
                if (part == 0) CBl[tt] = cb;
            } else {
#pragma unroll
                for (int e = 0; e < 8; ++e) { Wl[o + e] = 1.f; Al[o + e] = 0.f; Bl[o + e] = 0.f; Kl[o + e] = 0.f; Vl[o + e] = 0.f; gcur[e] = 0.f; }
                *(LAS u32x4*)(Rb + tt * LDB + 8 * part) = (u32x4){0u, 0u, 0u, 0u};
            }
        }
        RW_PREFETCH(tb + TB);
        __syncthreads();
        {
            const int kk_ = tid & 63, sg_ = tid >> 6;
            float bin[8], kin[8];
            {
                unsigned vt[4];
#pragma unroll
                for (int e = 0; e < 8; ++e) { const int o_ = (8 * sg_ + e) * LD + kk_; bin[e] = Bl[o_]; kin[e] = Kl[o_]; const unsigned vb_ = f2bf(Vl[o_]); if (e & 1) vt[e >> 1] |= vb_ << 16; else vt[e >> 1] = vb_; }
                *(LAS u32x4*)(VTb + kk_ * LDB + 8 * sg_) = (u32x4){vt[0], vt[1], vt[2], vt[3]};
            }
            __syncthreads();
            float wseg[8]; float wc = 1.f;
#pragma unroll
            for (int e = 0; e < 8; ++e) wseg[e] = Wl[(8 * sg_ + e) * LD + kk_];
            if (sg_ & 1) {
#pragma unroll
                for (int e = 0; e < 8; ++e) wc *= Wl[(8 * (sg_ - 1) + e) * LD + kk_];
            }
            unsigned bt[4], kt4[4];
#pragma unroll
            for (int e = 0; e < 8; ++e) { const int o_ = (8 * sg_ + e) * LD + kk_; const int ob_ = (8 * sg_ + e) * LDB + kk_;
                const float av = Al[o_] * wc; wc *= wseg[e]; const float iw = __builtin_amdgcn_rcpf(wc); const float bv = bin[e] * iw, kv = kin[e] * iw, rv = bf2f(Rb[ob_]) * wc;
                const unsigned bb_ = f2bf(bv), kb_ = f2bf(kv);
                Ab[ob_] = (bf16_t)f2bf(av); Rb[ob_] = (bf16_t)f2bf(rv); Bb[ob_] = (bf16_t)bb_; Kb[ob_] = (bf16_t)kb_;
                if (e & 1) { bt[e >> 1] |= bb_ << 16; kt4[e >> 1] |= kb_ << 16; } else { bt[e >> 1] = bb_; kt4[e >> 1] = kb_; } }
            *(LAS u32x4*)(BTb + kk_ * LDB + 8 * sg_) = (u32x4){bt[0], bt[1], bt[2], bt[3]};
            *(LAS u32x4*)(KTb + kk_ * LDB + 8 * sg_) = (u32x4){kt4[0], kt4[1], kt4[2], kt4[3]};
            if (sg_ & 1) WCl[(sg_ >> 1) * 64 + kk_] = wc;
        }
        __syncthreads();
        {
            const int gc = w >> 1, mt = w & 1; const int t0 = 16 * gc;
            const LAS bf16_t* pa = (mt ? Rb : Ab) + (t0 + c) * LDB + 8 * q;
            const bf16x8 a0 = *(const LAS bf16x8*)pa, a1 = *(const LAS bf16x8*)(pa + 32);
#pragma unroll
            for (int nt = 0; nt < 2; ++nt) {
                const LAS bf16_t* pb = (nt ? Kb : Bb) + (t0 + c) * LDB + 8 * q;
                const bf16x8 b0 = *(const LAS bf16x8*)pb, b1 = *(const LAS bf16x8*)(pb + 32);
                f32x4 g = __builtin_amdgcn_mfma_f32_16x16x32_bf16(a0, b0, (f32x4){0.f, 0.f, 0.f, 0.f}, 0, 0, 0);
                g = __builtin_amdgcn_mfma_f32_16x16x32_bf16(a1, b1, g, 0, 0, 0);
#pragma unroll
                for (int r = 0; r < 4; ++r) { const int t = 4 * q + r; const bool keep = mt ? (c <= t) : (c < t); const float gv = keep ? g[r] : 0.f;
                    if (mt) ((LAS bf16_t*)(GL + gc * 32 * LDG + (16 + t) * LDG))[16 * nt + c] = (bf16_t)f2bf(gv);
                    else { GL[gc * 32 * LDG + t * LDG + 16 * nt + c] = gv; if (nt == 1) LKb[(gc * 16 + t) * LDK + c] = (bf16_t)f2bf(gv); } }
            }
        }
        if ((w & 1) == 0 && q == 0) {
            const int gc = w >> 1;
            float tr[16];
            const LAS float* Lg = GL + gc * 32 * LDG;
#pragma unroll
            for (int t = 0; t < 16; ++t) { float acc = (t == c) ? 1.f : 0.f;
#pragma unroll
                for (int i = 0; i < t; ++i) acc += Lg[t * LDG + i] * tr[i];
                tr[t] = acc; Tbb[(gc * 16 + t) * LDK + c] = (bf16_t)f2bf(acc); }
        }
        if (PUB) asm volatile("s_waitcnt vmcnt(0)" ::: "memory");
        __syncthreads();
        if (PUB && tid == 0 && tb > 0) __hip_atomic_store(prog, (unsigned)tb, __ATOMIC_RELAXED, __HIP_MEMORY_SCOPE_AGENT);
        if (w < 4) {
            typedef short s16x4_t __attribute__((ext_vector_type(4)));
            for (int ch = 0; ch < nch; ++ch) {
                const int t0 = 16 * ch;
                const LAS float* Gc = GL + ch * 32 * LDG;
                const s16x4_t lkf = *(const LAS s16x4_t*)(LKb + (ch * 16 + c) * LDK + 4 * q), vtf = *(const LAS s16x4_t*)(VTb + (16 * w + c) * LDB + t0 + 4 * q);
                const s16x4_t tbf = *(const LAS s16x4_t*)(Tbb + (ch * 16 + c) * LDK + 4 * q);
                const LAS bf16_t* mrow = (const LAS bf16_t*)(Gc + (16 + c) * LDG) + 4 * q;
                const s16x4_t mbf = *(const LAS s16x4_t*)mrow, mkf = *(const LAS s16x4_t*)(mrow + 16);
                f32x4 xa = (f32x4){0.f, 0.f, 0.f, 0.f}, xr = (f32x4){0.f, 0.f, 0.f, 0.f};
#pragma unroll
                for (int kt = 0; kt < 4; ++kt) {
                    const s16x4_t sf = __builtin_bit_cast(s16x4_t, (u32x2){pk2(st[kt][0], st[kt][1]), pk2(st[kt][2], st[kt][3])});
                    const s16x4_t af = *(const LAS s16x4_t*)(Ab + (t0 + c) * LDB + 16 * kt + 4 * q), rf = *(const LAS s16x4_t*)(Rb + (t0 + c) * LDB + 16 * kt + 4 * q);
                    xa = __builtin_amdgcn_mfma_f32_16x16x16bf16_1k(af, sf, xa, 0, 0, 0);
                    xr = __builtin_amdgcn_mfma_f32_16x16x16bf16_1k(rf, sf, xr, 0, 0, 0);
                }
                xa = __builtin_amdgcn_mfma_f32_16x16x16bf16_1k(lkf, vtf, xa, 0, 0, 0);
                const s16x4_t rhf = __builtin_bit_cast(s16x4_t, (u32x2){pk2(xa[0], xa[1]), pk2(xa[2], xa[3])});
                const f32x4 u = __builtin_amdgcn_mfma_f32_16x16x16bf16_1k(tbf, rhf, (f32x4){0.f, 0.f, 0.f, 0.f}, 0, 0, 0);
                const s16x4_t uf = __builtin_bit_cast(s16x4_t, (u32x2){pk2(u[0], u[1]), pk2(u[2], u[3])});
                xr = __builtin_amdgcn_mfma_f32_16x16x16bf16_1k(mbf, uf, xr, 0, 0, 0);
                xr = __builtin_amdgcn_mfma_f32_16x16x16bf16_1k(mkf, vtf, xr, 0, 0, 0);
#pragma unroll
                for (int r = 0; r < 4; ++r) Yl[(t0 + 4 * q + r) * LD + 16 * w + c] = xr[r];
#pragma unroll
                for (int kt = 0; kt < 4; ++kt) {
                    const s16x4_t bf_ = *(const LAS s16x4_t*)(BTb + (16 * kt + c) * LDB + t0 + 4 * q), kf_ = *(const LAS s16x4_t*)(KTb + (16 * kt + c) * LDB + t0 + 4 * q);
                    st[kt] = __builtin_amdgcn_mfma_f32_16x16x16bf16_1k(bf_, uf, st[kt], 0, 0, 0);
                    st[kt] = __builtin_amdgcn_mfma_f32_16x16x16bf16_1k(kf_, vtf, st[kt], 0, 0, 0);
                    const f32x4 wcv = *(const LAS f32x4*)(WCl + ch * 64 + 16 * kt + 4 * q);
                    st[kt] = st[kt] * wcv;
                }
                if (BAT) {
#pragma unroll
                    for (int kt = 0; kt < 4; ++kt) *(GAS f32x4*)(Sout + (size_t)ch * sstride + (size_t)(16 * w + c) * 64 + 16 * kt + 4 * q) = st[kt];
                    if (ch + 1 < nch) {
#pragma unroll
                        for (int kt = 0; kt < 4; ++kt) st[kt] = *(const GAS f32x4*)(S0 + (size_t)(ch + 1) * sstride + (size_t)(16 * w + c) * 64 + 16 * kt + 4 * q);
                    }
                }
            }
        }
        __syncthreads();
        if (BAT ? ((tt & 15) < DS) : (tt < nvt)) {
            const size_t row = BAT ? (size_t)(rowbase + (tt >> 4) * DS + (tt & 15)) : (size_t)(rowbase + tb + tt);
            float y[8]; float s = 0.f;
#pragma unroll
            for (int e = 0; e < 8; ++e) { y[e] = Yl[tt * LD + 8 * part + e]; s += y[e]; }
            s = rw_sum8(s);
            const float mu = s * (1.f / 64.f); float s2 = 0.f;
#pragma unroll
            for (int e = 0; e < 8; ++e) { y[e] -= mu; s2 += y[e] * y[e]; }
            s2 = rw_sum8(s2);
            const float rstd = 1.0f / sqrtf(s2 * (1.f / 64.f) + GN_EPS);
            float o[8];
            const float cb = CBl[tt];
#pragma unroll
            for (int e = 0; e < 8; ++e) o[e] = (y[e] * rstd * clg[e] + clb[e] + cb * Vl[tt * LD + 8 * part + e]) * gcur[e];
            if (PUB) { const u32x4 yv = pack8(o); const bf16_t* yp = ycat + row * D + hk; asm volatile("global_store_dwordx4 %0, %1, off sc1" :: "v"(yp), "v"(yv) : "memory"); }
            else *(GAS u32x4*)(ycat + row * D + hk) = pack8(o);
        }
    }
#undef RW_PREFETCH
    if (!BAT && w < 4) {
#pragma unroll
        for (int kt = 0; kt < 4; ++kt) *(GAS f32x4*)(Sout + (size_t)(16 * w + c0) * 64 + 16 * kt + 4 * q0) = st[kt];
    }
    if (PUB) asm volatile("s_waitcnt vmcnt(0)" ::: "memory");
    __syncthreads();
    if (PUB && tid == 0) __hip_atomic_store(prog, (unsigned)T, __ATOMIC_RELAXED, __HIP_MEMORY_SCOPE_AGENT);
}
__global__ void __launch_bounds__(NTHREADS, 2) mega_fwd(Args args) {
    extern __shared__ __attribute__((aligned(16))) unsigned char lds_raw[];
    Frame F;
    F.lds = (LAS unsigned char*)lds_raw;
    F.out = args.out; F.ws = args.ws;
    F.tid = threadIdx.x; F.lane = F.tid & 63; F.wave = __builtin_amdgcn_readfirstlane(F.tid >> 6);
    F.G = gridDim.x; { const int bx = blockIdx.x; const int vcu = (F.G % 8 == 0) ? (bx % 8) * (F.G / 8) + bx / 8 : bx; F.gw = vcu * NWAVES + F.wave; }
    F.NGW = F.G * NWAVES;
    volatile LAS unsigned* MISC = (volatile LAS unsigned*)(F.lds + MISC_OFF);
    for (int u = F.tid; u < (LDS_BYTES - LDSCTL_OFF) / 4; u += NTHREADS) ((LAS unsigned*)(F.lds + LDSCTL_OFF))[u] = 0u;
    __syncthreads();
    unsigned* ctl = (unsigned*)(F.ws + WS_CTL);
    XcdBarrier bar = xcd_barrier_post(ctl + CW_BAR, MISC + 8);
    const int lo = args.ph_lo, hi = args.ph_hi;
#ifndef PHASE_MASK
#define PHASE_MASK 0x1ffffu
#endif
#define IN(k) (((PHASE_MASK >> (k)) & 1u) && lo <= (k) && (k) < hi)
#define SEAM(k) do { if (IN(k) && IN((k) + 1)) xcd_barrier(bar); } while (0)
#ifndef DUP_MASK
#define DUP_MASK 0u
#endif
#define RUNPH(k, ...) if (IN(k)) { __VA_ARGS__; if ((DUP_MASK >> (k)) & 1u) { xcd_barrier(bar); __VA_ARGS__; } }

    const int vcu = F.gw >> 3;
    unsigned char* ws = F.ws;
    RUNPH(0, { p0_prologue(F, args); __syncthreads(); p0_rows(F, args); })
    SEAM(0);
    RUNPH(1, pg8::gemm_phase<1u << pg8::EM_BF16>(F.lds, c_ph[0], ws, args.in[I_W0], args.in[I_A0], F.G, (int)blockIdx.x, ctl + CW_SPLIT + 1 * 256, MISC + 16);)
    SEAM(1);
    RUNPH(2, {    \
        constexpr int SMP_A = 128;       \
        if (vcu < 128) { mlstm_prompt_job(F, args, vcu); for (int j = DB * NHA - SMP_A + vcu; j < DB * NHA; j += 128) mlstm_sample_job(F, args, j); } \
        else { for (int j = vcu - 128; j < 384; j += 128) { if (j < 128) rglru_job(F, args, 0, j >> 5, (j >> 2) & 7, j & 3); else { const int k = j - 128; rglru_job(F, args, 1, k >> 5, (k >> 2) & 7, k & 3); } } \
               for (int j = vcu - 128; j < DB * NHA - SMP_A; j += 128) mlstm_sample_job(F, args, j); } \
    })
    SEAM(2);
    RUNPH(3, headnorm_pass(F, args);)
    SEAM(3);
    RUNPH(4, { pg8::gemm_phase<1u << pg8::EM_RESID>(F.lds, c_ph[1], ws, args.in[I_W0], args.in[I_A0], F.G, (int)blockIdx.x, ctl + CW_SPLIT + 4 * 256, MISC + 16); \
        constexpr int BUSY4 = ((MP / 256) * (D / 256) - 256) * 4;       \
        if ((int)blockIdx.x >= BUSY4) { Frame F2 = F; F2.gw = ((int)blockIdx.x - BUSY4) * NWAVES + F.wave; F2.NGW = (F.G - BUSY4) * NWAVES; int cursor = 0; convert_wup(F2, args, 0, cursor, (LAS float*)(F.lds + F.wave * 16896)); } })
    SEAM(4);
    RUNPH(5, ln_pass(F, (const bf16_t*)(ws + WS_ZRES), args.in[I_LN1G], args.in[I_LN1B], (bf16_t*)(ws + WS_HA));)
    SEAM(5);
    RUNPH(6, { pg8::gemm_phase<1u << pg8::EM_RELU2>(F.lds, c_ph[2], ws, args.in[I_W0], args.in[I_A0], F.G, (int)blockIdx.x, ctl + CW_SPLIT + 6 * 256, MISC + 16); \
        constexpr int BUSY6 = (MP / 256) * (DFF / 256) - 4 * 256;       \
        if ((int)blockIdx.x >= BUSY6) { Frame F2 = F; F2.gw = ((int)blockIdx.x - BUSY6) * NWAVES + F.wave; F2.NGW = (F.G - BUSY6) * NWAVES; int cursor = 0; convert_wdn(F2, args, 0, cursor, (LAS float*)(F.lds + F.wave * 16896)); } })
    SEAM(6);
    RUNPH(7, { pg8::gemm_phase<1u << pg8::EM_RESID>(F.lds, c_ph[3], ws, args.in[I_W0], args.in[I_A0], F.G, (int)blockIdx.x, ctl + CW_SPLIT + 7 * 256, MISC + 16); \
        constexpr int BUSY = ((MP / 256) * (D / 256) - 256) * 4;        \
        if ((int)blockIdx.x >= BUSY) { Frame F2 = F; F2.gw = ((int)blockIdx.x - BUSY) * NWAVES + F.wave; F2.NGW = (F.G - BUSY) * NWAVES; convert_rwkv_weights(F2, args, (LAS float*)(F.lds + F.wave * 16896)); } })
    SEAM(7);
    RUNPH(8, ln_mix_pass(F, args, (const bf16_t*)(ws + WS_ZRES), args.in[I_LN2G], args.in[I_LN2B]);)
    SEAM(8);
    RUNPH(9, pg8::gemm_phase<(1u << pg8::EM_BF16) | (1u << pg8::EM_TANH) | (1u << pg8::EM_SIGM)>(F.lds, c_ph[4], ws, args.in[I_W0], args.in[I_A0], F.G, (int)blockIdx.x, ctl + CW_SPLIT + 9 * 256, MISC + 16);)
    SEAM(9);
    RUNPH(10, pg8::gemm_phase<(1u << pg8::EM_BF16) | (1u << pg8::EM_WDEC) | (1u << pg8::EM_ASIG)>(F.lds, c_ph[5], ws, args.in[I_W0], args.in[I_A0], F.G, (int)blockIdx.x, ctl + CW_SPLIT + 10 * 256, MISC + 16);)
    SEAM(10);
    RUNPH(11, {   \
        const int rep_a = ((DUP_MASK >> 17) & 1u) ? 2 : 1; const int rep_b = ((DUP_MASK >> 18) & 1u) ? 2 : 1; \
        if (vcu < NB * NHC) { const int bb = vcu >> 5; const int h = vcu & 31; for (int rep = 0; rep < rep_a; ++rep) rwkv_job_c<true>(F, args, bb * TP, TP, h, nullptr, F.out + O_PS + (size_t)(bb * NHC + h) * HDC * HDC, ctl + CW_PROG + vcu); } \
        else { for (int rep = 0; rep < rep_b; ++rep) for (int j = vcu - NB * NHC; j < (DB / 4) * NHC; j += F.G - NB * NHC) { const int bb = 4 * (j >> 5); const int h = j & 31; \
            rwkv_job_c<false, true>(F, args, MPR + bb * DS, 64, h, args.in[I_RS] + (size_t)(bb * NHC + h) * HDC * HDC, F.out + O_SS + (size_t)(bb * NHC + h) * HDC * HDC, nullptr, (size_t)NHC * HDC * HDC); } \
              \
            asm volatile("s_waitcnt vmcnt(0)" ::: "memory"); __syncthreads(); \
            if (F.tid == 0) { __builtin_amdgcn_fence(__ATOMIC_RELEASE, "agent"); asm volatile("s_waitcnt vmcnt(0)" ::: "memory"); __hip_atomic_fetch_add(ctl + CW_PROG + 256, 1u, __ATOMIC_RELAXED, __HIP_MEMORY_SCOPE_AGENT); } \
            Frame F2 = F; F2.gw = (vcu - NB * NHC) * NWAVES + F.wave; F2.NGW = (F.G - NB * NHC) * NWAVES; int cursor = 0; \
            convert_wup(F2, args, 1, cursor, (LAS float*)(F.lds + F.wave * 16896)); \
            __syncthreads(); \
            pg8::gemm_phase<1u << pg8::EM_RESID, 1>(F.lds, c_ph[7], ws, args.in[I_W0], args.in[I_A0], F.G - NB * NHC, vcu - NB * NHC, ctl + CW_SPLIT + 11 * 256, MISC + 16, ctl + CW_PROG); } \
    })
    SEAM(11);
    RUNPH(12, { pg8::gemm_phase<1u << pg8::EM_RESID>(F.lds, c_ph[6], ws, args.in[I_W0], args.in[I_A0], F.G, (int)blockIdx.x, ctl + CW_SPLIT + 12 * 256, MISC + 16); \
        constexpr int BUSY12 = pg8::N_LATE * (D / 256);                \
        if ((int)blockIdx.x >= BUSY12) { Frame F2 = F; F2.gw = ((int)blockIdx.x - BUSY12) * NWAVES + F.wave; F2.NGW = (F.G - BUSY12) * NWAVES; int cursor = 0; \
            convert_wdn(F2, args, 1, cursor, (LAS float*)(F.lds + F.wave * 16896)); } })
    SEAM(12);
    RUNPH(13, ln_pass(F, (const bf16_t*)(ws + WS_ZRES), args.in[I_LN1G] + D, args.in[I_LN1B] + D, (bf16_t*)(ws + WS_HA));)
    SEAM(13);
    RUNPH(14, pg8::gemm_phase<1u << pg8::EM_RELU2>(F.lds, c_ph[2], ws, args.in[I_W0], args.in[I_A0], F.G, (int)blockIdx.x, ctl + CW_SPLIT + 14 * 256, MISC + 16);)
    SEAM(14);
    RUNPH(15, pg8::gemm_phase<1u << pg8::EM_RESID>(F.lds, c_ph[3], ws, args.in[I_W0], args.in[I_A0], F.G, (int)blockIdx.x, ctl + CW_SPLIT + 15 * 256, MISC + 16);)
    SEAM(15);
    RUNPH(16, ln_final(F, (const bf16_t*)(ws + WS_ZRES), args.in[I_LN2G] + D, args.in[I_LN2B] + D);)
#undef IN
#undef SEAM
}

constexpr int N_PHASES = 17;
extern "C" void kernel_launch(void* const* d_in, const int* in_sizes, int n_in, void* d_out, int out_size, void* d_ws, size_t ws_size, hipStream_t stream) {
    static int grid = 0;
    if (grid == 0) {
        if (n_in != N_IN || (size_t)out_size != O_END || ws_size < WS_END) { fprintf(stderr, "kernel_launch: unexpected sizes n_in %d out %d ws %zu (need %zu)\n", n_in, out_size, ws_size, (size_t)WS_END); grid = -1; return; }
        int dev = 0, cus = 0;
        if (hipGetDevice(&dev) != hipSuccess || hipDeviceGetAttribute(&cus, hipDeviceAttributeMultiprocessorCount, dev) != hipSuccess) { grid = -1; return; }
        if (hipFuncSetAttribute((const void*)mega_fwd, hipFuncAttributeMaxDynamicSharedMemorySize, LDS_BYTES) != hipSuccess) { fprintf(stderr, "kernel_launch: hipFuncSetAttribute failed\n"); grid = -1; return; }
        grid = cus;
    }
    if (grid < 0) return;
    (void)hipMemsetAsync((char*)d_ws + WS_CTL, 0, CTL_ZERO_BYTES, stream);
    Args a{};
    for (int i = 0; i < N_IN; ++i) a.in[i] = (const float*)d_in[i];
    a.out = (float*)d_out; a.ws = (unsigned char*)d_ws;
    a.ph_lo = 0; a.ph_hi = N_PHASES;
    hipLaunchKernelGGL(mega_fwd, dim3(grid), dim3(NTHREADS), LDS_BYTES, stream, a);
}
```
